# Optimizing an MI355X kernel written in HIP

```python
import jax, jax.numpy as jnp
from jax import lax
import numpy as np

D_MODEL = 1024
BATCH = 2
SEQ = 16384
DEPTH = 2

HEAD_DIM = 64
MIX_WIDTH = D_MODEL
MOBA_HEADS = 6
MLSTM_HEADS = 4
SWA_Q_HEADS = 6
SWA_KV_HEADS = 2
MOBA_WIDTH = MOBA_HEADS * HEAD_DIM
MLSTM_WIDTH = MLSTM_HEADS * HEAD_DIM
SWA_Q_WIDTH = SWA_Q_HEADS * HEAD_DIM
SWA_KV_WIDTH = SWA_KV_HEADS * HEAD_DIM
MOBA_BLOCK = 256
MOBA_TOPK = 3
MOBA_Q_CHUNK = 64
MLSTM_CHUNK = 64
CONV_WIDTH = 4
SWA_WINDOW = 128
ROPE_THETA = 10000.0
D_FF = 4 * D_MODEL
NORM_EPS = 1e-6
IN_SPLITS = (MOBA_WIDTH, MOBA_WIDTH, MOBA_WIDTH, SWA_Q_WIDTH, SWA_KV_WIDTH, SWA_KV_WIDTH, 2 * MLSTM_WIDTH, MLSTM_WIDTH, MLSTM_WIDTH, MLSTM_HEADS, MLSTM_HEADS)
IN_WIDTH = sum(IN_SPLITS)

kernel_name = 'hybrid_moba_mlstm_swa_block'


def rms_norm(x, g):
    xf = x.astype(jnp.float32)
    y = xf * lax.rsqrt(jnp.mean(xf * xf, axis=-1, keepdims=True) + NORM_EPS)
    return (y * g.astype(jnp.float32)).astype(x.dtype)


def rope_tables(seq):
    inv = ROPE_THETA ** (-jnp.arange(0, HEAD_DIM, 2, dtype=jnp.float32) / HEAD_DIM)
    ang = jnp.arange(seq, dtype=jnp.float32)[:, None] * inv[None, :]
    return jnp.cos(ang), jnp.sin(ang)


def apply_rope(x, cos, sin):
    c = cos[:, None, :].astype(x.dtype)
    s = sin[:, None, :].astype(x.dtype)
    x1, x2 = jnp.split(x, 2, axis=-1)
    return jnp.concatenate([x1 * c - x2 * s, x2 * c + x1 * s], axis=-1)


def causal_depthwise_conv(x, w, b):
    C = x.shape[-1]
    y = lax.conv_general_dilated(x, w[:, None, :].astype(x.dtype), (1,), [(w.shape[0] - 1, 0)],
                                 dimension_numbers=('NWC', 'WIO', 'NWC'), feature_group_count=C)
    return y + b.astype(x.dtype)


def moba_attention(q, k, v):
    B, H, S, D = q.shape
    L = MOBA_BLOCK
    n_blocks = -(-S // L)
    s_pad = n_blocks * L
    if s_pad != S:
        padw = ((0, 0), (0, 0), (0, s_pad - S), (0, 0))
        q, k, v = jnp.pad(q, padw), jnp.pad(k, padw), jnp.pad(v, padw)
    k_blk = k.reshape(B, H, n_blocks, L, D)
    v_blk = v.reshape(B, H, n_blocks, L, D)
    k_mean = jnp.mean(k_blk.astype(jnp.float32), axis=3)
    top = min(MOBA_TOPK, n_blocks)
    scale = D ** -0.5
    Qc = MOBA_Q_CHUNK
    b_idx = jnp.arange(B)[:, None, None, None]
    h_idx = jnp.arange(H)[None, :, None, None]

    def one_chunk(c):
        start = c * Qc
        blk = start // L
        qc = lax.dynamic_slice_in_dim(q, start, Qc, axis=2)
        gate = jnp.einsum('bhqd,bhnd->bhqn', qc.astype(jnp.float32), k_mean)
        gate = jnp.where(jnp.arange(n_blocks) < blk, gate, -jnp.inf)
        _, sel = lax.top_k(gate, top)
        sel_ok = jnp.arange(top) < blk
        k_sel = k_blk[b_idx, h_idx, sel]
        v_sel = v_blk[b_idx, h_idx, sel]
        s_sel = jnp.einsum('bhqd,bhqrld->bhqrl', qc, k_sel).astype(jnp.float32) * scale
        s_sel = jnp.where(sel_ok[:, None], s_sel, -jnp.inf).reshape(B, H, Qc, top * L)
        k_own = lax.dynamic_slice_in_dim(k, blk * L, L, axis=2)
        v_own = lax.dynamic_slice_in_dim(v, blk * L, L, axis=2)
        s_own = jnp.einsum('bhqd,bhld->bhql', qc, k_own).astype(jnp.float32) * scale
        q_pos = start + jnp.arange(Qc)
        k_pos = blk * L + jnp.arange(L)
        s_own = jnp.where(k_pos[None, :] <= q_pos[:, None], s_own, -jnp.inf)
        p = jax.nn.softmax(jnp.concatenate([s_sel, s_own], axis=-1), axis=-1).astype(v.dtype)
        p_sel = p[..., :top * L].reshape(B, H, Qc, top, L)
        p_own = p[..., top * L:]
        return (jnp.einsum('bhqrl,bhqrld->bhqd', p_sel, v_sel)
                + jnp.einsum('bhql,bhld->bhqd', p_own, v_own))

    outs = lax.map(one_chunk, jnp.arange(s_pad // Qc))
    out = jnp.moveaxis(outs, 0, 2).reshape(B, H, s_pad, D)
    return out[:, :, :S]


def mlstm_chunkwise(q, k, v, i_pre, f_pre):
    B, H, S, D = q.shape
    L = MLSTM_CHUNK
    nc = S // L
    k = k * (D ** -0.5)
    log_f = jax.nn.log_sigmoid(f_pre)

    def chunks(a):
        return jnp.moveaxis(a.reshape(B, H, nc, L, *a.shape[3:]), 2, 0)

    causal = jnp.tril(jnp.ones((L, L), dtype=bool))

    def step(carry, inp):
        C, n, m = carry
        qc, kc, vc, ic, lfc = inp
        b = jnp.cumsum(lfc, axis=-1)
        a = b[..., -1]
        d = b[..., :, None] - b[..., None, :] + ic[..., None, :]
        d = jnp.where(causal, d, -jnp.inf)
        inter = b + m[..., None]
        m_t = jnp.maximum(inter, jnp.max(d, axis=-1))
        w_intra = jnp.exp(d - m_t[..., None])
        w_inter = jnp.exp(inter - m_t)
        qk = jnp.einsum('bhtd,bhsd->bhts', qc, kc) * w_intra
        num = (w_inter[..., None] * jnp.einsum('bhtd,bhde->bhte', qc, C)
               + jnp.einsum('bhts,bhse->bhte', qk, vc))
        den = w_inter * jnp.einsum('bhtd,bhd->bht', qc, n) + jnp.sum(qk, axis=-1)
        h = num / jnp.maximum(jnp.abs(den), jnp.exp(-m_t))[..., None]
        g = a[..., None] - b + ic
        m_new = jnp.maximum(a + m, jnp.max(g, axis=-1))
        w_s = jnp.exp(g - m_new[..., None])
        decay = jnp.exp(a + m - m_new)
        C_new = decay[..., None, None] * C + jnp.einsum('bhsd,bhse->bhde', kc * w_s[..., None], vc)
        n_new = decay[..., None] * n + jnp.einsum('bhs,bhsd->bhd', w_s, kc)
        return (C_new, n_new, m_new), h

    init = (jnp.zeros((B, H, D, D), jnp.float32), jnp.zeros((B, H, D), jnp.float32),
            jnp.zeros((B, H), jnp.float32))
    _, h = lax.scan(step, init, (chunks(q), chunks(k), chunks(v), chunks(i_pre), chunks(log_f)))
    return jnp.moveaxis(h, 0, 2).reshape(B, H, S, D)


def swa_attention(q, k, v, sinks):
    B, S, Hq, D = q.shape
    Hkv = k.shape[2]
    G = Hq // Hkv
    W = SWA_WINDOW
    nb = S // W
    qb = q.reshape(B, nb, W, Hkv, G, D)

    def band(a):
        ab = a.reshape(B, nb, W, Hkv, D)
        prev = jnp.pad(ab, ((0, 0), (1, 0), (0, 0), (0, 0), (0, 0)))[:, :-1]
        return jnp.concatenate([prev, ab], axis=2)

    kb, vb = band(k), band(v)
    s = jnp.einsum('bnqkgd,bnjkd->bnkgqj', qb, kb).astype(jnp.float32) * (D ** -0.5)
    qi = jnp.arange(W)[:, None] + W
    kj = jnp.arange(2 * W)[None, :]
    in_window = (qi - kj >= 0) & (qi - kj < W)
    exists = (jnp.arange(nb)[:, None, None] > 0) | (kj[None] >= W)
    mask = in_window[None] & exists
    s = jnp.where(mask[None, :, None, None], s, -jnp.inf)
    sink = jnp.broadcast_to(sinks.astype(jnp.float32).reshape(1, 1, Hkv, G, 1, 1), s.shape[:-1] + (1,))
    p = jax.nn.softmax(jnp.concatenate([s, sink], axis=-1), axis=-1)[..., :-1].astype(v.dtype)
    o = jnp.einsum('bnkgqj,bnjkd->bnqkgd', p, vb)
    return o.reshape(B, S, Hq, D)


def hybrid_layer(x, cos, sin, ln1, w_in, conv_w, conv_b, igate_b, fgate_b, mlstm_norm,
                 moba_q_norm, moba_k_norm, swa_q_norm, swa_k_norm, swa_sinks, w_out,
                 ln2, w_up, w_down):
    B, S, _ = x.shape
    hn = rms_norm(x, ln1)
    proj = hn @ w_in
    idx = np.cumsum(IN_SPLITS)[:-1].tolist()
    mq, mk, mv, sq, sk, sv, xqk, xv, xo, xi, xf = jnp.split(proj, idx, axis=-1)

    def heads(a):
        return a.reshape(B, S, -1, HEAD_DIM)

    def bhsd(a):
        return a.transpose(0, 2, 1, 3)

    mq = apply_rope(rms_norm(heads(mq), moba_q_norm), cos, sin)
    mk = apply_rope(rms_norm(heads(mk), moba_k_norm), cos, sin)
    y_moba = bhsd(moba_attention(bhsd(mq), bhsd(mk), bhsd(heads(mv)))).reshape(B, S, MOBA_WIDTH)

    qk = jax.nn.silu(causal_depthwise_conv(xqk, conv_w, conv_b))
    lq, lk = jnp.split(qk, 2, axis=-1)
    i_pre = (xi + igate_b).astype(jnp.float32).transpose(0, 2, 1)
    f_pre = (xf + fgate_b).astype(jnp.float32).transpose(0, 2, 1)
    h = mlstm_chunkwise(bhsd(heads(lq)).astype(jnp.float32), bhsd(heads(lk)).astype(jnp.float32),
                        bhsd(heads(xv)).astype(jnp.float32), i_pre, f_pre)
    h = bhsd(h).astype(x.dtype) * heads(jax.nn.sigmoid(xo))
    y_mlstm = rms_norm(h, mlstm_norm).reshape(B, S, MLSTM_WIDTH)

    sq = apply_rope(rms_norm(heads(sq), swa_q_norm), cos, sin)
    sk = apply_rope(rms_norm(heads(sk), swa_k_norm), cos, sin)
    y_swa = swa_attention(sq, sk, heads(sv), swa_sinks).reshape(B, S, SWA_Q_WIDTH)

    x = x + jnp.concatenate([y_moba, y_mlstm, y_swa], axis=-1) @ w_out
    u = rms_norm(x, ln2) @ w_up
    return x + jnp.square(jax.nn.relu(u)) @ w_down


def setup_inputs(seed: int = 0) -> dict:
    key = jax.random.key(seed)
    ks = jax.random.split(key, 17)
    f32 = jnp.float32

    def nrm(k, shape, scale):
        return jax.random.normal(k, shape, f32) * scale

    return {
        'x': nrm(ks[0], (BATCH, SEQ, D_MODEL), 1.0),
        'ln1': 1.0 + nrm(ks[1], (DEPTH, D_MODEL), 0.02),
        'w_in': nrm(ks[2], (DEPTH, D_MODEL, IN_WIDTH), D_MODEL ** -0.5),
        'conv_w': nrm(ks[3], (DEPTH, CONV_WIDTH, 2 * MLSTM_WIDTH), CONV_WIDTH ** -0.5),
        'conv_b': nrm(ks[4], (DEPTH, 2 * MLSTM_WIDTH), 0.02),
        'igate_b': nrm(ks[5], (DEPTH, MLSTM_HEADS), 0.1),
        'fgate_b': jnp.linspace(3.0, 6.0, MLSTM_HEADS, dtype=f32)[None] + nrm(ks[6], (DEPTH, MLSTM_HEADS), 0.1),
        'mlstm_norm': 1.0 + nrm(ks[7], (DEPTH, MLSTM_HEADS, HEAD_DIM), 0.02),
        'moba_q_norm': 1.0 + nrm(ks[8], (DEPTH, HEAD_DIM), 0.02),
        'moba_k_norm': 1.0 + nrm(ks[9], (DEPTH, HEAD_DIM), 0.02),
        'swa_q_norm': 1.0 + nrm(ks[10], (DEPTH, HEAD_DIM), 0.02),
        'swa_k_norm': 1.0 + nrm(ks[11], (DEPTH, HEAD_DIM), 0.02),
        'swa_sinks': nrm(ks[12], (DEPTH, SWA_Q_HEADS), 1.0),
        'w_out': nrm(ks[13], (DEPTH, MIX_WIDTH, D_MODEL), MIX_WIDTH ** -0.5),
        'ln2': 1.0 + nrm(ks[14], (DEPTH, D_MODEL), 0.02),
        'w_up': nrm(ks[15], (DEPTH, D_MODEL, D_FF), D_MODEL ** -0.5),
        'w_down': nrm(ks[16], (DEPTH, D_FF, D_MODEL), D_FF ** -0.5),
    }


def reference(x, ln1, w_in, conv_w, conv_b, igate_b, fgate_b, mlstm_norm, moba_q_norm,
              moba_k_norm, swa_q_norm, swa_k_norm, swa_sinks, w_out, ln2, w_up, w_down):
    cos, sin = rope_tables(x.shape[1])
    for l in range(DEPTH):
        x = hybrid_layer(x, cos, sin, ln1[l], w_in[l], conv_w[l], conv_b[l], igate_b[l], fgate_b[l],
                         mlstm_norm[l], moba_q_norm[l], moba_k_norm[l], swa_q_norm[l], swa_k_norm[l],
                         swa_sinks[l], w_out[l], ln2[l], w_up[l], w_down[l])
    return x
```

```cpp
#include <hip/hip_runtime.h>
#include <hip/hip_cooperative_groups.h>
#include <cstdio>
#include <cstdint>
namespace cg = cooperative_groups;
namespace pg8 {
#define PG8_LAS __attribute__((address_space(3)))
typedef unsigned short bf16_t;
typedef short bf16x8 __attribute__((ext_vector_type(8)));
typedef float f32x4 __attribute__((ext_vector_type(4)));
typedef unsigned u32x4 __attribute__((ext_vector_type(4)));
constexpr int BM = 256, BK = 64, HALF = 128, HTB = HALF * BK * 2  , STAGE_BYTES = 8 * HTB, NXCD = 8, WGM = 8;

__host__ __device__ __forceinline__ int lds_byte(int r, int c) { const int st = (r >> 4) * 2 + (c >> 5), rr = r & 15, cc = c & 31, ob = rr * 64 + cc * 2; return st * 1024 + (ob ^ (((ob >> 9) & 1) << 5)); }
__host__ __device__ __forceinline__ void stage_rc(int b, int& R, int& C) { const int st = b / 1024, sb = b % 1024, swz = sb ^ (((sb >> 9) & 1) << 5); R = (st >> 1) * 16 + swz / 64; C = (st & 1) * 32 + (swz % 64) / 2; }
__host__ __device__ __forceinline__ int perm32(int rho) { const int n = rho >> 4, i = rho & 15; return 8 * (i >> 2) + 4 * n + (i & 3); }

struct Unit { int pm, pn; };
struct Gemm { const bf16_t* A; const bf16_t* Bt; int M, N, K; };

struct StaticOrder {
    int nM, nN, nwg, G, c;
    __host__ __device__ void init(int M, int N, int G_, int c_) { nM = M / BM; nN = N / BM; nwg = nM * nN; G = G_; c = c_; }
    __host__ __device__ bool next(int i, Unit& u) const {
        const long L = (long)i * G + c; if (L >= nwg) return false;
        int wgid = (int)L; { const int q = nwg / NXCD, r = nwg % NXCD, xcd = wgid % NXCD, off = wgid / NXCD; wgid = (xcd < r ? xcd * (q + 1) : r * (q + 1) + (xcd - r) * q) + off; }
        const int nig = WGM * nN, gid = wgid / nig, fm = gid * WGM, gsz = (nM - fm) < WGM ? (nM - fm) : WGM;
        u.pm = fm + ((wgid % nig) % gsz); u.pn = (wgid % nig) / gsz; return true;
    }
    __device__ __forceinline__ void a_ready(const Unit&) const {}
    __device__ __forceinline__ void done(const Unit&) const {}
};
__device__ __forceinline__ unsigned cvt_pk_bf16(float lo, float hi) { unsigned r; asm volatile("v_cvt_pk_bf16_f32 %0, %1, %2" : "=v"(r) : "v"(lo), "v"(hi)); return r; }
typedef float f32x2 __attribute__((ext_vector_type(2)));
template <class Epi, class Sched, bool ALIGN_EPI = false, bool SP2 = false>
__device__ __forceinline__ void gemm_phase(PG8_LAS unsigned char* lds, const Gemm g, const Sched& S, const Epi& E) {
    int tid_l = threadIdx.x; asm volatile("" : "+v"(tid_l)); const int tid = tid_l, wid = __builtin_amdgcn_readfirstlane(tid >> 6), lane = tid & 63, wr = wid >> 2, wc = wid & 3, fr = lane & 15, fq = lane >> 4;
    const int K = g.K, nt = K / BK;
    unsigned voffA[2], voffB[2];
#pragma unroll
    for (int i = 0; i < 2; ++i) { int R, C; stage_rc(tid * 16 + i * 8192, R, C); const int Rb = Epi::PERM ? ((R & ~31) + perm32(R & 31)) : R;
        voffA[i] = (unsigned)(R * K + C) * 2u; voffB[i] = (unsigned)(Rb * K + C) * 2u; }
    const size_t kstep = (size_t)(BK * 2);
    const size_t hstep = (size_t)HALF * K * 2;
    const size_t tstep = 2 * hstep;
    const unsigned ldsw = (unsigned)wid * 1024u;
    const int aoff = lds_byte(wr * 64 + fr, fq * 8), boff = lds_byte(wc * 32 + fr, fq * 8);
#define PG8_SA(b, h) (((b) * 2 + (h)) * HTB)
#define PG8_SB(b, h) ((4 + (b) * 2 + (h)) * HTB)
#define PG8_STAGE(bufoff, gbase, voff) do { _Pragma("unroll") for (int _i = 0; _i < 2; ++_i) \
        __builtin_amdgcn_global_load_lds((const unsigned*)((const char*)(gbase) + (voff)[_i]), (PG8_LAS unsigned*)(lds + (bufoff) + ldsw + _i * 8192), 16, 0, 0); } while (0)
#define PG8_LDA(dst, b, h) do { _Pragma("unroll") for (int m = 0; m < 4; ++m) _Pragma("unroll") for (int k = 0; k < 2; ++k) dst[m][k] = *(const PG8_LAS bf16x8*)(lds + PG8_SA(b, h) + aoff + m * 2048 + k * 1024); } while (0)
#define PG8_LDB(dst, b, h) do { _Pragma("unroll") for (int n = 0; n < 2; ++n) _Pragma("unroll") for (int k = 0; k < 2; ++k) dst[n][k] = *(const PG8_LAS bf16x8*)(lds + PG8_SB(b, h) + boff + n * 2048 + k * 1024); } while (0)
#define PG8_MMA(ai, bj, At, Bt) do { __builtin_amdgcn_s_setprio(1); _Pragma("unroll") for (int m = 0; m < 4; ++m) _Pragma("unroll") for (int n = 0; n < 2; ++n) _Pragma("unroll") for (int k = 0; k < 2; ++k) \
        acc[ai][bj][m][n] = __builtin_amdgcn_mfma_f32_16x16x32_bf16(Bt[n][k], At[m][k], acc[ai][bj][m][n], 0, 0, 0); __builtin_amdgcn_s_setprio(0); } while (0)
#define PG8_WAIT_V(n) asm volatile("s_waitcnt vmcnt(" #n ")" ::: "memory")
#define PG8_WAIT_L(n) asm volatile("s_waitcnt lgkmcnt(" #n ")" ::: "memory")
#define PG8_BAR __builtin_amdgcn_s_barrier()
#define PG8_SCHED __builtin_amdgcn_sched_barrier(0)
    Unit cur, nxt; int ui = 0;
    if (!S.next(0, cur)) return;
    f32x4 acc[2][2][4][2];
#pragma unroll
    for (int a = 0; a < 2; ++a)
#pragma unroll
        for (int b = 0; b < 2; ++b)
#pragma unroll
            for (int m = 0; m < 4; ++m)
#pragma unroll
                for (int n = 0; n < 2; ++n) acc[a][b][m][n] = (f32x4){0.f, 0.f, 0.f, 0.f};
    bf16x8 At[4][2], B0[2][2], B1[2][2];
    const char* cA = (const char*)g.A + (size_t)cur.pm * tstep; const char* cB = (const char*)g.Bt + (size_t)cur.pn * tstep;
    S.a_ready(cur);
    if constexpr (SP2) {
        PG8_STAGE(PG8_SB(0, 0), cB, voffB); PG8_STAGE(PG8_SB(0, 1), cB + hstep, voffB); PG8_STAGE(PG8_SA(0, 0), cA, voffA); PG8_STAGE(PG8_SA(0, 1), cA + hstep, voffA);
        if (wr == 1) PG8_BAR;
        PG8_WAIT_V(2); PG8_BAR;
        PG8_STAGE(PG8_SB(1, 0), cB + kstep, voffB); PG8_STAGE(PG8_SA(1, 0), cA + kstep, voffA); PG8_STAGE(PG8_SB(1, 1), cB + hstep + kstep, voffB);
        PG8_WAIT_V(6); PG8_BAR;
    } else {
        PG8_STAGE(PG8_SB(0, 0), cB, voffB); PG8_STAGE(PG8_SA(0, 0), cA, voffA); PG8_STAGE(PG8_SB(0, 1), cB + hstep, voffB); PG8_STAGE(PG8_SA(0, 1), cA + hstep, voffA);
        if (wr == 1) PG8_BAR;
        PG8_WAIT_V(4); PG8_BAR;
        PG8_STAGE(PG8_SB(1, 0), cB + kstep, voffB); PG8_STAGE(PG8_SA(1, 0), cA + kstep, voffA); PG8_STAGE(PG8_SB(1, 1), cB + hstep + kstep, voffB);
        PG8_WAIT_V(6); PG8_BAR;
    }
    for (;;) {
        const bool has_next = S.next(ui + 1, nxt);
        const char* nA = has_next ? (const char*)g.A + (size_t)nxt.pm * tstep : cA; const char* nB = has_next ? (const char*)g.Bt + (size_t)nxt.pn * tstep : cB;
        for (int t = 0; t < nt; t += 2) {
            const bool last = (t == nt - 2);
            const char* a1 = cA + (size_t)(t + 1) * kstep;
            const char* a2 = last ? nA : cA + (size_t)(t + 2) * kstep; const char* b2 = last ? nB : cB + (size_t)(t + 2) * kstep;
            const char* a3 = a2 + kstep; const char* b3 = b2 + kstep;
            if (last && has_next) S.a_ready(nxt);
            if constexpr (SP2) {
            PG8_LDB(B0, 0, 0); PG8_LDB(B1, 0, 1); PG8_SCHED; PG8_LDA(At, 0, 0); PG8_STAGE(PG8_SA(1, 1), a1 + hstep, voffA);
            PG8_WAIT_V(8); PG8_WAIT_L(0); PG8_BAR; PG8_MMA(0, 0, At, B0); PG8_MMA(0, 1, At, B1); PG8_BAR; PG8_SCHED;
            PG8_LDA(At, 0, 1); PG8_STAGE(PG8_SB(0, 0), b2, voffB); PG8_STAGE(PG8_SB(0, 1), b2 + hstep, voffB); PG8_STAGE(PG8_SA(0, 0), a2, voffA);
            PG8_WAIT_V(8); PG8_WAIT_L(0); PG8_BAR; PG8_MMA(1, 0, At, B0); PG8_MMA(1, 1, At, B1); PG8_BAR; PG8_SCHED;
            PG8_LDB(B0, 1, 0); PG8_LDB(B1, 1, 1); PG8_SCHED; PG8_LDA(At, 1, 0); PG8_STAGE(PG8_SA(0, 1), a2 + hstep, voffA);
            PG8_WAIT_V(8); PG8_WAIT_L(0); PG8_BAR; PG8_MMA(0, 0, At, B0); PG8_MMA(0, 1, At, B1); PG8_BAR; PG8_SCHED;
            PG8_LDA(At, 1, 1); PG8_STAGE(PG8_SB(1, 0), b3, voffB); PG8_STAGE(PG8_SB(1, 1), b3 + hstep, voffB); PG8_STAGE(PG8_SA(1, 0), a3, voffA);
            PG8_WAIT_V(8); PG8_WAIT_L(0); PG8_BAR; PG8_MMA(1, 0, At, B0); PG8_MMA(1, 1, At, B1); PG8_BAR; PG8_SCHED;
            } else {
            PG8_LDB(B0, 0, 0); PG8_SCHED; PG8_LDA(At, 0, 0); PG8_STAGE(PG8_SA(1, 1), a1 + hstep, voffA);
            PG8_WAIT_L(8); PG8_BAR; PG8_WAIT_L(0); PG8_MMA(0, 0, At, B0); PG8_BAR; PG8_SCHED;
            PG8_LDB(B1, 0, 1); PG8_STAGE(PG8_SB(0, 0), b2, voffB);
            PG8_BAR; PG8_WAIT_L(0); PG8_MMA(0, 1, At, B1); PG8_BAR;
            PG8_LDA(At, 0, 1); PG8_STAGE(PG8_SA(0, 0), a2, voffA);
            PG8_BAR; PG8_WAIT_L(0); PG8_MMA(1, 0, At, B0); PG8_BAR; PG8_SCHED;
            PG8_STAGE(PG8_SB(0, 1), b2 + hstep, voffB);
            PG8_WAIT_V(6); PG8_BAR; PG8_MMA(1, 1, At, B1); PG8_BAR;
            PG8_LDB(B0, 1, 0); PG8_SCHED; PG8_LDA(At, 1, 0); PG8_STAGE(PG8_SA(0, 1), a2 + hstep, voffA);
            PG8_WAIT_L(8); PG8_BAR; PG8_WAIT_L(0); PG8_MMA(0, 0, At, B0); PG8_BAR; PG8_SCHED;
            PG8_LDB(B1, 1, 1); PG8_STAGE(PG8_SB(1, 0), b3, voffB);
            PG8_BAR; PG8_WAIT_L(0); PG8_MMA(0, 1, At, B1); PG8_BAR;
            PG8_LDA(At, 1, 1); PG8_STAGE(PG8_SA(1, 0), a3, voffA);
            PG8_BAR; PG8_WAIT_L(0); PG8_MMA(1, 0, At, B0); PG8_BAR; PG8_SCHED;
            PG8_STAGE(PG8_SB(1, 1), b3 + hstep, voffB);
            PG8_WAIT_V(6); PG8_BAR; PG8_MMA(1, 1, At, B1); PG8_BAR;
            }
        }
        if constexpr (ALIGN_EPI) { if (wr == 0) PG8_BAR; }
        if constexpr (!Epi::AFTER_DRAIN) { E(acc, cur, wr, wc, fr, fq); S.done(cur); }
        if (!has_next) break;
#pragma unroll
        for (int a = 0; a < 2; ++a)
#pragma unroll
            for (int b = 0; b < 2; ++b)
#pragma unroll
                for (int m = 0; m < 4; ++m)
#pragma unroll
                    for (int n = 0; n < 2; ++n) acc[a][b][m][n] = (f32x4){0.f, 0.f, 0.f, 0.f};
        cur = nxt; cA = nA; cB = nB; ++ui;
        if constexpr (ALIGN_EPI) { if (wr == 1) PG8_BAR; }
    }
    PG8_WAIT_V(0);
    if constexpr (!ALIGN_EPI) { if (wr == 0) PG8_BAR; }
    PG8_BAR;
    if constexpr (Epi::AFTER_DRAIN) { E.fused(acc, cur, wr, wc, fr, fq, lds, wid, lane); S.done(cur); }
#undef PG8_SA
#undef PG8_SB
#undef PG8_STAGE
#undef PG8_LDA
#undef PG8_LDB
#undef PG8_MMA
#undef PG8_WAIT_V
#undef PG8_WAIT_L
#undef PG8_BAR
#undef PG8_SCHED
}
}

#ifndef MIX_STAGE
#define MIX_STAGE 3
#endif
using pg8::bf16_t; using pg8::bf16x8; using pg8::f32x4; using pg8::u32x4; using pg8::f32x2;
#define LAS __attribute__((address_space(3)))
typedef float f32x16 __attribute__((ext_vector_type(16)));
typedef unsigned u32x2 __attribute__((ext_vector_type(2)));
typedef __bf16 bf16x2_t __attribute__((ext_vector_type(2)));

constexpr int NB = 2, S = 16384, T = NB * S, DM = 1024, NIN = 2816, INW = 2824, FF = 4096;
constexpr int C_MQ = 0, C_MK = 384, C_MV = 768, C_SQ = 1152, C_SK = 1536, C_SV = 1664, C_XQK = 1792, C_XV = 2304, C_XO = 2560;
constexpr float EPS = 1e-6f;
constexpr float LOG2E = 1.4426950408889634f;
constexpr float QSCALE = 0.125f * LOG2E;
constexpr int NTHR = 512;

constexpr size_t MiB = 1ull << 20;
constexpr size_t WS_WIN = 1 * MiB, WIN_L = (size_t)NIN * DM * 2;
constexpr size_t WS_WOUT = 12 * MiB, WOUT_L = (size_t)DM * DM * 2;
constexpr size_t WS_WUP = 16 * MiB, WUP_L = (size_t)FF * DM * 2;
constexpr size_t WS_WDN = 32 * MiB, WDN_L = (size_t)DM * FF * 2;
constexpr size_t WS_WG = 48 * MiB;
constexpr size_t WS_COS = 49 * MiB, WS_SIN = 51 * MiB;
constexpr size_t WS_SSQ = 53 * MiB;
constexpr size_t WS_GATES = 55 * MiB;
constexpr size_t WS_KMEAN = 56 * MiB;
constexpr size_t WS_SEL = 57 * MiB;
constexpr size_t WS_MISC = 58 * MiB;
constexpr size_t WS_PML = 59 * MiB;
constexpr size_t WS_XB = 64 * MiB;
constexpr size_t WS_DC = 64 * MiB;
constexpr size_t WS_CST = 97 * MiB;
constexpr size_t WS_LQK = 128 * MiB;
constexpr size_t WS_YCAT = 160 * MiB;
constexpr size_t WS_PROJ = 224 * MiB;
constexpr size_t WS_PARTO = 400 * MiB;
constexpr size_t WS_H = 224 * MiB;
constexpr size_t WS_END = 480 * MiB;
static_assert(WS_WIN + 2 * WIN_L <= WS_WOUT && WS_DC + (size_t)2048 * 4160 * 4 <= WS_CST && WS_CST + (size_t)2049 * 4160 * 2 <= WS_LQK, "ws map");
static_assert(WS_PROJ + (size_t)T * NIN * 2 <= WS_PARTO && WS_PARTO + (size_t)12 * S * 3 * 64 * 2 <= WS_END && WS_H + (size_t)T * FF * 2 <= WS_END, "ws map 2");

constexpr int LDS_BYTES = 147456;

struct Params {
    const float* x; const float* ln1; const float* w_in; const float* conv_w; const float* conv_b; const float* igate_b; const float* fgate_b;
    const float* mlstm_norm; const float* moba_q_norm; const float* moba_k_norm; const float* swa_q_norm; const float* swa_k_norm; const float* swa_sinks;
    const float* w_out; const float* ln2; const float* w_up; const float* w_down;
    float* out; unsigned char* ws; int ph_lo, ph_hi;
};

__device__ __forceinline__ float wave_sum(float v) {
#pragma unroll
    for (int o = 1; o < 64; o <<= 1) v += __shfl_xor(v, o);
    return v;
}
__device__ __forceinline__ float wave_max(float v) {
#pragma unroll
    for (int o = 1; o < 64; o <<= 1) v = fmaxf(v, __shfl_xor(v, o));
    return v;
}
__device__ __forceinline__ unsigned pk2(float lo, float hi) { f32x2 v = {lo, hi}; bf16x2_t b = __builtin_convertvector(v, bf16x2_t); return __builtin_bit_cast(unsigned, b); }
__device__ __forceinline__ float bflo(unsigned w) { return __uint_as_float(w << 16); }
__device__ __forceinline__ float bfhi(unsigned w) { return __uint_as_float(w & 0xffff0000u); }
__device__ __forceinline__ void unpack8(const u32x4 w, float (&v)[8]) {
    v[0] = bflo(w.x); v[1] = bfhi(w.x); v[2] = bflo(w.y); v[3] = bfhi(w.y); v[4] = bflo(w.z); v[5] = bfhi(w.z); v[6] = bflo(w.w); v[7] = bfhi(w.w);
}
__device__ __forceinline__ u32x4 pack8(const float (&v)[8]) { u32x4 w; w.x = pk2(v[0], v[1]); w.y = pk2(v[2], v[3]); w.z = pk2(v[4], v[5]); w.w = pk2(v[6], v[7]); return w; }
#define LDS_WAIT() asm volatile("s_waitcnt lgkmcnt(0)" ::: "memory")
__device__ __forceinline__ float exp2_fast(float v) { return __builtin_amdgcn_exp2f(v); }

__device__ __forceinline__ float row_rstd(const float* ssq, int row, int fq) {
    const f32x4 p = *(const f32x4*)(ssq + (size_t)row * 16 + 4 * fq);
    float s = (p[0] + p[1]) + (p[2] + p[3]); s += __shfl_xor(s, 16); s += __shfl_xor(s, 32);
    return rsqrtf(s * (1.0f / 1024.0f) + EPS);
}
template <int ACT  > struct EpiScaled {
    static constexpr bool PERM = true, AFTER_DRAIN = false;
    bf16_t* O; int ldc; const float* ssq;
    __device__ __forceinline__ void operator()(const f32x4 (&acc)[2][2][4][2], const pg8::Unit& u, int wr, int wc, int fr, int fq) const {
        const int row0 = u.pm * pg8::BM + wr * 64 + fr, col0 = u.pn * pg8::BM + wc * 32 + 8 * fq;
#pragma unroll
        for (int ai = 0; ai < 2; ++ai)
#pragma unroll
            for (int m = 0; m < 4; ++m) {
                const int row = row0 + ai * pg8::HALF + m * 16;
                const float rs = row_rstd(ssq, row, fq);
                bf16_t* rowp = O + (size_t)row * ldc + col0;
#pragma unroll
                for (int bj = 0; bj < 2; ++bj) {
                    f32x4 v0 = acc[ai][bj][m][0] * rs, v1 = acc[ai][bj][m][1] * rs;
                    if (ACT == 1) {
#pragma unroll
                        for (int i = 0; i < 4; ++i) { const float a = fmaxf(v0[i], 0.f), b = fmaxf(v1[i], 0.f); v0[i] = a * a; v1[i] = b * b; }
                    }
                    u32x4 w; w.x = pk2(v0[0], v0[1]); w.y = pk2(v0[2], v0[3]); w.z = pk2(v1[0], v1[1]); w.w = pk2(v1[2], v1[3]);
                    *(u32x4*)(rowp + bj * pg8::HALF) = w;
                }
            }
    }
};
struct EpiRes {
    static constexpr bool PERM = true, AFTER_DRAIN = false;
    const float* res; float* out; bf16_t* xb; float* ssq;
    __device__ __forceinline__ void operator()(const f32x4 (&acc)[2][2][4][2], const pg8::Unit& u, int wr, int wc, int fr, int fq) const {
        const int row0 = u.pm * pg8::BM + wr * 64 + fr, col0 = u.pn * pg8::BM + wc * 32 + 8 * fq;
#pragma unroll
        for (int ai = 0; ai < 2; ++ai)
#pragma unroll
            for (int m = 0; m < 4; ++m) {
                const int row = row0 + ai * pg8::HALF + m * 16;
                const size_t off = (size_t)row * DM + col0;
                float part = 0.f;
#pragma unroll
                for (int bj = 0; bj < 2; ++bj) {
                    const f32x4 r0 = *(const f32x4*)(res + off + bj * pg8::HALF), r1 = *(const f32x4*)(res + off + bj * pg8::HALF + 4);
                    const f32x4 v0 = acc[ai][bj][m][0] + r0, v1 = acc[ai][bj][m][1] + r1;
                    *(f32x4*)(out + off + bj * pg8::HALF) = v0; *(f32x4*)(out + off + bj * pg8::HALF + 4) = v1;
                    if (xb) { u32x4 w; w.x = pk2(v0[0], v0[1]); w.y = pk2(v0[2], v0[3]); w.z = pk2(v1[0], v1[1]); w.w = pk2(v1[2], v1[3]); *(u32x4*)(xb + off + bj * pg8::HALF) = w; }
                    part += (v0[0] * v0[0] + v0[1] * v0[1]) + (v0[2] * v0[2] + v0[3] * v0[3]) + (v1[0] * v1[0] + v1[1] * v1[1]) + (v1[2] * v1[2] + v1[3] * v1[3]);
                }
                part += __shfl_xor(part, 16); part += __shfl_xor(part, 32);
                if (ssq && fq == 0) ssq[(size_t)row * 16 + u.pn * 4 + wc] = part;
            }
    }
};
template <class Epi> __device__ __forceinline__ void run_gemm(LAS unsigned char* lds, const bf16_t* A, const bf16_t* Bt, int M, int N, int K, const Epi& E, int bid) {
    pg8::Gemm g{A, Bt, M, N, K}; pg8::StaticOrder so; so.init(M, N, (int)gridDim.x, bid);
    pg8::gemm_phase<Epi, pg8::StaticOrder, true, true>(lds, g, so, E);
}

__device__ __forceinline__ void transpose_item(const float* W, int K, int ld, int nblk, const float* scale, bf16_t* WT, LAS float* scr, int item, int lane) {
    const int kb = item / nblk, nb = item % nblk, k0 = 64 * kb, n0 = 32 * nb;
#pragma unroll 8
    for (int i = 0; i < 32; ++i) {
        const int kk = 2 * i + (lane >> 5); float v = W[(size_t)(k0 + kk) * ld + n0 + (lane & 31)];
        if (scale) v *= scale[k0 + kk];
        scr[kk * 33 + (lane & 31)] = v;
    }
    LDS_WAIT();
    const int c = lane & 7;
#pragma unroll
    for (int j = 0; j < 4; ++j) {
        const int n = (lane >> 3) + 8 * j; const LAS float* s = scr + (8 * c) * 33 + n;
        u32x4 o; o.x = pk2(s[0 * 33], s[1 * 33]); o.y = pk2(s[2 * 33], s[3 * 33]); o.z = pk2(s[4 * 33], s[5 * 33]); o.w = pk2(s[6 * 33], s[7 * 33]);
        *(u32x4*)(WT + (size_t)(n0 + n) * K + k0 + 8 * c) = o;
    }
    LDS_WAIT();
}
__device__ __forceinline__ void rope_entry(int pos, int i, float& cs, float& sn) {
    const double R = 0.74989420933245582730;
    double inv = 1.0; { double b = R; int e = i; while (e) { if (e & 1) inv *= b; b *= b; e >>= 1; } }
    const double ang = (double)pos * inv;
    const double n = __builtin_rint(ang * 0.63661977236758134308);
    double y = __builtin_fma(-n, 1.57079632679489655800, ang); y = __builtin_fma(-n, 6.12323399573676603587e-17, y);
    const double y2 = y * y;
    double sp = -1.0 / 1307674368000.0; sp = sp * y2 + 1.0 / 6227020800.0; sp = sp * y2 - 1.0 / 39916800.0; sp = sp * y2 + 1.0 / 362880.0; sp = sp * y2 - 1.0 / 5040.0;
    sp = sp * y2 + 1.0 / 120.0; sp = sp * y2 - 1.0 / 6.0; sp = sp * y2 + 1.0; const double sy = sp * y;
    double cp = 1.0 / 20922789888000.0; cp = cp * y2 - 1.0 / 87178291200.0; cp = cp * y2 + 1.0 / 479001600.0; cp = cp * y2 - 1.0 / 3628800.0; cp = cp * y2 + 1.0 / 40320.0;
    cp = cp * y2 - 1.0 / 720.0; cp = cp * y2 + 1.0 / 24.0; cp = cp * y2 - 0.5; const double cy = cp * y2 + 1.0;
    const int q = (int)((long long)n & 3);
    const double s_ = (q == 0) ? sy : (q == 1) ? cy : (q == 2) ? -sy : -cy;
    const double c_ = (q == 0) ? cy : (q == 1) ? -sy : (q == 2) ? -cy : sy;
    cs = (float)c_; sn = (float)s_;
}
__device__ __forceinline__ void prologue(const Params& p, LAS unsigned char* lds, int tid, int wave, int lane) {
    unsigned char* ws = p.ws;
    const int G = (int)gridDim.x, gw = (int)blockIdx.x * 8 + wave, NGW = G * 8;
    LAS float* scr = (LAS float*)(lds + wave * 8704);
    constexpr int I_IN = 16 * 88, I_OUT = 16 * 32, I_UP = 16 * 128, I_DN = 64 * 32, I_L = I_IN + I_OUT + I_UP + I_DN;
    for (int it = gw; it < 2 * I_L; it += NGW) {
        const int l = it / I_L; int r = it % I_L;
        if (r < I_IN) { transpose_item(p.w_in + (size_t)l * DM * INW, DM, INW, 88, p.ln1 + l * DM, (bf16_t*)(ws + WS_WIN + l * WIN_L), scr, r, lane); continue; } r -= I_IN;
        if (r < I_OUT) { transpose_item(p.w_out + (size_t)l * DM * DM, DM, DM, 32, nullptr, (bf16_t*)(ws + WS_WOUT + l * WOUT_L), scr, r, lane); continue; } r -= I_OUT;
        if (r < I_UP) { transpose_item(p.w_up + (size_t)l * DM * FF, DM, FF, 128, p.ln2 + l * DM, (bf16_t*)(ws + WS_WUP + l * WUP_L), scr, r, lane); continue; } r -= I_UP;
        transpose_item(p.w_down + (size_t)l * FF * DM, FF, DM, 32, nullptr, (bf16_t*)(ws + WS_WDN + l * WDN_L), scr, r, lane);
    }
    { float* WG = (float*)(ws + WS_WG);
      for (int e = (int)blockIdx.x * NTHR + tid; e < 2 * 8 * DM; e += G * NTHR) { const int l = e >> 13, c = (e >> 10) & 7, k = e & 1023; WG[e] = p.ln1[l * DM + k] * p.w_in[((size_t)l * DM + k) * INW + NIN + c]; } }
    { float* COS = (float*)(ws + WS_COS); float* SIN = (float*)(ws + WS_SIN);
      for (int e = (int)blockIdx.x * NTHR + tid; e < S * 32; e += G * NTHR) { float c, s; rope_entry(e >> 5, e & 31, c, s); COS[e] = c; SIN[e] = s; } }
    { bf16_t* XB = (bf16_t*)(ws + WS_XB); float* SSQ = (float*)(ws + WS_SSQ);
      for (int m = gw; m < T; m += NGW) {
          const f32x4* xr = (const f32x4*)(p.x + (size_t)m * DM) + lane; f32x4 v[4]; float s = 0.f;
#pragma unroll
          for (int j = 0; j < 4; ++j) { v[j] = xr[64 * j]; s += (v[j][0] * v[j][0] + v[j][1] * v[j][1]) + (v[j][2] * v[j][2] + v[j][3] * v[j][3]); }
          s = wave_sum(s);
          u32x2* o8 = (u32x2*)(XB + (size_t)m * DM) + lane;
#pragma unroll
          for (int j = 0; j < 4; ++j) { u32x2 w; w.x = pk2(v[j][0], v[j][1]); w.y = pk2(v[j][2], v[j][3]); o8[64 * j] = w; }
          if (lane < 16) SSQ[(size_t)m * 16 + lane] = (lane == 0) ? s : 0.f;
      } }
}

__device__ __forceinline__ void prep_unit(const Params& p, int layer, int u, LAS unsigned char* lds, int tid, int wave, int lane) {
    unsigned char* ws = p.ws;
    const int blk = u / 30, job = u % 30;
    const int row0 = blk * 256, b = blk >> 6, pos0 = (blk & 63) * 256;
    bf16_t* PROJ = (bf16_t*)(ws + WS_PROJ);
    const int c = lane & 7, tl = lane >> 3;
    if (job < 20) {
        int col; const float* gw; float scale; bool iskm = false; int kh = 0;
        if (job < 6) { col = C_MQ + 64 * job; gw = p.moba_q_norm + layer * 64; scale = QSCALE; }
        else if (job < 12) { kh = job - 6; col = C_MK + 64 * kh; gw = p.moba_k_norm + layer * 64; scale = 1.f; iskm = true; }
        else if (job < 18) { col = C_SQ + 64 * (job - 12); gw = p.swa_q_norm + layer * 64; scale = QSCALE; }
        else { col = C_SK + 64 * (job - 18); gw = p.swa_k_norm + layer * 64; scale = 1.f; }
        float gv[8]; { const f32x4 g0 = *(const f32x4*)(gw + 8 * c), g1 = *(const f32x4*)(gw + 8 * c + 4); gv[0] = g0[0]; gv[1] = g0[1]; gv[2] = g0[2]; gv[3] = g0[3]; gv[4] = g1[0]; gv[5] = g1[1]; gv[6] = g1[2]; gv[7] = g1[3]; }
        float ks[8];
#pragma unroll
        for (int e = 0; e < 8; ++e) ks[e] = 0.f;
        const float* COS = (const float*)(ws + WS_COS); const float* SIN = (const float*)(ws + WS_SIN);
#pragma unroll
        for (int it = 0; it < 4; ++it) {
            const int tt = 32 * wave + 8 * it + tl;
            bf16_t* ptr = PROJ + (size_t)(row0 + tt) * NIN + col + 8 * c;
            const u32x4 w = *(const u32x4*)ptr; float v[8]; unpack8(w, v);
            float ss = 0.f;
#pragma unroll
            for (int e = 0; e < 8; ++e) ss += v[e] * v[e];
            ss += __shfl_xor(ss, 1); ss += __shfl_xor(ss, 2); ss += __shfl_xor(ss, 4);
            const float rs = rsqrtf(ss * (1.0f / 64.0f) + EPS);
            const int pos = pos0 + tt;
            const f32x4 c0 = *(const f32x4*)(COS + (size_t)pos * 32 + 8 * (c & 3)), c1 = *(const f32x4*)(COS + (size_t)pos * 32 + 8 * (c & 3) + 4);
            const f32x4 s0 = *(const f32x4*)(SIN + (size_t)pos * 32 + 8 * (c & 3)), s1 = *(const f32x4*)(SIN + (size_t)pos * 32 + 8 * (c & 3) + 4);
            float o[8];
#pragma unroll
            for (int e = 0; e < 8; ++e) {
                const float val = v[e] * rs * gv[e]; const float pr = __shfl_xor(val, 4);
                const float cs = (e < 4) ? c0[e & 3] : c1[e & 3], sn = (e < 4) ? s0[e & 3] : s1[e & 3];
                o[e] = (c < 4) ? (val * cs - pr * sn) : (val * cs + pr * sn);
                ks[e] += o[e];
                o[e] *= scale;
            }
            *(u32x4*)ptr = pack8(o);
        }
        if (iskm) {
#pragma unroll
            for (int e = 0; e < 8; ++e) { ks[e] += __shfl_xor(ks[e], 8); ks[e] += __shfl_xor(ks[e], 16); ks[e] += __shfl_xor(ks[e], 32); }
            LAS float* red = (LAS float*)lds;
            if (tl == 0) {
#pragma unroll
                for (int e = 0; e < 8; ++e) red[wave * 64 + 8 * c + e] = ks[e];
            }
            __syncthreads();
            if (tid < 64) {
                float s = 0.f;
#pragma unroll
                for (int w8 = 0; w8 < 8; ++w8) s += red[w8 * 64 + tid];
                float* KM = (float*)(ws + WS_KMEAN);
                KM[((size_t)((b * 6 + kh) * 64 + (blk & 63))) * 64 + tid] = s * (1.0f / 256.0f);
            }
            __syncthreads();
        }
    } else if (job < 28) {
        const int cj = job - 20, col = C_XQK + 64 * cj; const float osc = (cj >= 4) ? 0.125f : 1.f;
        bf16_t* LQK = (bf16_t*)(ws + WS_LQK);
        float cw[4][8], cb[8];
#pragma unroll
        for (int jj = 0; jj < 4; ++jj) { const float* wp = p.conv_w + ((size_t)layer * 4 + jj) * 512 + 64 * cj + 8 * c; const f32x4 a = *(const f32x4*)wp, bq = *(const f32x4*)(wp + 4);
            cw[jj][0] = a[0]; cw[jj][1] = a[1]; cw[jj][2] = a[2]; cw[jj][3] = a[3]; cw[jj][4] = bq[0]; cw[jj][5] = bq[1]; cw[jj][6] = bq[2]; cw[jj][7] = bq[3]; }
        { const float* bp = p.conv_b + (size_t)layer * 512 + 64 * cj + 8 * c; const f32x4 a = *(const f32x4*)bp, bq = *(const f32x4*)(bp + 4);
          cb[0] = a[0]; cb[1] = a[1]; cb[2] = a[2]; cb[3] = a[3]; cb[4] = bq[0]; cb[5] = bq[1]; cb[6] = bq[2]; cb[7] = bq[3]; }
#pragma unroll
        for (int it = 0; it < 4; ++it) {
            const int tt = 32 * wave + 8 * it + tl, pos = pos0 + tt; const size_t row = (size_t)row0 + tt;
            float acc[8];
#pragma unroll
            for (int e = 0; e < 8; ++e) acc[e] = cb[e];
#pragma unroll
            for (int jj = 0; jj < 4; ++jj) {
                if (pos - 3 + jj >= 0) {
                    const u32x4 w = *(const u32x4*)(PROJ + (row - 3 + jj) * NIN + col + 8 * c); float v[8]; unpack8(w, v);
#pragma unroll
                    for (int e = 0; e < 8; ++e) acc[e] += cw[jj][e] * v[e];
                }
            }
            float o[8];
#pragma unroll
            for (int e = 0; e < 8; ++e) { const float y = acc[e]; o[e] = y / (1.f + __expf(-y)) * osc; }
            *(u32x4*)(LQK + row * 512 + 64 * cj + 8 * c) = pack8(o);
        }
    } else {
        const int gh = job - 28;
        const float* WG = (const float*)(ws + WS_WG) + (size_t)layer * 8 * DM + (size_t)gh * 4 * DM;
        const bf16_t* XB = (const bf16_t*)(ws + WS_XB); const float* SSQ = (const float*)(ws + WS_SSQ); float* GT = (float*)(ws + WS_GATES);
        float wg[4][16];
#pragma unroll
        for (int cc = 0; cc < 4; ++cc)
#pragma unroll
            for (int hf = 0; hf < 2; ++hf) { const float* wp = WG + cc * DM + 512 * hf + 8 * lane; const f32x4 a = *(const f32x4*)wp, bq = *(const f32x4*)(wp + 4);
                wg[cc][8 * hf + 0] = a[0]; wg[cc][8 * hf + 1] = a[1]; wg[cc][8 * hf + 2] = a[2]; wg[cc][8 * hf + 3] = a[3]; wg[cc][8 * hf + 4] = bq[0]; wg[cc][8 * hf + 5] = bq[1]; wg[cc][8 * hf + 6] = bq[2]; wg[cc][8 * hf + 7] = bq[3]; }
        float bias = 0.f; if (lane < 4) bias = (gh == 0) ? p.igate_b[layer * 4 + lane] : p.fgate_b[layer * 4 + lane];
#pragma unroll 1
        for (int rr = 0; rr < 32; ++rr) {
            const size_t row = (size_t)row0 + 32 * wave + rr;
            const u32x4 a0 = *(const u32x4*)(XB + row * DM + 8 * lane), a1 = *(const u32x4*)(XB + row * DM + 512 + 8 * lane);
            float xv[16]; { float t0[8], t1[8]; unpack8(a0, t0); unpack8(a1, t1);
#pragma unroll
                for (int e = 0; e < 8; ++e) { xv[e] = t0[e]; xv[8 + e] = t1[e]; } }
            float d[4];
#pragma unroll
            for (int cc = 0; cc < 4; ++cc) { float s = 0.f;
#pragma unroll
                for (int k = 0; k < 16; ++k) s += xv[k] * wg[cc][k];
                d[cc] = wave_sum(s); }
            float sp = SSQ[row * 16 + (lane & 15)]; sp += __shfl_xor(sp, 1); sp += __shfl_xor(sp, 2); sp += __shfl_xor(sp, 4); sp += __shfl_xor(sp, 8);
            const float rs = rsqrtf(sp * (1.0f / 1024.0f) + EPS);
            float dv = d[0]; dv = (lane == 1) ? d[1] : dv; dv = (lane == 2) ? d[2] : dv; dv = (lane == 3) ? d[3] : dv;
            if (lane < 4) GT[row * 8 + 4 * gh + lane] = dv * rs + bias;
        }
    }
}

constexpr int KP = 72, VP = 260;
constexpr int AT_KS = 0, AT_VT = 256 * KP * 2, AT_LIST = AT_VT + 64 * VP * 2, AT_CNT = AT_LIST + 8192;
__device__ __forceinline__ void stage_kv256(LAS unsigned char* lds, const bf16_t* kb, const bf16_t* vb, long row0, long rowmin, int tid) {
#pragma unroll
    for (int i = 0; i < 4; ++i) {
        const int chunk = i * NTHR + tid, row = chunk >> 3, c8 = chunk & 7;
        long gr = row0 + row; gr = gr < rowmin ? rowmin : gr;
        const u32x4 kv = *(const u32x4*)(kb + gr * NIN + 8 * c8);
        const u32x4 vv = *(const u32x4*)(vb + gr * NIN + 8 * c8);
        *(LAS u32x4*)(lds + AT_KS + (row * KP + 8 * c8) * 2) = kv;
        LAS bf16_t* vt = (LAS bf16_t*)(lds + AT_VT) + (8 * c8) * VP + row;
        vt[0 * VP] = (bf16_t)(vv.x & 0xffffu); vt[1 * VP] = (bf16_t)(vv.x >> 16); vt[2 * VP] = (bf16_t)(vv.y & 0xffffu); vt[3 * VP] = (bf16_t)(vv.y >> 16);
        vt[4 * VP] = (bf16_t)(vv.z & 0xffffu); vt[5 * VP] = (bf16_t)(vv.z >> 16); vt[6 * VP] = (bf16_t)(vv.w & 0xffffu); vt[7 * VP] = (bf16_t)(vv.w >> 16);
    }
}
__device__ __forceinline__ void attn_tile(const LAS unsigned char* lds, const bf16x8 (&qf)[4], int kmin, int kmax, int r32, int hi, f32x16 (&o)[2], float& mrow, float& lrow) {
    const LAS unsigned char* kbase = lds + AT_KS + (r32 * KP + 8 * hi) * 2;
    const LAS unsigned char* vbase = lds + AT_VT + (r32 * VP + 4 * hi) * 2;
    const int klo = kmin - 4 * hi, khi = kmax - 4 * hi;
#pragma unroll
    for (int dt = 0; dt < 2; ++dt)
#pragma unroll
        for (int r = 0; r < 16; ++r) o[dt][r] = 0.f;
    float m = -INFINITY, l = 0.f;
#pragma unroll 1
    for (int kt = 0; kt < 8; ++kt) {
        f32x16 s;
#pragma unroll
        for (int r = 0; r < 16; ++r) s[r] = 0.f;
#pragma unroll
        for (int d0 = 0; d0 < 4; ++d0) {
            const bf16x8 kf = *(const LAS bf16x8*)(kbase + (32 * kt * KP + 16 * d0) * 2);
            s = __builtin_amdgcn_mfma_f32_32x32x16_bf16(kf, qf[d0], s, 0, 0, 0);
        }
        float tmx = -INFINITY;
#pragma unroll
        for (int r = 0; r < 16; ++r) {
            const int kv = 32 * kt + (r & 3) + 8 * (r >> 2);
            const float v = (kv >= klo && kv <= khi) ? s[r] : -INFINITY;
            s[r] = v; tmx = fmaxf(tmx, v);
        }
        tmx = fmaxf(tmx, __shfl_xor(tmx, 32));
        const float mn = fmaxf(m, tmx), mu = (mn == -INFINITY) ? 0.f : mn;
        const float sc = exp2_fast(m - mu);
        float sum = 0.f;
#pragma unroll
        for (int r = 0; r < 16; ++r) { const float pv = exp2_fast(s[r] - mu); s[r] = pv; sum += pv; }
        sum += __shfl_xor(sum, 32);
        l = l * sc + sum; m = mn;
#pragma unroll
        for (int dt = 0; dt < 2; ++dt)
#pragma unroll
            for (int r = 0; r < 16; ++r) o[dt][r] *= sc;
#pragma unroll
        for (int j = 0; j < 2; ++j) {
            u32x4 pw; pw.x = pk2(s[8 * j + 0], s[8 * j + 1]); pw.y = pk2(s[8 * j + 2], s[8 * j + 3]); pw.z = pk2(s[8 * j + 4], s[8 * j + 5]); pw.w = pk2(s[8 * j + 6], s[8 * j + 7]);
            const bf16x8 pb = __builtin_bit_cast(bf16x8, pw);
#pragma unroll
            for (int dt = 0; dt < 2; ++dt) {
                const LAS unsigned char* vp = vbase + (32 * dt * VP + 32 * kt + 16 * j) * 2;
                const u32x2 lo = *(const LAS u32x2*)vp, hi2 = *(const LAS u32x2*)(vp + 16);
                u32x4 vw; vw.x = lo.x; vw.y = lo.y; vw.z = hi2.x; vw.w = hi2.y;
                o[dt] = __builtin_amdgcn_mfma_f32_32x32x16_bf16(__builtin_bit_cast(bf16x8, vw), pb, o[dt], 0, 0, 0);
            }
        }
    }
    mrow = m; lrow = l;
}
__device__ __forceinline__ void store_orow_bf16(bf16_t* dst, const f32x16 (&o)[2], float sc, int hi) {
#pragma unroll
    for (int dt = 0; dt < 2; ++dt)
#pragma unroll
        for (int g = 0; g < 4; ++g) { u32x2 w; w.x = pk2(o[dt][4 * g] * sc, o[dt][4 * g + 1] * sc); w.y = pk2(o[dt][4 * g + 2] * sc, o[dt][4 * g + 3] * sc); *(u32x2*)(dst + 32 * dt + 8 * g + 4 * hi) = w; }
}
__device__ __forceinline__ void load_qf(bf16x8 (&qf)[4], const bf16_t* qrow, int hi) {
#pragma unroll
    for (int d0 = 0; d0 < 4; ++d0) qf[d0] = *(const bf16x8*)(qrow + 16 * d0 + 8 * hi);
}

__device__ __forceinline__ void swa_unit(const Params& p, int layer, int u, LAS unsigned char* lds, int tid, int wave, int lane) {
    const int kh = u & 1, n = (u >> 1) & 127, b = u >> 8;
    const bf16_t* PROJ = (const bf16_t*)(p.ws + WS_PROJ); bf16_t* YC = (bf16_t*)(p.ws + WS_YCAT);
    const long rowb = (long)b * S;
    stage_kv256(lds, PROJ + C_SK + 64 * kh, PROJ + C_SV + 64 * kh, rowb + 128 * (n - 1), rowb, tid);
    __syncthreads();
    const int r32 = lane & 31, hi = lane >> 5;
    for (int tl = wave; tl < 12; tl += 8) {
        const int qh = 3 * kh + (tl >> 2), rt = tl & 3, qi = 32 * rt + r32; const long row = rowb + 128 * n + qi;
        bf16x8 qf[4]; load_qf(qf, PROJ + row * NIN + C_SQ + 64 * qh, hi);
        int kmin = qi + 1; if (n == 0 && kmin < 128) kmin = 128;
        f32x16 o[2]; float m, l; attn_tile(lds, qf, kmin, qi + 128, r32, hi, o, m, l);
        l += exp2_fast(p.swa_sinks[layer * 6 + qh] * LOG2E - m);
        store_orow_bf16(YC + row * DM + 640 + 64 * qh, o, 1.0f / l, hi);
    }
    __syncthreads();
}

__device__ __forceinline__ void sel_wave_unit(const Params& p, int wu, int lane) {
    const int bh = wu >> 8, i = wu & 255, b = bh / 6, h = bh % 6, t0 = i * 64, blk = t0 >> 8;
    unsigned sel = 0xFFFFFFu;
    if (blk > 0) {
        const bf16_t* qp = (const bf16_t*)(p.ws + WS_PROJ) + ((size_t)b * S + t0 + lane) * NIN + C_MQ + 64 * h;
        float q[64];
#pragma unroll
        for (int c8 = 0; c8 < 8; ++c8) { const u32x4 w = *(const u32x4*)(qp + 8 * c8); float v[8]; unpack8(w, v);
#pragma unroll
            for (int e = 0; e < 8; ++e) q[8 * c8 + e] = v[e]; }
        float v0 = -INFINITY, v1 = -INFINITY, v2 = -INFINITY; unsigned i0 = 255u, i1 = 255u, i2 = 255u;
        const float* km = (const float*)(p.ws + WS_KMEAN) + (size_t)bh * 64 * 64;
        for (int j = 0; j < blk; ++j) {
            const f32x4* kr = (const f32x4*)(km + j * 64); float g0 = 0.f, g1 = 0.f;
#pragma unroll
            for (int d4 = 0; d4 < 16; d4 += 2) { const f32x4 ka = kr[d4], kb = kr[d4 + 1];
                g0 += q[4 * d4] * ka[0] + q[4 * d4 + 1] * ka[1] + q[4 * d4 + 2] * ka[2] + q[4 * d4 + 3] * ka[3];
                g1 += q[4 * d4 + 4] * kb[0] + q[4 * d4 + 5] * kb[1] + q[4 * d4 + 6] * kb[2] + q[4 * d4 + 7] * kb[3]; }
            const float g = g0 + g1; const unsigned ju = (unsigned)j;
            if (g > v0) { v2 = v1; i2 = i1; v1 = v0; i1 = i0; v0 = g; i0 = ju; }
            else if (g > v1) { v2 = v1; i2 = i1; v1 = g; i1 = ju; }
            else if (g > v2) { v2 = g; i2 = ju; }
        }
        sel = i0 | (i1 << 8) | (i2 << 16);
    }
    ((unsigned*)(p.ws + WS_SEL))[(size_t)bh * S + t0 + lane] = sel;
}
__device__ __forceinline__ void moba_sel_unit(const Params& p, int v, LAS unsigned char* lds, int tid, int wave, int lane) {
    const int bh = v % 12, w = v / 12, b = bh / 6, h = bh % 6;
    int j = 0, c = w; for (;;) { const int nc = (63 - j + 7) >> 3; if (c < nc) break; c -= nc; ++j; }
    const int tstart = 256 * (j + 1) + 2048 * c;
    LAS unsigned* list = (LAS unsigned*)(lds + AT_LIST); LAS unsigned* cnt = (LAS unsigned*)(lds + AT_CNT);
    if (tid == 0) *cnt = 0u;
    __syncthreads();
    const unsigned* SEL = (const unsigned*)(p.ws + WS_SEL) + (size_t)bh * S;
#pragma unroll
    for (int i = 0; i < 4; ++i) {
        const int tq = i * NTHR + tid, t = tstart + tq;
        if (t < S) {
            const unsigned sel = SEL[t]; int rk = -1;
            if ((sel & 0xffu) == (unsigned)j) rk = 0; else if (((sel >> 8) & 0xffu) == (unsigned)j) rk = 1; else if (((sel >> 16) & 0xffu) == (unsigned)j) rk = 2;
            if (rk >= 0) { const unsigned pos = __hip_atomic_fetch_add(cnt, 1u, __ATOMIC_RELAXED, __HIP_MEMORY_SCOPE_WORKGROUP); list[pos] = (unsigned)tq | ((unsigned)rk << 12); }
        }
    }
    __syncthreads();
    const int n = (int)*cnt;
    if (n > 0) {
        const bf16_t* PROJ = (const bf16_t*)(p.ws + WS_PROJ);
        stage_kv256(lds, PROJ + C_MK + 64 * h, PROJ + C_MV + 64 * h, (long)b * S + 256 * j, 0, tid);
        __syncthreads();
        const int r32 = lane & 31, hi = lane >> 5, ntl = (n + 31) >> 5;
        float* PML = (float*)(p.ws + WS_PML); bf16_t* PO = (bf16_t*)(p.ws + WS_PARTO);
        for (int tl = wave; tl < ntl; tl += 8) {
            const int idx = 32 * tl + r32; const bool valid = idx < n;
            const unsigned e = list[valid ? idx : 0]; const int t = tstart + (int)(e & 0x7ffu), rk = (int)(e >> 12);
            const long row = (long)b * S + t;
            bf16x8 qf[4]; load_qf(qf, PROJ + row * NIN + C_MQ + 64 * h, hi);
            f32x16 o[2]; float m, l; attn_tile(lds, qf, 0, 255, r32, hi, o, m, l);
            if (valid) {
                const size_t base = ((size_t)bh * S + t) * 3 + rk;
                if (hi == 0) { PML[base * 2] = m; PML[base * 2 + 1] = l; }
                store_orow_bf16(PO + base * 64, o, 1.0f, hi);
            }
        }
    }
    __syncthreads();
}
__device__ __forceinline__ void moba_own_unit(const Params& p, int u, LAS unsigned char* lds, int tid, int wave, int lane) {
    const int bh = u % 12, blk = u / 12, b = bh / 6, h = bh % 6;
    const bf16_t* PROJ = (const bf16_t*)(p.ws + WS_PROJ); bf16_t* YC = (bf16_t*)(p.ws + WS_YCAT);
    stage_kv256(lds, PROJ + C_MK + 64 * h, PROJ + C_MV + 64 * h, (long)b * S + 256 * blk, 0, tid);
    __syncthreads();
    const int r32 = lane & 31, hi = lane >> 5, qi = 32 * wave + r32, t = 256 * blk + qi; const long row = (long)b * S + t;
    bf16x8 qf[4]; load_qf(qf, PROJ + row * NIN + C_MQ + 64 * h, hi);
    f32x16 o[2]; float m, l; attn_tile(lds, qf, 0, qi, r32, hi, o, m, l);
    const int nv = blk < 3 ? blk : 3;
    const float* PML = (const float*)(p.ws + WS_PML); const bf16_t* PO = (const bf16_t*)(p.ws + WS_PARTO);
    const size_t base = ((size_t)bh * S + t) * 3;
    float mr[3], lr[3]; float M = m;
#pragma unroll
    for (int r = 0; r < 3; ++r) { mr[r] = -INFINITY; lr[r] = 0.f; if (r < nv) { const f32x2 ml = *(const f32x2*)(PML + (base + r) * 2); mr[r] = ml[0]; lr[r] = ml[1]; M = fmaxf(M, mr[r]); } }
    const float w0 = exp2_fast(m - M); float L = l * w0;
#pragma unroll
    for (int dt = 0; dt < 2; ++dt)
#pragma unroll
        for (int r = 0; r < 16; ++r) o[dt][r] *= w0;
#pragma unroll
    for (int r = 0; r < 3; ++r) {
        if (r < nv) {
            const float wr_ = exp2_fast(mr[r] - M); L += wr_ * lr[r];
            const bf16_t* src = PO + (base + r) * 64;
#pragma unroll
            for (int dt = 0; dt < 2; ++dt)
#pragma unroll
                for (int g = 0; g < 4; ++g) { const u32x2 wv = *(const u32x2*)(src + 32 * dt + 8 * g + 4 * hi);
                    o[dt][4 * g] += wr_ * bflo(wv.x); o[dt][4 * g + 1] += wr_ * bfhi(wv.x); o[dt][4 * g + 2] += wr_ * bflo(wv.y); o[dt][4 * g + 3] += wr_ * bfhi(wv.y); }
        }
    }
    store_orow_bf16(YC + row * DM + 64 * h, o, 1.0f / L, hi);
    __syncthreads();
}

__device__ __forceinline__ float log_sigmoid(float f) { return fminf(f, 0.f) - log1pf(__expf(-fabsf(f))); }
__device__ __forceinline__ float wave_incl_scan(float v, int lane) {
#pragma unroll
    for (int o = 1; o < 64; o <<= 1) { const float t = __shfl_up(v, o); if (lane >= o) v += t; }
    return v;
}
constexpr int MP = 72;
constexpr int M1_KT = 0, M1_VT = 64 * MP * 2, M1_W = M1_VT + 96 * MP * 2, M1_SUB = M1_W + 256;
__device__ __forceinline__ void m1_quad(const Params& p, int quad, LAS unsigned char* lds, int tid, int wave, int lane) {
    const int sub = wave >> 1, wp = wave & 1, unit = quad * 4 + sub, bh = unit >> 8, c = unit & 255, b = bh >> 2, h = bh & 3;
    const long row0 = (long)b * S + 64 * c;
    LAS unsigned char* L = lds + sub * M1_SUB;
    LAS float* wv = (LAS float*)(L + M1_W);
    const float* GT = (const float*)(p.ws + WS_GATES);
    if (wp == 0) {
        const float ig = GT[(row0 + lane) * 8 + h], fg = GT[(row0 + lane) * 8 + 4 + h];
        const float bs = wave_incl_scan(log_sigmoid(fg), lane);
        const float a = __shfl(bs, 63), g = a - bs + ig, mg = wave_max(g);
        wv[lane] = __expf(g - mg);
        if (lane == 0) { float* MISC = (float*)(p.ws + WS_MISC); MISC[unit] = a; MISC[2048 + unit] = mg; }
    }
    __syncthreads();
    const bf16_t* LQK = (const bf16_t*)(p.ws + WS_LQK); const bf16_t* PROJ = (const bf16_t*)(p.ws + WS_PROJ);
    const int tp = wp * 64 + lane;
#pragma unroll
    for (int i = 0; i < 4; ++i) {
        const int chunk = i * 128 + tp, s = chunk >> 3, c8 = chunk & 7;
        const u32x4 kw = *(const u32x4*)(LQK + (row0 + s) * 512 + 256 + 64 * h + 8 * c8);
        const u32x4 vw = *(const u32x4*)(PROJ + (row0 + s) * NIN + C_XV + 64 * h + 8 * c8);
        float kf[8]; unpack8(kw, kf); const float ws_ = wv[s];
        LAS bf16_t* kt = (LAS bf16_t*)(L + M1_KT) + (8 * c8) * MP + s;
#pragma unroll
        for (int e = 0; e < 8; e += 2) { const unsigned pw = pk2(kf[e] * ws_, kf[e + 1] * ws_); kt[e * MP] = (bf16_t)(pw & 0xffffu); kt[(e + 1) * MP] = (bf16_t)(pw >> 16); }
        LAS bf16_t* vt = (LAS bf16_t*)(L + M1_VT) + (8 * c8) * MP + s;
        vt[0 * MP] = (bf16_t)(vw.x & 0xffffu); vt[1 * MP] = (bf16_t)(vw.x >> 16); vt[2 * MP] = (bf16_t)(vw.y & 0xffffu); vt[3 * MP] = (bf16_t)(vw.y >> 16);
        vt[4 * MP] = (bf16_t)(vw.z & 0xffffu); vt[5 * MP] = (bf16_t)(vw.z >> 16); vt[6 * MP] = (bf16_t)(vw.w & 0xffffu); vt[7 * MP] = (bf16_t)(vw.w >> 16);
    }
#pragma unroll
    for (int i = 0; i < 16; ++i) { const int e = i * 128 + tp, rr = e >> 6, ss = e & 63; ((LAS bf16_t*)(L + M1_VT))[(64 + rr) * MP + ss] = (rr == 0) ? (bf16_t)0x3F80u : (bf16_t)0u; }
    __syncthreads();
    const int r32 = lane & 31, hi = lane >> 5;
    f32x16 acc[3];
#pragma unroll
    for (int et = 0; et < 3; ++et)
#pragma unroll
        for (int r = 0; r < 16; ++r) acc[et][r] = 0.f;
#pragma unroll
    for (int ks = 0; ks < 4; ++ks) {
        const bf16x8 bfr = *(const LAS bf16x8*)(L + M1_KT + ((32 * wp + r32) * MP + 16 * ks + 8 * hi) * 2);
#pragma unroll
        for (int et = 0; et < 3; ++et) {
            const bf16x8 afr = *(const LAS bf16x8*)(L + M1_VT + ((32 * et + r32) * MP + 16 * ks + 8 * hi) * 2);
            acc[et] = __builtin_amdgcn_mfma_f32_32x32x16_bf16(afr, bfr, acc[et], 0, 0, 0);
        }
    }
    float* DC = (float*)(p.ws + WS_DC) + (size_t)unit * 4160;
    const int d = 32 * wp + r32;
#pragma unroll
    for (int et = 0; et < 2; ++et)
#pragma unroll
        for (int r = 0; r < 16; ++r) { const int e = 32 * et + (r & 3) + 8 * (r >> 2) + 4 * hi; DC[e * 64 + d] = acc[et][r]; }
    if (hi == 0) DC[64 * 64 + d] = acc[2][0];
    __syncthreads();
}
__device__ __forceinline__ void scan_unit(const Params& p, int su, int tid) {
    const int e = su * NTHR + tid, bh = e / 4160, idx = e % 4160;
    if (bh >= 8) return;
    const float* MISC = (const float*)(p.ws + WS_MISC); float* MS = (float*)(p.ws + WS_MISC) + 4096;
    const float* DC = (const float*)(p.ws + WS_DC); bf16_t* CST = (bf16_t*)(p.ws + WS_CST);
    float C = 0.f, m = 0.f;
#pragma unroll 8
    for (int c = 0; c < 256; ++c) {
        const int unit = bh * 256 + c;
        CST[(size_t)unit * 4160 + idx] = (bf16_t)(pk2(C, 0.f) & 0xffffu);
        if (idx == 0) MS[unit] = m;
        const float a = MISC[unit], mg = MISC[2048 + unit];
        const float mn = fmaxf(a + m, mg), dec = __expf(a + m - mn), sc = __expf(mg - mn);
        C = dec * C + sc * DC[(size_t)unit * 4160 + idx]; m = mn;
    }
}
constexpr int M3_K = 0, M3_VT = 64 * MP * 2, M3_CS = 2 * 64 * MP * 2, M3_BS = M3_CS + 256, M3_SUB = M3_BS + 256;
__device__ __forceinline__ void m3_quad(const Params& p, int layer, int quad, LAS unsigned char* lds, int tid, int wave, int lane) {
    const int sub = wave >> 1, wp = wave & 1, unit = quad * 4 + sub, bh = unit >> 8, c = unit & 255, b = bh >> 2, h = bh & 3;
    const long row0 = (long)b * S + 64 * c;
    LAS unsigned char* L = lds + sub * M3_SUB;
    LAS float* cs = (LAS float*)(L + M3_CS); LAS float* bsv = (LAS float*)(L + M3_BS);
    const float* GT = (const float*)(p.ws + WS_GATES);
    if (wp == 0) {
        const float ig = GT[(row0 + lane) * 8 + h], fg = GT[(row0 + lane) * 8 + 4 + h];
        const float bs = wave_incl_scan(log_sigmoid(fg), lane);
        cs[lane] = ig - bs; bsv[lane] = bs;
    }
    const bf16_t* LQK = (const bf16_t*)(p.ws + WS_LQK); const bf16_t* PROJ = (const bf16_t*)(p.ws + WS_PROJ);
    const int tp = wp * 64 + lane;
#pragma unroll
    for (int i = 0; i < 4; ++i) {
        const int chunk = i * 128 + tp, s = chunk >> 3, c8 = chunk & 7;
        const u32x4 kw = *(const u32x4*)(LQK + (row0 + s) * 512 + 256 + 64 * h + 8 * c8);
        const u32x4 vw = *(const u32x4*)(PROJ + (row0 + s) * NIN + C_XV + 64 * h + 8 * c8);
        *(LAS u32x4*)(L + M3_K + (s * MP + 8 * c8) * 2) = kw;
        LAS bf16_t* vt = (LAS bf16_t*)(L + M3_VT) + (8 * c8) * MP + s;
        vt[0 * MP] = (bf16_t)(vw.x & 0xffffu); vt[1 * MP] = (bf16_t)(vw.x >> 16); vt[2 * MP] = (bf16_t)(vw.y & 0xffffu); vt[3 * MP] = (bf16_t)(vw.y >> 16);
        vt[4 * MP] = (bf16_t)(vw.z & 0xffffu); vt[5 * MP] = (bf16_t)(vw.z >> 16); vt[6 * MP] = (bf16_t)(vw.w & 0xffffu); vt[7 * MP] = (bf16_t)(vw.w >> 16);
    }
    __syncthreads();
    const int r32 = lane & 31, hi = lane >> 5, t = 32 * wp + r32; const long row = row0 + t;
    bf16x8 qf[4]; load_qf(qf, LQK + row * 512 + 64 * h, hi);
    f32x16 sT[2];
#pragma unroll
    for (int st = 0; st < 2; ++st) {
        f32x16 a;
#pragma unroll
        for (int r = 0; r < 16; ++r) a[r] = 0.f;
#pragma unroll
        for (int d0 = 0; d0 < 4; ++d0) {
            const bf16x8 kf = *(const LAS bf16x8*)(L + M3_K + ((32 * st + r32) * MP + 16 * d0 + 8 * hi) * 2);
            a = __builtin_amdgcn_mfma_f32_32x32x16_bf16(kf, qf[d0], a, 0, 0, 0);
        }
        sT[st] = a;
    }
    const float b_t = bsv[t], m_c = ((const float*)(p.ws + WS_MISC))[4096 + unit], inter = b_t + m_c;
    f32x16 dm[2]; float mx = inter;
#pragma unroll
    for (int st = 0; st < 2; ++st)
#pragma unroll
        for (int g = 0; g < 4; ++g) {
            const f32x4 c4 = *(const LAS f32x4*)(cs + 32 * st + 8 * g + 4 * hi);
#pragma unroll
            for (int e2 = 0; e2 < 4; ++e2) { const int s = 32 * st + 8 * g + 4 * hi + e2; const float dv = (s <= t) ? (b_t + c4[e2]) : -INFINITY; dm[st][4 * g + e2] = dv; mx = fmaxf(mx, dv); }
        }
    mx = fmaxf(mx, __shfl_xor(mx, 32));
    const float w_inter = __expf(inter - mx);
    float den = 0.f;
#pragma unroll
    for (int st = 0; st < 2; ++st)
#pragma unroll
        for (int r = 0; r < 16; ++r) { const float qk = sT[st][r] * __expf(dm[st][r] - mx); sT[st][r] = qk; den += qk; }
    den += __shfl_xor(den, 32);
    f32x16 acc[3];
    const bf16_t* CST = (const bf16_t*)(p.ws + WS_CST) + (size_t)unit * 4160;
#pragma unroll
    for (int et = 0; et < 3; ++et) {
        f32x16 a;
#pragma unroll
        for (int r = 0; r < 16; ++r) a[r] = 0.f;
#pragma unroll
        for (int d0 = 0; d0 < 4; ++d0) {
            const bf16x8 cf = *(const bf16x8*)(CST + (32 * et + r32) * 64 + 16 * d0 + 8 * hi);
            a = __builtin_amdgcn_mfma_f32_32x32x16_bf16(cf, qf[d0], a, 0, 0, 0);
        }
        acc[et] = a;
    }
    const float qn = __shfl(acc[2][0], r32);
#pragma unroll
    for (int et = 0; et < 2; ++et)
#pragma unroll
        for (int r = 0; r < 16; ++r) acc[et][r] *= w_inter;
#pragma unroll
    for (int st = 0; st < 2; ++st)
#pragma unroll
        for (int j = 0; j < 2; ++j) {
            u32x4 pw; pw.x = pk2(sT[st][8 * j + 0], sT[st][8 * j + 1]); pw.y = pk2(sT[st][8 * j + 2], sT[st][8 * j + 3]); pw.z = pk2(sT[st][8 * j + 4], sT[st][8 * j + 5]); pw.w = pk2(sT[st][8 * j + 6], sT[st][8 * j + 7]);
            const bf16x8 pb = __builtin_bit_cast(bf16x8, pw);
#pragma unroll
            for (int et = 0; et < 2; ++et) {
                const LAS unsigned char* vp = L + M3_VT + ((32 * et + r32) * MP + 32 * st + 16 * j + 4 * hi) * 2;
                const u32x2 lo = *(const LAS u32x2*)vp, hi2 = *(const LAS u32x2*)(vp + 16);
                u32x4 vw; vw.x = lo.x; vw.y = lo.y; vw.z = hi2.x; vw.w = hi2.y;
                acc[et] = __builtin_amdgcn_mfma_f32_32x32x16_bf16(__builtin_bit_cast(bf16x8, vw), pb, acc[et], 0, 0, 0);
            }
        }
    const float dtot = w_inter * qn + den, inv = 1.0f / fmaxf(fabsf(dtot), __expf(-mx));
    float ss = 0.f;
#pragma unroll
    for (int et = 0; et < 2; ++et)
#pragma unroll
        for (int g = 0; g < 4; ++g) {
            const u32x2 xw = *(const u32x2*)(PROJ + row * NIN + C_XO + 64 * h + 32 * et + 8 * g + 4 * hi);
            const float xo[4] = {bflo(xw.x), bfhi(xw.x), bflo(xw.y), bfhi(xw.y)};
#pragma unroll
            for (int e2 = 0; e2 < 4; ++e2) { const float hv = acc[et][4 * g + e2] * inv / (1.f + __expf(-xo[e2])); acc[et][4 * g + e2] = hv; ss += hv * hv; }
        }
    ss += __shfl_xor(ss, 32);
    const float rs = rsqrtf(ss * (1.0f / 64.0f) + EPS);
    const float* nw = p.mlstm_norm + (size_t)layer * 256 + 64 * h;
    bf16_t* dst = (bf16_t*)(p.ws + WS_YCAT) + row * DM + 384 + 64 * h;
#pragma unroll
    for (int et = 0; et < 2; ++et)
#pragma unroll
        for (int g = 0; g < 4; ++g) {
            const f32x4 nv = *(const f32x4*)(nw + 32 * et + 8 * g + 4 * hi);
            u32x2 w; w.x = pk2(acc[et][4 * g] * rs * nv[0], acc[et][4 * g + 1] * rs * nv[1]); w.y = pk2(acc[et][4 * g + 2] * rs * nv[2], acc[et][4 * g + 3] * rs * nv[3]);
            *(u32x2*)(dst + 32 * et + 8 * g + 4 * hi) = w;
        }
    __syncthreads();
}

__global__ void __launch_bounds__(NTHR, 2) hybrid_fwd(Params p0) {
    extern __shared__ __attribute__((aligned(16))) unsigned char lds_raw[];
    LAS unsigned char* lds = (LAS unsigned char*)lds_raw;
    cg::grid_group grid = cg::this_grid();
    const int lo = p0.ph_lo, hi = p0.ph_hi;
#define IN(k) (lo <= (k) && (k) < hi)
#define SEAM(k) do { if (IN(k) && IN((k) + 1)) grid.sync(); } while (0)
#define PHASE_VARS() int tid = threadIdx.x; asm volatile("" : "+v"(tid)); const int lane = tid & 63, wave = __builtin_amdgcn_readfirstlane(tid >> 6); \
    int bid = (int)blockIdx.x; asm volatile("" : "+s"(bid)); const int G = (int)gridDim.x; Params p = p0; { unsigned char* w_ = p0.ws; asm volatile("" : "+s"(w_)); p.ws = w_; } unsigned char* ws = p.ws; (void)ws; (void)lane; (void)wave; (void)bid; (void)G
    if (IN(0)) { PHASE_VARS(); prologue(p, lds, tid, wave, lane); }
    SEAM(0);
#pragma unroll 1
    for (int layer = 0; layer < 2; ++layer) {
        const int P = 1 + 8 * layer;
        if (IN(P)) { PHASE_VARS(); EpiScaled<0> E{(bf16_t*)(ws + WS_PROJ), NIN, (const float*)(ws + WS_SSQ)}; run_gemm(lds, (const bf16_t*)(ws + WS_XB), (const bf16_t*)(ws + WS_WIN + layer * WIN_L), T, NIN, DM, E, bid); }
        SEAM(P);
        if (IN(P + 1)) { PHASE_VARS();
            for (int u = bid; u < 128 * 30; u += G) prep_unit(p, layer, u, lds, tid, wave, lane);
#if MIX_STAGE < 3
            { u32x4* y4 = (u32x4*)(ws + WS_YCAT); const u32x4 z = {0u, 0u, 0u, 0u}; for (size_t e = (size_t)bid * NTHR + tid; e < (size_t)T * DM / 8; e += (size_t)G * NTHR) y4[e] = z; }
#endif
        }
        SEAM(P + 1);
        if (IN(P + 2)) { PHASE_VARS();
#if MIX_STAGE >= 1
            for (int q = bid; q < 512; q += G) m1_quad(p, q, lds, tid, wave, lane);
#endif
#if MIX_STAGE >= 3
            for (int wu = bid * 8 + wave; wu < 3072; wu += G * 8) sel_wave_unit(p, wu, lane);
#endif
        }
        SEAM(P + 2);
        if (IN(P + 3)) { PHASE_VARS();
            for (int u = bid; u < 65 + 512 + 3360; u += G) {
                if (u < 65) {
#if MIX_STAGE >= 1
                    scan_unit(p, u, tid);
#endif
                } else if (u < 577) {
#if MIX_STAGE >= 2
                    swa_unit(p, layer, u - 65, lds, tid, wave, lane);
#endif
                } else {
#if MIX_STAGE >= 3
                    moba_sel_unit(p, u - 577, lds, tid, wave, lane);
#endif
                }
            }
        }
        SEAM(P + 3);
        if (IN(P + 4)) { PHASE_VARS();
            for (int u = bid; u < 768 + 512; u += G) {
                if (u < 768) {
#if MIX_STAGE >= 3
                    moba_own_unit(p, u, lds, tid, wave, lane);
#endif
                } else {
#if MIX_STAGE >= 1
                    m3_quad(p, layer, u - 768, lds, tid, wave, lane);
#endif
                }
            }
        }
        SEAM(P + 4);
        if (IN(P + 5)) { PHASE_VARS(); EpiRes E{layer == 0 ? p.x : (const float*)p.out, p.out, (bf16_t*)(ws + WS_XB), (float*)(ws + WS_SSQ)}; run_gemm(lds, (const bf16_t*)(ws + WS_YCAT), (const bf16_t*)(ws + WS_WOUT + layer * WOUT_L), T, DM, DM, E, bid); }
        SEAM(P + 5);
        if (IN(P + 6)) { PHASE_VARS(); EpiScaled<1> E{(bf16_t*)(ws + WS_H), FF, (const float*)(ws + WS_SSQ)}; run_gemm(lds, (const bf16_t*)(ws + WS_XB), (const bf16_t*)(ws + WS_WUP + layer * WUP_L), T, FF, DM, E, bid); }
        SEAM(P + 6);
        if (IN(P + 7)) { PHASE_VARS(); EpiRes E{(const float*)p.out, p.out, layer == 0 ? (bf16_t*)(ws + WS_XB) : nullptr, layer == 0 ? (float*)(ws + WS_SSQ) : nullptr}; run_gemm(lds, (const bf16_t*)(ws + WS_H), (const bf16_t*)(ws + WS_WDN + layer * WDN_L), T, DM, FF, E, bid); }
        SEAM(P + 7);
    }
#undef IN
#undef SEAM
}

#ifndef N_LAUNCH_SPLIT
#define N_LAUNCH_SPLIT 0
#endif
extern "C" void kernel_launch(void* const* d_in, const int* in_sizes, int n_in, void* d_out, int out_size, void* d_ws, size_t ws_size, hipStream_t stream) {
    static int grid = 0;
    if (grid == 0) {
        if (n_in != 17 || in_sizes[0] != T * DM || out_size != T * DM || ws_size < WS_END) { fprintf(stderr, "kernel_launch: unexpected shapes (n_in %d, in0 %d, out %d, ws %zu); nothing launched\n", n_in, n_in > 0 ? in_sizes[0] : -1, out_size, ws_size); grid = -1; return; }
        int dev = 0, cus = 0, per_cu = 0;
        if (hipGetDevice(&dev) != hipSuccess || hipDeviceGetAttribute(&cus, hipDeviceAttributeMultiprocessorCount, dev) != hipSuccess) { grid = -1; return; }
        if (hipFuncSetAttribute((const void*)hybrid_fwd, hipFuncAttributeMaxDynamicSharedMemorySize, LDS_BYTES) != hipSuccess) { fprintf(stderr, "kernel_launch: hipFuncSetAttribute failed\n"); grid = -1; return; }
        if (hipOccupancyMaxActiveBlocksPerMultiprocessor(&per_cu, (const void*)hybrid_fwd, NTHR, LDS_BYTES) != hipSuccess || per_cu < 1) { fprintf(stderr, "kernel_launch: occupancy query says %d blocks per CU\n", per_cu); (void)hipGetLastError(); grid = -1; return; }
        grid = cus;
    }
    if (grid < 0) return;
    Params p{};
    const float** pp = (const float**)&p;
    for (int i = 0; i < 17; ++i) pp[i] = (const float*)d_in[i];
    p.out = (float*)d_out; p.ws = (unsigned char*)d_ws;
#if N_LAUNCH_SPLIT
    for (int ph = 0; ph < 17; ++ph) {
        p.ph_lo = ph; p.ph_hi = ph + 1; void* args[] = {&p};
        hipError_t e = hipLaunchCooperativeKernel((const void*)hybrid_fwd, dim3(grid), dim3(NTHR), args, LDS_BYTES, stream);
        if (e != hipSuccess) { fprintf(stderr, "cooperative launch failed: %s\n", hipGetErrorString(e)); break; }
    }
#else
    p.ph_lo = 0; p.ph_hi = 17; void* args[] = {&p};
    hipError_t e = hipLaunchCooperativeKernel((const void*)hybrid_fwd, dim3(grid), dim3(NTHR), args, LDS_BYTES, stream);
    if (e != hipSuccess) fprintf(stderr, "cooperative launch failed: %s (grid %d)\n", hipGetErrorString(e), grid);
#endif
}
```

```cpp
#include <hip/hip_runtime.h>
#include <hip/hip_cooperative_groups.h>
#include <cstdio>
#include <cstdint>
namespace cg = cooperative_groups;
namespace pg8 {
#define PG8_LAS __attribute__((address_space(3)))
typedef unsigned short bf16_t;
typedef short bf16x8 __attribute__((ext_vector_type(8)));
typedef float f32x4 __attribute__((ext_vector_type(4)));
typedef unsigned u32x4 __attribute__((ext_vector_type(4)));
constexpr int BM = 256, BK = 64, HALF = 128, HTB = HALF * BK * 2  , STAGE_BYTES = 8 * HTB, NXCD = 8, WGM = 8;

__host__ __device__ __forceinline__ int lds_byte(int r, int c) { const int st = (r >> 4) * 2 + (c >> 5), rr = r & 15, cc = c & 31, ob = rr * 64 + cc * 2; return st * 1024 + (ob ^ (((ob >> 9) & 1) << 5)); }
__host__ __device__ __forceinline__ void stage_rc(int b, int& R, int& C) { const int st = b / 1024, sb = b % 1024, swz = sb ^ (((sb >> 9) & 1) << 5); R = (st >> 1) * 16 + swz / 64; C = (st & 1) * 32 + (swz % 64) / 2; }
__host__ __device__ __forceinline__ int perm32(int rho) { const int n = rho >> 4, i = rho & 15; return 8 * (i >> 2) + 4 * n + (i & 3); }

struct Unit { int pm, pn; };
struct Gemm { const bf16_t* A; const bf16_t* Bt; int M, N, K; };

struct StaticOrder {
    int nM, nN, nwg, G, c;
    __host__ __device__ void init(int M, int N, int G_, int c_) { nM = M / BM; nN = N / BM; nwg = nM * nN; G = G_; c = c_; }
    __host__ __device__ bool next(int i, Unit& u) const {
        const long L = (long)i * G + c; if (L >= nwg) return false;
        int wgid = (int)L; { const int q = nwg / NXCD, r = nwg % NXCD, xcd = wgid % NXCD, off = wgid / NXCD; wgid = (xcd < r ? xcd * (q + 1) : r * (q + 1) + (xcd - r) * q) + off; }
        const int nig = WGM * nN, gid = wgid / nig, fm = gid * WGM, gsz = (nM - fm) < WGM ? (nM - fm) : WGM;
        u.pm = fm + ((wgid % nig) % gsz); u.pn = (wgid % nig) / gsz; return true;
    }
    __device__ __forceinline__ void a_ready(const Unit&) const {}
    __device__ __forceinline__ void done(const Unit&) const {}
};
__device__ __forceinline__ unsigned cvt_pk_bf16(float lo, float hi) { unsigned r; asm volatile("v_cvt_pk_bf16_f32 %0, %1, %2" : "=v"(r) : "v"(lo), "v"(hi)); return r; }
typedef float f32x2 __attribute__((ext_vector_type(2)));
template <class Epi, class Sched, bool ALIGN_EPI = false, bool SP2 = false>
__device__ __forceinline__ void gemm_phase(PG8_LAS unsigned char* lds, const Gemm g, const Sched& S, const Epi& E) {
    int tid_l = threadIdx.x; asm volatile("" : "+v"(tid_l)); const int tid = tid_l, wid = __builtin_amdgcn_readfirstlane(tid >> 6), lane = tid & 63, wr = wid >> 2, wc = wid & 3, fr = lane & 15, fq = lane >> 4;
    const int K = g.K, nt = K / BK;
    unsigned voffA[2], voffB[2];
#pragma unroll
    for (int i = 0; i < 2; ++i) { int R, C; stage_rc(tid * 16 + i * 8192, R, C); const int Rb = Epi::PERM ? ((R & ~31) + perm32(R & 31)) : R;
        voffA[i] = (unsigned)(R * K + C) * 2u; voffB[i] = (unsigned)(Rb * K + C) * 2u; }
    const size_t kstep = (size_t)(BK * 2);
    const size_t hstep = (size_t)HALF * K * 2;
    const size_t tstep = 2 * hstep;
    const unsigned ldsw = (unsigned)wid * 1024u;
    const int aoff = lds_byte(wr * 64 + fr, fq * 8), boff = lds_byte(wc * 32 + fr, fq * 8);
#define PG8_SA(b, h) (((b) * 2 + (h)) * HTB)
#define PG8_SB(b, h) ((4 + (b) * 2 + (h)) * HTB)
#define PG8_STAGE(bufoff, gbase, voff) do { _Pragma("unroll") for (int _i = 0; _i < 2; ++_i) \
        __builtin_amdgcn_global_load_lds((const unsigned*)((const char*)(gbase) + (voff)[_i]), (PG8_LAS unsigned*)(lds + (bufoff) + ldsw + _i * 8192), 16, 0, 0); } while (0)
#define PG8_LDA(dst, b, h) do { _Pragma("unroll") for (int m = 0; m < 4; ++m) _Pragma("unroll") for (int k = 0; k < 2; ++k) dst[m][k] = *(const PG8_LAS bf16x8*)(lds + PG8_SA(b, h) + aoff + m * 2048 + k * 1024); } while (0)
#define PG8_LDB(dst, b, h) do { _Pragma("unroll") for (int n = 0; n < 2; ++n) _Pragma("unroll") for (int k = 0; k < 2; ++k) dst[n][k] = *(const PG8_LAS bf16x8*)(lds + PG8_SB(b, h) + boff + n * 2048 + k * 1024); } while (0)
#define PG8_MMA(ai, bj, At, Bt) do { __builtin_amdgcn_s_setprio(1); _Pragma("unroll") for (int m = 0; m < 4; ++m) _Pragma("unroll") for (int n = 0; n < 2; ++n) _Pragma("unroll") for (int k = 0; k < 2; ++k) \
        acc[ai][bj][m][n] = __builtin_amdgcn_mfma_f32_16x16x32_bf16(Bt[n][k], At[m][k], acc[ai][bj][m][n], 0, 0, 0); __builtin_amdgcn_s_setprio(0); } while (0)
#define PG8_WAIT_V(n) asm volatile("s_waitcnt vmcnt(" #n ")" ::: "memory")
#define PG8_WAIT_L(n) asm volatile("s_waitcnt lgkmcnt(" #n ")" ::: "memory")
#define PG8_BAR __builtin_amdgcn_s_barrier()
#define PG8_SCHED __builtin_amdgcn_sched_barrier(0)
    Unit cur, nxt; int ui = 0;
    if (!S.next(0, cur)) return;
    f32x4 acc[2][2][4][2];
#pragma unroll
    for (int a = 0; a < 2; ++a)
#pragma unroll
        for (int b = 0; b < 2; ++b)
#pragma unroll
            for (int m = 0; m < 4; ++m)
#pragma unroll
                for (int n = 0; n < 2; ++n) acc[a][b][m][n] = (f32x4){0.f, 0.f, 0.f, 0.f};
    bf16x8 At[4][2], B0[2][2], B1[2][2];
    const char* cA = (const char*)g.A + (size_t)cur.pm * tstep; const char* cB = (const char*)g.Bt + (size_t)cur.pn * tstep;
    S.a_ready(cur);
    if constexpr (SP2) {
        PG8_STAGE(PG8_SB(0, 0), cB, voffB); PG8_STAGE(PG8_SB(0, 1), cB + hstep, voffB); PG8_STAGE(PG8_SA(0, 0), cA, voffA); PG8_STAGE(PG8_SA(0, 1), cA + hstep, voffA);
        if (wr == 1) PG8_BAR;
        PG8_WAIT_V(2); PG8_BAR;
        PG8_STAGE(PG8_SB(1, 0), cB + kstep, voffB); PG8_STAGE(PG8_SA(1, 0), cA + kstep, voffA); PG8_STAGE(PG8_SB(1, 1), cB + hstep + kstep, voffB);
        PG8_WAIT_V(6); PG8_BAR;
    } else {
        PG8_STAGE(PG8_SB(0, 0), cB, voffB); PG8_STAGE(PG8_SA(0, 0), cA, voffA); PG8_STAGE(PG8_SB(0, 1), cB + hstep, voffB); PG8_STAGE(PG8_SA(0, 1), cA + hstep, voffA);
        if (wr == 1) PG8_BAR;
        PG8_WAIT_V(4); PG8_BAR;
        PG8_STAGE(PG8_SB(1, 0), cB + kstep, voffB); PG8_STAGE(PG8_SA(1, 0), cA + kstep, voffA); PG8_STAGE(PG8_SB(1, 1), cB + hstep + kstep, voffB);
        PG8_WAIT_V(6); PG8_BAR;
    }
    for (;;) {
        const bool has_next = S.next(ui + 1, nxt);
        const char* nA = has_next ? (const char*)g.A + (size_t)nxt.pm * tstep : cA; const char* nB = has_next ? (const char*)g.Bt + (size_t)nxt.pn * tstep : cB;
        for (int t = 0; t < nt; t += 2) {
            const bool last = (t == nt - 2);
            const char* a1 = cA + (size_t)(t + 1) * kstep;
            const char* a2 = last ? nA : cA + (size_t)(t + 2) * kstep; const char* b2 = last ? nB : cB + (size_t)(t + 2) * kstep;
            const char* a3 = a2 + kstep; const char* b3 = b2 + kstep;
            if (last && has_next) S.a_ready(nxt);
            if constexpr (SP2) {
            PG8_LDB(B0, 0, 0); PG8_LDB(B1, 0, 1); PG8_SCHED; PG8_LDA(At, 0, 0); PG8_STAGE(PG8_SA(1, 1), a1 + hstep, voffA);
            PG8_WAIT_V(8); PG8_WAIT_L(0); PG8_BAR; PG8_MMA(0, 0, At, B0); PG8_MMA(0, 1, At, B1); PG8_BAR; PG8_SCHED;
            PG8_LDA(At, 0, 1); PG8_STAGE(PG8_SB(0, 0), b2, voffB); PG8_STAGE(PG8_SB(0, 1), b2 + hstep, voffB); PG8_STAGE(PG8_SA(0, 0), a2, voffA);
            PG8_WAIT_V(8); PG8_WAIT_L(0); PG8_BAR; PG8_MMA(1, 0, At, B0); PG8_MMA(1, 1, At, B1); PG8_BAR; PG8_SCHED;
            PG8_LDB(B0, 1, 0); PG8_LDB(B1, 1, 1); PG8_SCHED; PG8_LDA(At, 1, 0); PG8_STAGE(PG8_SA(0, 1), a2 + hstep, voffA);
            PG8_WAIT_V(8); PG8_WAIT_L(0); PG8_BAR; PG8_MMA(0, 0, At, B0); PG8_MMA(0, 1, At, B1); PG8_BAR; PG8_SCHED;
            PG8_LDA(At, 1, 1); PG8_STAGE(PG8_SB(1, 0), b3, voffB); PG8_STAGE(PG8_SB(1, 1), b3 + hstep, voffB); PG8_STAGE(PG8_SA(1, 0), a3, voffA);
            PG8_WAIT_V(8); PG8_WAIT_L(0); PG8_BAR; PG8_MMA(1, 0, At, B0); PG8_MMA(1, 1, At, B1); PG8_BAR; PG8_SCHED;
            } else {
            PG8_LDB(B0, 0, 0); PG8_SCHED; PG8_LDA(At, 0, 0); PG8_STAGE(PG8_SA(1, 1), a1 + hstep, voffA);
            PG8_WAIT_L(8); PG8_BAR; PG8_WAIT_L(0); PG8_MMA(0, 0, At, B0); PG8_BAR; PG8_SCHED;
            PG8_LDB(B1, 0, 1); PG8_STAGE(PG8_SB(0, 0), b2, voffB);
            PG8_BAR; PG8_WAIT_L(0); PG8_MMA(0, 1, At, B1); PG8_BAR;
            PG8_LDA(At, 0, 1); PG8_STAGE(PG8_SA(0, 0), a2, voffA);
            PG8_BAR; PG8_WAIT_L(0); PG8_MMA(1, 0, At, B0); PG8_BAR; PG8_SCHED;
            PG8_STAGE(PG8_SB(0, 1), b2 + hstep, voffB);
            PG8_WAIT_V(6); PG8_BAR; PG8_MMA(1, 1, At, B1); PG8_BAR;
            PG8_LDB(B0, 1, 0); PG8_SCHED; PG8_LDA(At, 1, 0); PG8_STAGE(PG8_SA(0, 1), a2 + hstep, voffA);
            PG8_WAIT_L(8); PG8_BAR; PG8_WAIT_L(0); PG8_MMA(0, 0, At, B0); PG8_BAR; PG8_SCHED;
            PG8_LDB(B1, 1, 1); PG8_STAGE(PG8_SB(1, 0), b3, voffB);
            PG8_BAR; PG8_WAIT_L(0); PG8_MMA(0, 1, At, B1); PG8_BAR;
            PG8_LDA(At, 1, 1); PG8_STAGE(PG8_SA(1, 0), a3, voffA);
            PG8_BAR; PG8_WAIT_L(0); PG8_MMA(1, 0, At, B0); PG8_BAR; PG8_SCHED;
            PG8_STAGE(PG8_SB(1, 1), b3 + hstep, voffB);
            PG8_WAIT_V(6); PG8_BAR; PG8_MMA(1, 1, At, B1); PG8_BAR;
            }
        }
        if constexpr (ALIGN_EPI) { if (wr == 0) PG8_BAR; }
        if constexpr (!Epi::AFTER_DRAIN) { E(acc, cur, wr, wc, fr, fq); S.done(cur); }
        if (!has_next) break;
#pragma unroll
        for (int a = 0; a < 2; ++a)
#pragma unroll
            for (int b = 0; b < 2; ++b)
#pragma unroll
                for (int m = 0; m < 4; ++m)
#pragma unroll
                    for (int n = 0; n < 2; ++n) acc[a][b][m][n] = (f32x4){0.f, 0.f, 0.f, 0.f};
        cur = nxt; cA = nA; cB = nB; ++ui;
        if constexpr (ALIGN_EPI) { if (wr == 1) PG8_BAR; }
    }
    PG8_WAIT_V(0);
    if constexpr (!ALIGN_EPI) { if (wr == 0) PG8_BAR; }
    PG8_BAR;
    if constexpr (Epi::AFTER_DRAIN) { E.fused(acc, cur, wr, wc, fr, fq, lds, wid, lane); S.done(cur); }
#undef PG8_SA
#undef PG8_SB
#undef PG8_STAGE
#undef PG8_LDA
#undef PG8_LDB
#undef PG8_MMA
#undef PG8_WAIT_V
#undef PG8_WAIT_L
#undef PG8_BAR
#undef PG8_SCHED
}
}

#ifndef MIX_STAGE
#define MIX_STAGE 3
#endif
using pg8::bf16_t; using pg8::bf16x8; using pg8::f32x4; using pg8::u32x4; using pg8::f32x2;
#define LAS __attribute__((address_space(3)))
typedef float f32x16 __attribute__((ext_vector_type(16)));
typedef unsigned u32x2 __attribute__((ext_vector_type(2)));
typedef __bf16 bf16x2_t __attribute__((ext_vector_type(2)));

constexpr int NB = 2, S = 16384, T = NB * S, DM = 1024, NIN = 2816, INW = 2824, FF = 4096;
constexpr int C_MQ = 0, C_MK = 384, C_MV = 768, C_SQ = 1152, C_SK = 1536, C_SV = 1664, C_XQK = 1792, C_XV = 2304, C_XO = 2560;
constexpr float EPS = 1e-6f;
constexpr float LOG2E = 1.4426950408889634f;
constexpr float QSCALE = 0.125f * LOG2E;
constexpr int NTHR = 512;

constexpr size_t MiB = 1ull << 20;
constexpr size_t WS_WIN = 1 * MiB, WIN_L = (size_t)NIN * DM * 2;
constexpr size_t WS_WOUT = 12 * MiB, WOUT_L = (size_t)DM * DM * 2;
constexpr size_t WS_WUP = 16 * MiB, WUP_L = (size_t)FF * DM * 2;
constexpr size_t WS_WDN = 32 * MiB, WDN_L = (size_t)DM * FF * 2;
constexpr size_t WS_WG = 48 * MiB;
constexpr size_t WS_COS = 49 * MiB, WS_SIN = 51 * MiB;
constexpr size_t WS_SSQ = 53 * MiB;
constexpr size_t WS_GATES = 55 * MiB;
constexpr size_t WS_KMEAN = 56 * MiB;
constexpr size_t WS_SEL = 57 * MiB;
constexpr size_t WS_MISC = 58 * MiB;
constexpr size_t WS_PML = 59 * MiB;
constexpr size_t WS_XB = 64 * MiB;
constexpr size_t WS_DC = 64 * MiB;
constexpr size_t WS_CST = 97 * MiB;
constexpr size_t WS_LQK = 128 * MiB;
constexpr size_t WS_YCAT = 160 * MiB;
constexpr size_t WS_PROJ = 224 * MiB;
constexpr size_t WS_PARTO = 400 * MiB;
constexpr size_t WS_H = 224 * MiB;
constexpr size_t WS_END = 480 * MiB;
static_assert(WS_WIN + 2 * WIN_L <= WS_WOUT && WS_DC + (size_t)2048 * 4160 * 4 <= WS_CST && WS_CST + (size_t)2049 * 4160 * 2 <= WS_LQK, "ws map");
static_assert(WS_PROJ + (size_t)T * NIN * 2 <= WS_PARTO && WS_PARTO + (size_t)12 * S * 3 * 64 * 2 <= WS_END && WS_H + (size_t)T * FF * 2 <= WS_END, "ws map 2");

constexpr int LDS_BYTES = 147456, BAR_LDS_OFF = 131072 + 64;
constexpr size_t WS_CTL = 0;

struct Params {
    const float* x; const float* ln1; const float* w_in; const float* conv_w; const float* conv_b; const float* igate_b; const float* fgate_b;
    const float* mlstm_norm; const float* moba_q_norm; const float* moba_k_norm; const float* swa_q_norm; const float* swa_k_norm; const float* swa_sinks;
    const float* w_out; const float* ln2; const float* w_up; const float* w_down;
    float* out; unsigned char* ws; int ph_lo, ph_hi;
};

__device__ __forceinline__ float wave_sum(float v) {
#pragma unroll
    for (int o = 1; o < 64; o <<= 1) v += __shfl_xor(v, o);
    return v;
}
__device__ __forceinline__ float wave_max(float v) {
#pragma unroll
    for (int o = 1; o < 64; o <<= 1) v = fmaxf(v, __shfl_xor(v, o));
    return v;
}
__device__ __forceinline__ unsigned pk2(float lo, float hi) { f32x2 v = {lo, hi}; bf16x2_t b = __builtin_convertvector(v, bf16x2_t); return __builtin_bit_cast(unsigned, b); }
__device__ __forceinline__ float bflo(unsigned w) { return __uint_as_float(w << 16); }
__device__ __forceinline__ float bfhi(unsigned w) { return __uint_as_float(w & 0xffff0000u); }
__device__ __forceinline__ void unpack8(const u32x4 w, float (&v)[8]) {
    v[0] = bflo(w.x); v[1] = bfhi(w.x); v[2] = bflo(w.y); v[3] = bfhi(w.y); v[4] = bflo(w.z); v[5] = bfhi(w.z); v[6] = bflo(w.w); v[7] = bfhi(w.w);
}
__device__ __forceinline__ u32x4 pack8(const float (&v)[8]) { u32x4 w; w.x = pk2(v[0], v[1]); w.y = pk2(v[2], v[3]); w.z = pk2(v[4], v[5]); w.w = pk2(v[6], v[7]); return w; }
#define LDS_WAIT() asm volatile("s_waitcnt lgkmcnt(0)" ::: "memory")
__device__ __forceinline__ float exp2_fast(float v) { return __builtin_amdgcn_exp2f(v); }

__device__ __forceinline__ float row_rstd(const float* ssq, int row, int fq) {
    const f32x4 p = *(const f32x4*)(ssq + (size_t)row * 16 + 4 * fq);
    float s = (p[0] + p[1]) + (p[2] + p[3]); s += __shfl_xor(s, 16); s += __shfl_xor(s, 32);
    return rsqrtf(s * (1.0f / 1024.0f) + EPS);
}
template <int ACT  > struct EpiScaled {
    static constexpr bool PERM = true, AFTER_DRAIN = false;
    bf16_t* O; int ldc; const float* ssq;
    __device__ __forceinline__ void operator()(const f32x4 (&acc)[2][2][4][2], const pg8::Unit& u, int wr, int wc, int fr, int fq) const {
        const int row0 = u.pm * pg8::BM + wr * 64 + fr, col0 = u.pn * pg8::BM + wc * 32 + 8 * fq;
#pragma unroll
        for (int ai = 0; ai < 2; ++ai)
#pragma unroll
            for (int m = 0; m < 4; ++m) {
                const int row = row0 + ai * pg8::HALF + m * 16;
                const float rs = row_rstd(ssq, row, fq);
                bf16_t* rowp = O + (size_t)row * ldc + col0;
#pragma unroll
                for (int bj = 0; bj < 2; ++bj) {
                    f32x4 v0 = acc[ai][bj][m][0] * rs, v1 = acc[ai][bj][m][1] * rs;
                    if (ACT == 1) {
#pragma unroll
                        for (int i = 0; i < 4; ++i) { const float a = fmaxf(v0[i], 0.f), b = fmaxf(v1[i], 0.f); v0[i] = a * a; v1[i] = b * b; }
                    }
                    u32x4 w; w.x = pk2(v0[0], v0[1]); w.y = pk2(v0[2], v0[3]); w.z = pk2(v1[0], v1[1]); w.w = pk2(v1[2], v1[3]);
                    *(u32x4*)(rowp + bj * pg8::HALF) = w;
                }
            }
    }
};
struct EpiRes {
    static constexpr bool PERM = true, AFTER_DRAIN = false;
    const float* res; float* out; bf16_t* xb; float* ssq;
    __device__ __forceinline__ void operator()(const f32x4 (&acc)[2][2][4][2], const pg8::Unit& u, int wr, int wc, int fr, int fq) const {
        const int row0 = u.pm * pg8::BM + wr * 64 + fr, col0 = u.pn * pg8::BM + wc * 32 + 8 * fq;
#pragma unroll
        for (int ai = 0; ai < 2; ++ai)
#pragma unroll
            for (int m = 0; m < 4; ++m) {
                const int row = row0 + ai * pg8::HALF + m * 16;
                const size_t off = (size_t)row * DM + col0;
                float part = 0.f;
#pragma unroll
                for (int bj = 0; bj < 2; ++bj) {
                    const f32x4 r0 = *(const f32x4*)(res + off + bj * pg8::HALF), r1 = *(const f32x4*)(res + off + bj * pg8::HALF + 4);
                    const f32x4 v0 = acc[ai][bj][m][0] + r0, v1 = acc[ai][bj][m][1] + r1;
                    *(f32x4*)(out + off + bj * pg8::HALF) = v0; *(f32x4*)(out + off + bj * pg8::HALF + 4) = v1;
                    if (xb) { u32x4 w; w.x = pk2(v0[0], v0[1]); w.y = pk2(v0[2], v0[3]); w.z = pk2(v1[0], v1[1]); w.w = pk2(v1[2], v1[3]); *(u32x4*)(xb + off + bj * pg8::HALF) = w; }
                    part += (v0[0] * v0[0] + v0[1] * v0[1]) + (v0[2] * v0[2] + v0[3] * v0[3]) + (v1[0] * v1[0] + v1[1] * v1[1]) + (v1[2] * v1[2] + v1[3] * v1[3]);
                }
                part += __shfl_xor(part, 16); part += __shfl_xor(part, 32);
                if (ssq && fq == 0) ssq[(size_t)row * 16 + u.pn * 4 + wc] = part;
            }
    }
};
template <class Epi> __device__ __forceinline__ void run_gemm(LAS unsigned char* lds, const bf16_t* A, const bf16_t* Bt, int M, int N, int K, const Epi& E, int bid) {
    pg8::Gemm g{A, Bt, M, N, K}; pg8::StaticOrder so; so.init(M, N, (int)gridDim.x, bid);
    pg8::gemm_phase<Epi, pg8::StaticOrder, true, true>(lds, g, so, E);
}

__device__ __forceinline__ void transpose_item(const float* W, int K, int ld, int nblk, const float* scale, bf16_t* WT, LAS float* scr, int item, int lane) {
    const int kb = item / nblk, nb = item % nblk, k0 = 64 * kb, n0 = 32 * nb;
#pragma unroll 8
    for (int i = 0; i < 32; ++i) {
        const int kk = 2 * i + (lane >> 5); float v = W[(size_t)(k0 + kk) * ld + n0 + (lane & 31)];
        if (scale) v *= scale[k0 + kk];
        scr[kk * 33 + (lane & 31)] = v;
    }
    LDS_WAIT();
    const int c = lane & 7;
#pragma unroll
    for (int j = 0; j < 4; ++j) {
        const int n = (lane >> 3) + 8 * j; const LAS float* s = scr + (8 * c) * 33 + n;
        u32x4 o; o.x = pk2(s[0 * 33], s[1 * 33]); o.y = pk2(s[2 * 33], s[3 * 33]); o.z = pk2(s[4 * 33], s[5 * 33]); o.w = pk2(s[6 * 33], s[7 * 33]);
        *(u32x4*)(WT + (size_t)(n0 + n) * K + k0 + 8 * c) = o;
    }
    LDS_WAIT();
}
__device__ __forceinline__ void rope_entry(int pos, int i, float& cs, float& sn) {
    const double R = 0.74989420933245582730;
    double inv = 1.0; { double b = R; int e = i; while (e) { if (e & 1) inv *= b; b *= b; e >>= 1; } }
    const double ang = (double)pos * inv;
    const double n = __builtin_rint(ang * 0.63661977236758134308);
    double y = __builtin_fma(-n, 1.57079632679489655800, ang); y = __builtin_fma(-n, 6.12323399573676603587e-17, y);
    const double y2 = y * y;
    double sp = -1.0 / 1307674368000.0; sp = sp * y2 + 1.0 / 6227020800.0; sp = sp * y2 - 1.0 / 39916800.0; sp = sp * y2 + 1.0 / 362880.0; sp = sp * y2 - 1.0 / 5040.0;
    sp = sp * y2 + 1.0 / 120.0; sp = sp * y2 - 1.0 / 6.0; sp = sp * y2 + 1.0; const double sy = sp * y;
    double cp = 1.0 / 20922789888000.0; cp = cp * y2 - 1.0 / 87178291200.0; cp = cp * y2 + 1.0 / 479001600.0; cp = cp * y2 - 1.0 / 3628800.0; cp = cp * y2 + 1.0 / 40320.0;
    cp = cp * y2 - 1.0 / 720.0; cp = cp * y2 + 1.0 / 24.0; cp = cp * y2 - 0.5; const double cy = cp * y2 + 1.0;
    const int q = (int)((long long)n & 3);
    const double s_ = (q == 0) ? sy : (q == 1) ? cy : (q == 2) ? -sy : -cy;
    const double c_ = (q == 0) ? cy : (q == 1) ? -sy : (q == 2) ? -cy : sy;
    cs = (float)c_; sn = (float)s_;
}
__device__ __forceinline__ void prologue(const Params& p, LAS unsigned char* lds, int tid, int wave, int lane) {
    unsigned char* ws = p.ws;
    const int G = (int)gridDim.x, gw = (int)blockIdx.x * 8 + wave, NGW = G * 8;
    LAS float* scr = (LAS float*)(lds + wave * 8704);
    constexpr int I_IN = 16 * 88, I_OUT = 16 * 32, I_UP = 16 * 128, I_DN = 64 * 32, I_L = I_IN + I_OUT + I_UP + I_DN;
    for (int it = gw; it < 2 * I_L; it += NGW) {
        const int l = it / I_L; int r = it % I_L;
        if (r < I_IN) { transpose_item(p.w_in + (size_t)l * DM * INW, DM, INW, 88, p.ln1 + l * DM, (bf16_t*)(ws + WS_WIN + l * WIN_L), scr, r, lane); continue; } r -= I_IN;
        if (r < I_OUT) { transpose_item(p.w_out + (size_t)l * DM * DM, DM, DM, 32, nullptr, (bf16_t*)(ws + WS_WOUT + l * WOUT_L), scr, r, lane); continue; } r -= I_OUT;
        if (r < I_UP) { transpose_item(p.w_up + (size_t)l * DM * FF, DM, FF, 128, p.ln2 + l * DM, (bf16_t*)(ws + WS_WUP + l * WUP_L), scr, r, lane); continue; } r -= I_UP;
        transpose_item(p.w_down + (size_t)l * FF * DM, FF, DM, 32, nullptr, (bf16_t*)(ws + WS_WDN + l * WDN_L), scr, r, lane);
    }
    { float* WG = (float*)(ws + WS_WG);
      for (int e = (int)blockIdx.x * NTHR + tid; e < 2 * 8 * DM; e += G * NTHR) { const int l = e >> 13, c = (e >> 10) & 7, k = e & 1023; WG[e] = p.ln1[l * DM + k] * p.w_in[((size_t)l * DM + k) * INW + NIN + c]; } }
    { float* COS = (float*)(ws + WS_COS); float* SIN = (float*)(ws + WS_SIN);
      for (int e = (int)blockIdx.x * NTHR + tid; e < S * 32; e += G * NTHR) { float c, s; rope_entry(e >> 5, e & 31, c, s); COS[e] = c; SIN[e] = s; } }
    { bf16_t* XB = (bf16_t*)(ws + WS_XB); float* SSQ = (float*)(ws + WS_SSQ);
      for (int m = gw; m < T; m += NGW) {
          const f32x4* xr = (const f32x4*)(p.x + (size_t)m * DM) + lane; f32x4 v[4]; float s = 0.f;
#pragma unroll
          for (int j = 0; j < 4; ++j) { v[j] = xr[64 * j]; s += (v[j][0] * v[j][0] + v[j][1] * v[j][1]) + (v[j][2] * v[j][2] + v[j][3] * v[j][3]); }
          s = wave_sum(s);
          u32x2* o8 = (u32x2*)(XB + (size_t)m * DM) + lane;
#pragma unroll
          for (int j = 0; j < 4; ++j) { u32x2 w; w.x = pk2(v[j][0], v[j][1]); w.y = pk2(v[j][2], v[j][3]); o8[64 * j] = w; }
          if (lane < 16) SSQ[(size_t)m * 16 + lane] = (lane == 0) ? s : 0.f;
      } }
}

__device__ __forceinline__ void prep_unit(const Params& p, int layer, int u, LAS unsigned char* lds, int tid, int wave, int lane) {
    unsigned char* ws = p.ws;
    const int blk = u / 30, job = u % 30;
    const int row0 = blk * 256, b = blk >> 6, pos0 = (blk & 63) * 256;
    bf16_t* PROJ = (bf16_t*)(ws + WS_PROJ);
    const int c = lane & 7, tl = lane >> 3;
    if (job < 20) {
        int col; const float* gw; float scale; bool iskm = false; int kh = 0;
        if (job < 6) { col = C_MQ + 64 * job; gw = p.moba_q_norm + layer * 64; scale = QSCALE; }
        else if (job < 12) { kh = job - 6; col = C_MK + 64 * kh; gw = p.moba_k_norm + layer * 64; scale = 1.f; iskm = true; }
        else if (job < 18) { col = C_SQ + 64 * (job - 12); gw = p.swa_q_norm + layer * 64; scale = QSCALE; }
        else { col = C_SK + 64 * (job - 18); gw = p.swa_k_norm + layer * 64; scale = 1.f; }
        float gv[8]; { const f32x4 g0 = *(const f32x4*)(gw + 8 * c), g1 = *(const f32x4*)(gw + 8 * c + 4); gv[0] = g0[0]; gv[1] = g0[1]; gv[2] = g0[2]; gv[3] = g0[3]; gv[4] = g1[0]; gv[5] = g1[1]; gv[6] = g1[2]; gv[7] = g1[3]; }
        float ks[8];
#pragma unroll
        for (int e = 0; e < 8; ++e) ks[e] = 0.f;
        const float* COS = (const float*)(ws + WS_COS); const float* SIN = (const float*)(ws + WS_SIN);
#pragma unroll
        for (int it = 0; it < 4; ++it) {
            const int tt = 32 * wave + 8 * it + tl;
            bf16_t* ptr = PROJ + (size_t)(row0 + tt) * NIN + col + 8 * c;
            const u32x4 w = *(const u32x4*)ptr; float v[8]; unpack8(w, v);
            float ss = 0.f;
#pragma unroll
            for (int e = 0; e < 8; ++e) ss += v[e] * v[e];
            ss += __shfl_xor(ss, 1); ss += __shfl_xor(ss, 2); ss += __shfl_xor(ss, 4);
            const float rs = rsqrtf(ss * (1.0f / 64.0f) + EPS);
            const int pos = pos0 + tt;
            const f32x4 c0 = *(const f32x4*)(COS + (size_t)pos * 32 + 8 * (c & 3)), c1 = *(const f32x4*)(COS + (size_t)pos * 32 + 8 * (c & 3) + 4);
            const f32x4 s0 = *(const f32x4*)(SIN + (size_t)pos * 32 + 8 * (c & 3)), s1 = *(const f32x4*)(SIN + (size_t)pos * 32 + 8 * (c & 3) + 4);
            float o[8];
#pragma unroll
            for (int e = 0; e < 8; ++e) {
                const float val = v[e] * rs * gv[e]; const float pr = __shfl_xor(val, 4);
                const float cs = (e < 4) ? c0[e & 3] : c1[e & 3], sn = (e < 4) ? s0[e & 3] : s1[e & 3];
                o[e] = (c < 4) ? (val * cs - pr * sn) : (val * cs + pr * sn);
                ks[e] += o[e];
                o[e] *= scale;
            }
            *(u32x4*)ptr = pack8(o);
        }
        if (iskm) {
#pragma unroll
            for (int e = 0; e < 8; ++e) { ks[e] += __shfl_xor(ks[e], 8); ks[e] += __shfl_xor(ks[e], 16); ks[e] += __shfl_xor(ks[e], 32); }
            LAS float* red = (LAS float*)lds;
            if (tl == 0) {
#pragma unroll
                for (int e = 0; e < 8; ++e) red[wave * 64 + 8 * c + e] = ks[e];
            }
            __syncthreads();
            if (tid < 64) {
                float s = 0.f;
#pragma unroll
                for (int w8 = 0; w8 < 8; ++w8) s += red[w8 * 64 + tid];
                float* KM = (float*)(ws + WS_KMEAN);
                KM[((size_t)((b * 6 + kh) * 64 + (blk & 63))) * 64 + tid] = s * (1.0f / 256.0f);
            }
            __syncthreads();
        }
    } else if (job < 28) {
        const int cj = job - 20, col = C_XQK + 64 * cj; const float osc = (cj >= 4) ? 0.125f : 1.f;
        bf16_t* LQK = (bf16_t*)(ws + WS_LQK);
        float cw[4][8], cb[8];
#pragma unroll
        for (int jj = 0; jj < 4; ++jj) { const float* wp = p.conv_w + ((size_t)layer * 4 + jj) * 512 + 64 * cj + 8 * c; const f32x4 a = *(const f32x4*)wp, bq = *(const f32x4*)(wp + 4);
            cw[jj][0] = a[0]; cw[jj][1] = a[1]; cw[jj][2] = a[2]; cw[jj][3] = a[3]; cw[jj][4] = bq[0]; cw[jj][5] = bq[1]; cw[jj][6] = bq[2]; cw[jj][7] = bq[3]; }
        { const float* bp = p.conv_b + (size_t)layer * 512 + 64 * cj + 8 * c; const f32x4 a = *(const f32x4*)bp, bq = *(const f32x4*)(bp + 4);
          cb[0] = a[0]; cb[1] = a[1]; cb[2] = a[2]; cb[3] = a[3]; cb[4] = bq[0]; cb[5] = bq[1]; cb[6] = bq[2]; cb[7] = bq[3]; }
#pragma unroll
        for (int it = 0; it < 4; ++it) {
            const int tt = 32 * wave + 8 * it + tl, pos = pos0 + tt; const size_t row = (size_t)row0 + tt;
            float acc[8];
#pragma unroll
            for (int e = 0; e < 8; ++e) acc[e] = cb[e];
#pragma unroll
            for (int jj = 0; jj < 4; ++jj) {
                if (pos - 3 + jj >= 0) {
                    const u32x4 w = *(const u32x4*)(PROJ + (row - 3 + jj) * NIN + col + 8 * c); float v[8]; unpack8(w, v);
#pragma unroll
                    for (int e = 0; e < 8; ++e) acc[e] += cw[jj][e] * v[e];
                }
            }
            float o[8];
#pragma unroll
            for (int e = 0; e < 8; ++e) { const float y = acc[e]; o[e] = y / (1.f + __expf(-y)) * osc; }
            *(u32x4*)(LQK + row * 512 + 64 * cj + 8 * c) = pack8(o);
        }
    } else {
        const int gh = job - 28;
        const float* WG = (const float*)(ws + WS_WG) + (size_t)layer * 8 * DM + (size_t)gh * 4 * DM;
        const bf16_t* XB = (const bf16_t*)(ws + WS_XB); const float* SSQ = (const float*)(ws + WS_SSQ); float* GT = (float*)(ws + WS_GATES);
        float wg[4][16];
#pragma unroll
        for (int cc = 0; cc < 4; ++cc)
#pragma unroll
            for (int hf = 0; hf < 2; ++hf) { const float* wp = WG + cc * DM + 512 * hf + 8 * lane; const f32x4 a = *(const f32x4*)wp, bq = *(const f32x4*)(wp + 4);
                wg[cc][8 * hf + 0] = a[0]; wg[cc][8 * hf + 1] = a[1]; wg[cc][8 * hf + 2] = a[2]; wg[cc][8 * hf + 3] = a[3]; wg[cc][8 * hf + 4] = bq[0]; wg[cc][8 * hf + 5] = bq[1]; wg[cc][8 * hf + 6] = bq[2]; wg[cc][8 * hf + 7] = bq[3]; }
        float bias = 0.f; if (lane < 4) bias = (gh == 0) ? p.igate_b[layer * 4 + lane] : p.fgate_b[layer * 4 + lane];
#pragma unroll 1
        for (int rr = 0; rr < 32; ++rr) {
            const size_t row = (size_t)row0 + 32 * wave + rr;
            const u32x4 a0 = *(const u32x4*)(XB + row * DM + 8 * lane), a1 = *(const u32x4*)(XB + row * DM + 512 + 8 * lane);
            float xv[16]; { float t0[8], t1[8]; unpack8(a0, t0); unpack8(a1, t1);
#pragma unroll
                for (int e = 0; e < 8; ++e) { xv[e] = t0[e]; xv[8 + e] = t1[e]; } }
            float d[4];
#pragma unroll
            for (int cc = 0; cc < 4; ++cc) { float s = 0.f;
#pragma unroll
                for (int k = 0; k < 16; ++k) s += xv[k] * wg[cc][k];
                d[cc] = wave_sum(s); }
            float sp = SSQ[row * 16 + (lane & 15)]; sp += __shfl_xor(sp, 1); sp += __shfl_xor(sp, 2); sp += __shfl_xor(sp, 4); sp += __shfl_xor(sp, 8);
            const float rs = rsqrtf(sp * (1.0f / 1024.0f) + EPS);
            float dv = d[0]; dv = (lane == 1) ? d[1] : dv; dv = (lane == 2) ? d[2] : dv; dv = (lane == 3) ? d[3] : dv;
            if (lane < 4) GT[row * 8 + 4 * gh + lane] = dv * rs + bias;
        }
    }
}

#define RLX_AGENT __ATOMIC_RELAXED, __HIP_MEMORY_SCOPE_AGENT
#define XB_TMO      128
#define XB_XCNT(j)  (256  + 64 * (j))
#define XB_XSUB(j)  (1280 + 64 * (j))
#define XB_XGEN(j)  (2304 + 64 * (j))
#define XB_TOP      3328
#define XB_TOPGEN   3392
#define XCD_BAR_WORDS 3456
#define XB_SPIN_CAP (1u << 18)

__device__ __forceinline__ unsigned xb_ld(unsigned* p)              { return __hip_atomic_load(p, __ATOMIC_RELAXED, __HIP_MEMORY_SCOPE_AGENT); }
__device__ __forceinline__ unsigned xb_add(unsigned* p, unsigned v) { return __hip_atomic_fetch_add(p, v, __ATOMIC_RELAXED, __HIP_MEMORY_SCOPE_AGENT); }
__device__ __forceinline__ unsigned xb_xcc_id() { return (unsigned)__builtin_amdgcn_s_getreg((3 << 11) | 20) & 0xFu; }
#define XB_SPIN(cond, bar) do { unsigned _sp = 0; while (cond) { __builtin_amdgcn_s_sleep(1); \
    if ((++_sp & 255u) == 0u) { if (xb_ld(&(bar)[XB_TMO])) break; if (_sp > XB_SPIN_CAP) { atomicAdd(&(bar)[XB_TMO], 1u); break; } } } } while (0)

struct XcdBarrier {
    unsigned* bar; unsigned x;
    volatile LAS unsigned* st;
};

__device__ __forceinline__ XcdBarrier xcd_barrier_post(unsigned* bar, volatile LAS unsigned* st) {
    XcdBarrier b; b.bar = bar; b.x = xb_xcc_id(); b.st = st;
    if (threadIdx.x == 0) (void)xb_add(&bar[XB_XCNT(b.x)], 1u);
    return b;
}
__device__ __forceinline__ void xcd_barrier_complete(unsigned* bar, unsigned x, unsigned& nloc, unsigned& nx) {
    const unsigned G = gridDim.x * gridDim.y * gridDim.z;
    unsigned sum, cnt, mine, sp = 0u;
    for (;;) {
        sum = 0u; cnt = 0u; mine = 0u;
#pragma unroll
        for (unsigned j = 0; j < 16; ++j) { const unsigned c = xb_ld(&bar[XB_XCNT(j)]); sum += c; cnt += (c > 0u) ? 1u : 0u; mine = (j == x) ? c : mine; }
        if (sum == G) break;
        __builtin_amdgcn_s_sleep(1);
        if ((++sp & 255u) == 0u) { if (xb_ld(&bar[XB_TMO])) break; if (sp > XB_SPIN_CAP) { atomicAdd(&bar[XB_TMO], 1u); break; } }
    }
    nloc = mine > 0u ? mine : 1u; nx = cnt > 0u ? cnt : 1u;
}

__device__ __forceinline__ void xcd_barrier(const XcdBarrier& b) {
    asm volatile("s_waitcnt vmcnt(0)" ::: "memory");
    __syncthreads();
    if (threadIdx.x == 0) {
        unsigned* bar = b.bar;
        __builtin_amdgcn_s_waitcnt(0);
        unsigned nloc = b.st[0], nx = b.st[1];
        if (nloc == 0u) { xcd_barrier_complete(bar, b.x, nloc, nx); b.st[0] = nloc; b.st[1] = nx; }
        const unsigned old = xb_add(&bar[XB_XSUB(b.x)], 1u);
        const unsigned gen = old / nloc;
        if (old + 1u == (gen + 1u) * nloc) {
            __builtin_amdgcn_fence(__ATOMIC_RELEASE, "agent");
            asm volatile("s_waitcnt vmcnt(0)" ::: "memory");
            const unsigned og = xb_add(&bar[XB_TOP], 1u);
            const unsigned tg = og / nx;
            if (og + 1u == (tg + 1u) * nx) xb_add(&bar[XB_TOPGEN], 1u);
            else XB_SPIN(xb_ld(&bar[XB_TOPGEN]) == tg, bar);
            __builtin_amdgcn_fence(__ATOMIC_ACQUIRE, "agent");
            xb_add(&bar[XB_XGEN(b.x)], 1u);
            asm volatile("s_waitcnt vmcnt(0)" ::: "memory");
        } else {
            XB_SPIN(xb_ld(&bar[XB_XGEN(b.x)]) == gen, bar);
            __builtin_amdgcn_fence(__ATOMIC_ACQUIRE, "agent");
            asm volatile("s_waitcnt vmcnt(0)" ::: "memory");
        }
    }
    __syncthreads();
}

constexpr int KP = 72, VP = 260;
constexpr int AT_KS = 0, AT_VT = 256 * KP * 2, AT_LIST = AT_VT + 64 * VP * 2, AT_CNT = AT_LIST + 8192;
__device__ __forceinline__ void stage_kv256(LAS unsigned char* lds, const bf16_t* kb, const bf16_t* vb, long row0, long rowmin, int tid) {
#pragma unroll
    for (int i = 0; i < 4; ++i) {
        const int chunk = i * NTHR + tid, row = chunk >> 3, c8 = chunk & 7;
        long gr = row0 + row; gr = gr < rowmin ? rowmin : gr;
        const u32x4 kv = *(const u32x4*)(kb + gr * NIN + 8 * c8);
        const u32x4 vv = *(const u32x4*)(vb + gr * NIN + 8 * c8);
        *(LAS u32x4*)(lds + AT_KS + (row * KP + 8 * c8) * 2) = kv;
        LAS bf16_t* vt = (LAS bf16_t*)(lds + AT_VT) + (8 * c8) * VP + row;
        vt[0 * VP] = (bf16_t)(vv.x & 0xffffu); vt[1 * VP] = (bf16_t)(vv.x >> 16); vt[2 * VP] = (bf16_t)(vv.y & 0xffffu); vt[3 * VP] = (bf16_t)(vv.y >> 16);
        vt[4 * VP] = (bf16_t)(vv.z & 0xffffu); vt[5 * VP] = (bf16_t)(vv.z >> 16); vt[6 * VP] = (bf16_t)(vv.w & 0xffffu); vt[7 * VP] = (bf16_t)(vv.w >> 16);
    }
}
__device__ __forceinline__ void attn_tile(const LAS unsigned char* lds, const bf16x8 (&qf)[4], int kmin, int kmax, int r32, int hi, f32x16 (&o)[2], float& mrow, float& lrow) {
    const LAS unsigned char* kbase = lds + AT_KS + (r32 * KP + 8 * hi) * 2;
    const LAS unsigned char* vbase = lds + AT_VT + (r32 * VP + 4 * hi) * 2;
    const int klo = kmin - 4 * hi, khi = kmax - 4 * hi;
#pragma unroll
    for (int dt = 0; dt < 2; ++dt)
#pragma unroll
        for (int r = 0; r < 16; ++r) o[dt][r] = 0.f;
    float m = -INFINITY, l = 0.f;
#pragma unroll 1
    for (int kt = 0; kt < 8; ++kt) {
        f32x16 s;
#pragma unroll
        for (int r = 0; r < 16; ++r) s[r] = 0.f;
#pragma unroll
        for (int d0 = 0; d0 < 4; ++d0) {
            const bf16x8 kf = *(const LAS bf16x8*)(kbase + (32 * kt * KP + 16 * d0) * 2);
            s = __builtin_amdgcn_mfma_f32_32x32x16_bf16(kf, qf[d0], s, 0, 0, 0);
        }
        float tmx = -INFINITY;
#pragma unroll
        for (int r = 0; r < 16; ++r) {
            const int kv = 32 * kt + (r & 3) + 8 * (r >> 2);
            const float v = (kv >= klo && kv <= khi) ? s[r] : -INFINITY;
            s[r] = v; tmx = fmaxf(tmx, v);
        }
        tmx = fmaxf(tmx, __shfl_xor(tmx, 32));
        const float mn = fmaxf(m, tmx), mu = (mn == -INFINITY) ? 0.f : mn;
        const float sc = exp2_fast(m - mu);
        float sum = 0.f;
#pragma unroll
        for (int r = 0; r < 16; ++r) { const float pv = exp2_fast(s[r] - mu); s[r] = pv; sum += pv; }
        sum += __shfl_xor(sum, 32);
        l = l * sc + sum; m = mn;
#pragma unroll
        for (int dt = 0; dt < 2; ++dt)
#pragma unroll
            for (int r = 0; r < 16; ++r) o[dt][r] *= sc;
#pragma unroll
        for (int j = 0; j < 2; ++j) {
            u32x4 pw; pw.x = pk2(s[8 * j + 0], s[8 * j + 1]); pw.y = pk2(s[8 * j + 2], s[8 * j + 3]); pw.z = pk2(s[8 * j + 4], s[8 * j + 5]); pw.w = pk2(s[8 * j + 6], s[8 * j + 7]);
            const bf16x8 pb = __builtin_bit_cast(bf16x8, pw);
#pragma unroll
            for (int dt = 0; dt < 2; ++dt) {
                const LAS unsigned char* vp = vbase + (32 * dt * VP + 32 * kt + 16 * j) * 2;
                const u32x2 lo = *(const LAS u32x2*)vp, hi2 = *(const LAS u32x2*)(vp + 16);
                u32x4 vw; vw.x = lo.x; vw.y = lo.y; vw.z = hi2.x; vw.w = hi2.y;
                o[dt] = __builtin_amdgcn_mfma_f32_32x32x16_bf16(__builtin_bit_cast(bf16x8, vw), pb, o[dt], 0, 0, 0);
            }
        }
    }
    mrow = m; lrow = l;
}
__device__ __forceinline__ void store_orow_bf16(bf16_t* dst, const f32x16 (&o)[2], float sc, int hi) {
#pragma unroll
    for (int dt = 0; dt < 2; ++dt)
#pragma unroll
        for (int g = 0; g < 4; ++g) { u32x2 w; w.x = pk2(o[dt][4 * g] * sc, o[dt][4 * g + 1] * sc); w.y = pk2(o[dt][4 * g + 2] * sc, o[dt][4 * g + 3] * sc); *(u32x2*)(dst + 32 * dt + 8 * g + 4 * hi) = w; }
}
__device__ __forceinline__ void load_qf(bf16x8 (&qf)[4], const bf16_t* qrow, int hi) {
#pragma unroll
    for (int d0 = 0; d0 < 4; ++d0) qf[d0] = *(const bf16x8*)(qrow + 16 * d0 + 8 * hi);
}

__device__ __forceinline__ void swa_unit(const Params& p, int layer, int u, LAS unsigned char* lds, int tid, int wave, int lane) {
    const int kh = u & 1, n = (u >> 1) & 127, b = u >> 8;
    const bf16_t* PROJ = (const bf16_t*)(p.ws + WS_PROJ); bf16_t* YC = (bf16_t*)(p.ws + WS_YCAT);
    const long rowb = (long)b * S;
    stage_kv256(lds, PROJ + C_SK + 64 * kh, PROJ + C_SV + 64 * kh, rowb + 128 * (n - 1), rowb, tid);
    __syncthreads();
    const int r32 = lane & 31, hi = lane >> 5;
    for (int tl = wave; tl < 12; tl += 8) {
        const int qh = 3 * kh + (tl >> 2), rt = tl & 3, qi = 32 * rt + r32; const long row = rowb + 128 * n + qi;
        bf16x8 qf[4]; load_qf(qf, PROJ + row * NIN + C_SQ + 64 * qh, hi);
        int kmin = qi + 1; if (n == 0 && kmin < 128) kmin = 128;
        f32x16 o[2]; float m, l; attn_tile(lds, qf, kmin, qi + 128, r32, hi, o, m, l);
        l += exp2_fast(p.swa_sinks[layer * 6 + qh] * LOG2E - m);
        store_orow_bf16(YC + row * DM + 640 + 64 * qh, o, 1.0f / l, hi);
    }
    __syncthreads();
}

__device__ __forceinline__ void sel_wave_unit(const Params& p, int wu, int lane) {
    const int bh = wu >> 8, i = wu & 255, b = bh / 6, h = bh % 6, t0 = i * 64, blk = t0 >> 8;
    unsigned sel = 0xFFFFFFu;
    if (blk > 0) {
        const bf16_t* qp = (const bf16_t*)(p.ws + WS_PROJ) + ((size_t)b * S + t0 + lane) * NIN + C_MQ + 64 * h;
        float q[64];
#pragma unroll
        for (int c8 = 0; c8 < 8; ++c8) { const u32x4 w = *(const u32x4*)(qp + 8 * c8); float v[8]; unpack8(w, v);
#pragma unroll
            for (int e = 0; e < 8; ++e) q[8 * c8 + e] = v[e]; }
        float v0 = -INFINITY, v1 = -INFINITY, v2 = -INFINITY; unsigned i0 = 255u, i1 = 255u, i2 = 255u;
        const float* km = (const float*)(p.ws + WS_KMEAN) + (size_t)bh * 64 * 64;
        for (int j = 0; j < blk; ++j) {
            const f32x4* kr = (const f32x4*)(km + j * 64); float g0 = 0.f, g1 = 0.f;
#pragma unroll
            for (int d4 = 0; d4 < 16; d4 += 2) { const f32x4 ka = kr[d4], kb = kr[d4 + 1];
                g0 += q[4 * d4] * ka[0] + q[4 * d4 + 1] * ka[1] + q[4 * d4 + 2] * ka[2] + q[4 * d4 + 3] * ka[3];
                g1 += q[4 * d4 + 4] * kb[0] + q[4 * d4 + 5] * kb[1] + q[4 * d4 + 6] * kb[2] + q[4 * d4 + 7] * kb[3]; }
            const float g = g0 + g1; const unsigned ju = (unsigned)j;
            if (g > v0) { v2 = v1; i2 = i1; v1 = v0; i1 = i0; v0 = g; i0 = ju; }
            else if (g > v1) { v2 = v1; i2 = i1; v1 = g; i1 = ju; }
            else if (g > v2) { v2 = g; i2 = ju; }
        }
        sel = i0 | (i1 << 8) | (i2 << 16);
    }
    ((unsigned*)(p.ws + WS_SEL))[(size_t)bh * S + t0 + lane] = sel;
}
__device__ __forceinline__ void moba_sel_unit(const Params& p, int v, LAS unsigned char* lds, int tid, int wave, int lane) {
    const int bh = v % 12, w = v / 12, b = bh / 6, h = bh % 6;
    int j = 0, c = w; for (;;) { const int nc = (63 - j + 7) >> 3; if (c < nc) break; c -= nc; ++j; }
    const int tstart = 256 * (j + 1) + 2048 * c;
    LAS unsigned* list = (LAS unsigned*)(lds + AT_LIST); LAS unsigned* cnt = (LAS unsigned*)(lds + AT_CNT);
    if (tid == 0) *cnt = 0u;
    __syncthreads();
    const unsigned* SEL = (const unsigned*)(p.ws + WS_SEL) + (size_t)bh * S;
#pragma unroll
    for (int i = 0; i < 4; ++i) {
        const int tq = i * NTHR + tid, t = tstart + tq;
        if (t < S) {
            const unsigned sel = SEL[t]; int rk = -1;
            if ((sel & 0xffu) == (unsigned)j) rk = 0; else if (((sel >> 8) & 0xffu) == (unsigned)j) rk = 1; else if (((sel >> 16) & 0xffu) == (unsigned)j) rk = 2;
            if (rk >= 0) { const unsigned pos = __hip_atomic_fetch_add(cnt, 1u, __ATOMIC_RELAXED, __HIP_MEMORY_SCOPE_WORKGROUP); list[pos] = (unsigned)tq | ((unsigned)rk << 12); }
        }
    }
    __syncthreads();
    const int n = (int)*cnt;
    if (n > 0) {
        const bf16_t* PROJ = (const bf16_t*)(p.ws + WS_PROJ);
        stage_kv256(lds, PROJ + C_MK + 64 * h, PROJ + C_MV + 64 * h, (long)b * S + 256 * j, 0, tid);
        __syncthreads();
        const int r32 = lane & 31, hi = lane >> 5, ntl = (n + 31) >> 5;
        float* PML = (float*)(p.ws + WS_PML); bf16_t* PO = (bf16_t*)(p.ws + WS_PARTO);
        for (int tl = wave; tl < ntl; tl += 8) {
            const int idx = 32 * tl + r32; const bool valid = idx < n;
            const unsigned e = list[valid ? idx : 0]; const int t = tstart + (int)(e & 0x7ffu), rk = (int)(e >> 12);
            const long row = (long)b * S + t;
            bf16x8 qf[4]; load_qf(qf, PROJ + row * NIN + C_MQ + 64 * h, hi);
            f32x16 o[2]; float m, l; attn_tile(lds, qf, 0, 255, r32, hi, o, m, l);
            if (valid) {
                const size_t base = ((size_t)bh * S + t) * 3 + rk;
                if (hi == 0) { PML[base * 2] = m; PML[base * 2 + 1] = l; }
                store_orow_bf16(PO + base * 64, o, 1.0f, hi);
            }
        }
    }
    __syncthreads();
}
__device__ __forceinline__ void moba_own_unit(const Params& p, int u, LAS unsigned char* lds, int tid, int wave, int lane) {
    const int bh = u % 12, blk = u / 12, b = bh / 6, h = bh % 6;
    const bf16_t* PROJ = (const bf16_t*)(p.ws + WS_PROJ); bf16_t* YC = (bf16_t*)(p.ws + WS_YCAT);
    stage_kv256(lds, PROJ + C_MK + 64 * h, PROJ + C_MV + 64 * h, (long)b * S + 256 * blk, 0, tid);
    __syncthreads();
    const int r32 = lane & 31, hi = lane >> 5, qi = 32 * wave + r32, t = 256 * blk + qi; const long row = (long)b * S + t;
    bf16x8 qf[4]; load_qf(qf, PROJ + row * NIN + C_MQ + 64 * h, hi);
    f32x16 o[2]; float m, l; attn_tile(lds, qf, 0, qi, r32, hi, o, m, l);
    const int nv = blk < 3 ? blk : 3;
    const float* PML = (const float*)(p.ws + WS_PML); const bf16_t* PO = (const bf16_t*)(p.ws + WS_PARTO);
    const size_t base = ((size_t)bh * S + t) * 3;
    float mr[3], lr[3]; float M = m;
#pragma unroll
    for (int r = 0; r < 3; ++r) { mr[r] = -INFINITY; lr[r] = 0.f; if (r < nv) { const f32x2 ml = *(const f32x2*)(PML + (base + r) * 2); mr[r] = ml[0]; lr[r] = ml[1]; M = fmaxf(M, mr[r]); } }
    const float w0 = exp2_fast(m - M); float L = l * w0;
#pragma unroll
    for (int dt = 0; dt < 2; ++dt)
#pragma unroll
        for (int r = 0; r < 16; ++r) o[dt][r] *= w0;
#pragma unroll
    for (int r = 0; r < 3; ++r) {
        if (r < nv) {
            const float wr_ = exp2_fast(mr[r] - M); L += wr_ * lr[r];
            const bf16_t* src = PO + (base + r) * 64;
#pragma unroll
            for (int dt = 0; dt < 2; ++dt)
#pragma unroll
                for (int g = 0; g < 4; ++g) { const u32x2 wv = *(const u32x2*)(src + 32 * dt + 8 * g + 4 * hi);
                    o[dt][4 * g] += wr_ * bflo(wv.x); o[dt][4 * g + 1] += wr_ * bfhi(wv.x); o[dt][4 * g + 2] += wr_ * bflo(wv.y); o[dt][4 * g + 3] += wr_ * bfhi(wv.y); }
        }
    }
    store_orow_bf16(YC + row * DM + 64 * h, o, 1.0f / L, hi);
    __syncthreads();
}

__device__ __forceinline__ float log_sigmoid(float f) { return fminf(f, 0.f) - log1pf(__expf(-fabsf(f))); }
__device__ __forceinline__ float wave_incl_scan(float v, int lane) {
#pragma unroll
    for (int o = 1; o < 64; o <<= 1) { const float t = __shfl_up(v, o); if (lane >= o) v += t; }
    return v;
}
constexpr int MP = 72;
constexpr int M1_KT = 0, M1_VT = 64 * MP * 2, M1_W = M1_VT + 96 * MP * 2, M1_SUB = M1_W + 256;
__device__ __forceinline__ void m1_quad(const Params& p, int quad, LAS unsigned char* lds, int tid, int wave, int lane) {
    const int sub = wave >> 1, wp = wave & 1, unit = quad * 4 + sub, bh = unit >> 8, c = unit & 255, b = bh >> 2, h = bh & 3;
    const long row0 = (long)b * S + 64 * c;
    LAS unsigned char* L = lds + sub * M1_SUB;
    LAS float* wv = (LAS float*)(L + M1_W);
    const float* GT = (const float*)(p.ws + WS_GATES);
    if (wp == 0) {
        const float ig = GT[(row0 + lane) * 8 + h], fg = GT[(row0 + lane) * 8 + 4 + h];
        const float bs = wave_incl_scan(log_sigmoid(fg), lane);
        const float a = __shfl(bs, 63), g = a - bs + ig, mg = wave_max(g);
        wv[lane] = __expf(g - mg);
        if (lane == 0) { float* MISC = (float*)(p.ws + WS_MISC); MISC[unit] = a; MISC[2048 + unit] = mg; }
    }
    __syncthreads();
    const bf16_t* LQK = (const bf16_t*)(p.ws + WS_LQK); const bf16_t* PROJ = (const bf16_t*)(p.ws + WS_PROJ);
    const int tp = wp * 64 + lane;
#pragma unroll
    for (int i = 0; i < 4; ++i) {
        const int chunk = i * 128 + tp, s = chunk >> 3, c8 = chunk & 7;
        const u32x4 kw = *(const u32x4*)(LQK + (row0 + s) * 512 + 256 + 64 * h + 8 * c8);
        const u32x4 vw = *(const u32x4*)(PROJ + (row0 + s) * NIN + C_XV + 64 * h + 8 * c8);
        float kf[8]; unpack8(kw, kf); const float ws_ = wv[s];
        LAS bf16_t* kt = (LAS bf16_t*)(L + M1_KT) + (8 * c8) * MP + s;
#pragma unroll
        for (int e = 0; e < 8; e += 2) { const unsigned pw = pk2(kf[e] * ws_, kf[e + 1] * ws_); kt[e * MP] = (bf16_t)(pw & 0xffffu); kt[(e + 1) * MP] = (bf16_t)(pw >> 16); }
        LAS bf16_t* vt = (LAS bf16_t*)(L + M1_VT) + (8 * c8) * MP + s;
        vt[0 * MP] = (bf16_t)(vw.x & 0xffffu); vt[1 * MP] = (bf16_t)(vw.x >> 16); vt[2 * MP] = (bf16_t)(vw.y & 0xffffu); vt[3 * MP] = (bf16_t)(vw.y >> 16);
        vt[4 * MP] = (bf16_t)(vw.z & 0xffffu); vt[5 * MP] = (bf16_t)(vw.z >> 16); vt[6 * MP] = (bf16_t)(vw.w & 0xffffu); vt[7 * MP] = (bf16_t)(vw.w >> 16);
    }
#pragma unroll
    for (int i = 0; i < 16; ++i) { const int e = i * 128 + tp, rr = e >> 6, ss = e & 63; ((LAS bf16_t*)(L + M1_VT))[(64 + rr) * MP + ss] = (rr == 0) ? (bf16_t)0x3F80u : (bf16_t)0u; }
    __syncthreads();
    const int r32 = lane & 31, hi = lane >> 5;
    f32x16 acc[3];
#pragma unroll
    for (int et = 0; et < 3; ++et)
#pragma unroll
        for (int r = 0; r < 16; ++r) acc[et][r] = 0.f;
#pragma unroll
    for (int ks = 0; ks < 4; ++ks) {
        const bf16x8 bfr = *(const LAS bf16x8*)(L + M1_KT + ((32 * wp + r32) * MP + 16 * ks + 8 * hi) * 2);
#pragma unroll
        for (int et = 0; et < 3; ++et) {
            const bf16x8 afr = *(const LAS bf16x8*)(L + M1_VT + ((32 * et + r32) * MP + 16 * ks + 8 * hi) * 2);
            acc[et] = __builtin_amdgcn_mfma_f32_32x32x16_bf16(afr, bfr, acc[et], 0, 0, 0);
        }
    }
    float* DC = (float*)(p.ws + WS_DC) + (size_t)unit * 4160;
    const int d = 32 * wp + r32;
#pragma unroll
    for (int et = 0; et < 2; ++et)
#pragma unroll
        for (int r = 0; r < 16; ++r) { const int e = 32 * et + (r & 3) + 8 * (r >> 2) + 4 * hi; DC[e * 64 + d] = acc[et][r]; }
    if (hi == 0) DC[64 * 64 + d] = acc[2][0];
    __syncthreads();
}
__device__ __forceinline__ void scan_unit(const Params& p, int su, int tid) {
    const int e = su * NTHR + tid, bh = e / 4160, idx = e % 4160;
    if (bh >= 8) return;
    const float* MISC = (const float*)(p.ws + WS_MISC); float* MS = (float*)(p.ws + WS_MISC) + 4096;
    const float* DC = (const float*)(p.ws + WS_DC); bf16_t* CST = (bf16_t*)(p.ws + WS_CST);
    float C = 0.f, m = 0.f;
#pragma unroll 8
    for (int c = 0; c < 256; ++c) {
        const int unit = bh * 256 + c;
        CST[(size_t)unit * 4160 + idx] = (bf16_t)(pk2(C, 0.f) & 0xffffu);
        if (idx == 0) MS[unit] = m;
        const float a = MISC[unit], mg = MISC[2048 + unit];
        const float mn = fmaxf(a + m, mg), dec = __expf(a + m - mn), sc = __expf(mg - mn);
        C = dec * C + sc * DC[(size_t)unit * 4160 + idx]; m = mn;
    }
}
constexpr int M3_K = 0, M3_VT = 64 * MP * 2, M3_CS = 2 * 64 * MP * 2, M3_BS = M3_CS + 256, M3_SUB = M3_BS + 256;
__device__ __forceinline__ void m3_quad(const Params& p, int layer, int quad, LAS unsigned char* lds, int tid, int wave, int lane) {
    const int sub = wave >> 1, wp = wave & 1, unit = quad * 4 + sub, bh = unit >> 8, c = unit & 255, b = bh >> 2, h = bh & 3;
    const long row0 = (long)b * S + 64 * c;
    LAS unsigned char* L = lds + sub * M3_SUB;
    LAS float* cs = (LAS float*)(L + M3_CS); LAS float* bsv = (LAS float*)(L + M3_BS);
    const float* GT = (const float*)(p.ws + WS_GATES);
    if (wp == 0) {
        const float ig = GT[(row0 + lane) * 8 + h], fg = GT[(row0 + lane) * 8 + 4 + h];
        const float bs = wave_incl_scan(log_sigmoid(fg), lane);
        cs[lane] = ig - bs; bsv[lane] = bs;
    }
    const bf16_t* LQK = (const bf16_t*)(p.ws + WS_LQK); const bf16_t* PROJ = (const bf16_t*)(p.ws + WS_PROJ);
    const int tp = wp * 64 + lane;
#pragma unroll
    for (int i = 0; i < 4; ++i) {
        const int chunk = i * 128 + tp, s = chunk >> 3, c8 = chunk & 7;
        const u32x4 kw = *(const u32x4*)(LQK + (row0 + s) * 512 + 256 + 64 * h + 8 * c8);
        const u32x4 vw = *(const u32x4*)(PROJ + (row0 + s) * NIN + C_XV + 64 * h + 8 * c8);
        *(LAS u32x4*)(L + M3_K + (s * MP + 8 * c8) * 2) = kw;
        LAS bf16_t* vt = (LAS bf16_t*)(L + M3_VT) + (8 * c8) * MP + s;
        vt[0 * MP] = (bf16_t)(vw.x & 0xffffu); vt[1 * MP] = (bf16_t)(vw.x >> 16); vt[2 * MP] = (bf16_t)(vw.y & 0xffffu); vt[3 * MP] = (bf16_t)(vw.y >> 16);
        vt[4 * MP] = (bf16_t)(vw.z & 0xffffu); vt[5 * MP] = (bf16_t)(vw.z >> 16); vt[6 * MP] = (bf16_t)(vw.w & 0xffffu); vt[7 * MP] = (bf16_t)(vw.w >> 16);
    }
    __syncthreads();
    const int r32 = lane & 31, hi = lane >> 5, t = 32 * wp + r32; const long row = row0 + t;
    bf16x8 qf[4]; load_qf(qf, LQK + row * 512 + 64 * h, hi);
    f32x16 sT[2];
#pragma unroll
    for (int st = 0; st < 2; ++st) {
        f32x16 a;
#pragma unroll
        for (int r = 0; r < 16; ++r) a[r] = 0.f;
#pragma unroll
        for (int d0 = 0; d0 < 4; ++d0) {
            const bf16x8 kf = *(const LAS bf16x8*)(L + M3_K + ((32 * st + r32) * MP + 16 * d0 + 8 * hi) * 2);
            a = __builtin_amdgcn_mfma_f32_32x32x16_bf16(kf, qf[d0], a, 0, 0, 0);
        }
        sT[st] = a;
    }
    const float b_t = bsv[t], m_c = ((const float*)(p.ws + WS_MISC))[4096 + unit], inter = b_t + m_c;
    f32x16 dm[2]; float mx = inter;
#pragma unroll
    for (int st = 0; st < 2; ++st)
#pragma unroll
        for (int g = 0; g < 4; ++g) {
            const f32x4 c4 = *(const LAS f32x4*)(cs + 32 * st + 8 * g + 4 * hi);
#pragma unroll
            for (int e2 = 0; e2 < 4; ++e2) { const int s = 32 * st + 8 * g + 4 * hi + e2; const float dv = (s <= t) ? (b_t + c4[e2]) : -INFINITY; dm[st][4 * g + e2] = dv; mx = fmaxf(mx, dv); }
        }
    mx = fmaxf(mx, __shfl_xor(mx, 32));
    const float w_inter = __expf(inter - mx);
    float den = 0.f;
#pragma unroll
    for (int st = 0; st < 2; ++st)
#pragma unroll
        for (int r = 0; r < 16; ++r) { const float qk = sT[st][r] * __expf(dm[st][r] - mx); sT[st][r] = qk; den += qk; }
    den += __shfl_xor(den, 32);
    f32x16 acc[3];
    const bf16_t* CST = (const bf16_t*)(p.ws + WS_CST) + (size_t)unit * 4160;
#pragma unroll
    for (int et = 0; et < 3; ++et) {
        f32x16 a;
#pragma unroll
        for (int r = 0; r < 16; ++r) a[r] = 0.f;
#pragma unroll
        for (int d0 = 0; d0 < 4; ++d0) {
            const bf16x8 cf = *(const bf16x8*)(CST + (32 * et + r32) * 64 + 16 * d0 + 8 * hi);
            a = __builtin_amdgcn_mfma_f32_32x32x16_bf16(cf, qf[d0], a, 0, 0, 0);
        }
        acc[et] = a;
    }
    const float qn = __shfl(acc[2][0], r32);
#pragma unroll
    for (int et = 0; et < 2; ++et)
#pragma unroll
        for (int r = 0; r < 16; ++r) acc[et][r] *= w_inter;
#pragma unroll
    for (int st = 0; st < 2; ++st)
#pragma unroll
        for (int j = 0; j < 2; ++j) {
            u32x4 pw; pw.x = pk2(sT[st][8 * j + 0], sT[st][8 * j + 1]); pw.y = pk2(sT[st][8 * j + 2], sT[st][8 * j + 3]); pw.z = pk2(sT[st][8 * j + 4], sT[st][8 * j + 5]); pw.w = pk2(sT[st][8 * j + 6], sT[st][8 * j + 7]);
            const bf16x8 pb = __builtin_bit_cast(bf16x8, pw);
#pragma unroll
            for (int et = 0; et < 2; ++et) {
                const LAS unsigned char* vp = L + M3_VT + ((32 * et + r32) * MP + 32 * st + 16 * j + 4 * hi) * 2;
                const u32x2 lo = *(const LAS u32x2*)vp, hi2 = *(const LAS u32x2*)(vp + 16);
                u32x4 vw; vw.x = lo.x; vw.y = lo.y; vw.z = hi2.x; vw.w = hi2.y;
                acc[et] = __builtin_amdgcn_mfma_f32_32x32x16_bf16(__builtin_bit_cast(bf16x8, vw), pb, acc[et], 0, 0, 0);
            }
        }
    const float dtot = w_inter * qn + den, inv = 1.0f / fmaxf(fabsf(dtot), __expf(-mx));
    float ss = 0.f;
#pragma unroll
    for (int et = 0; et < 2; ++et)
#pragma unroll
        for (int g = 0; g < 4; ++g) {
            const u32x2 xw = *(const u32x2*)(PROJ + row * NIN + C_XO + 64 * h + 32 * et + 8 * g + 4 * hi);
            const float xo[4] = {bflo(xw.x), bfhi(xw.x), bflo(xw.y), bfhi(xw.y)};
#pragma unroll
            for (int e2 = 0; e2 < 4; ++e2) { const float hv = acc[et][4 * g + e2] * inv / (1.f + __expf(-xo[e2])); acc[et][4 * g + e2] = hv; ss += hv * hv; }
        }
    ss += __shfl_xor(ss, 32);
    const float rs = rsqrtf(ss * (1.0f / 64.0f) + EPS);
    const float* nw = p.mlstm_norm + (size_t)layer * 256 + 64 * h;
    bf16_t* dst = (bf16_t*)(p.ws + WS_YCAT) + row * DM + 384 + 64 * h;
#pragma unroll
    for (int et = 0; et < 2; ++et)
#pragma unroll
        for (int g = 0; g < 4; ++g) {
            const f32x4 nv = *(const f32x4*)(nw + 32 * et + 8 * g + 4 * hi);
            u32x2 w; w.x = pk2(acc[et][4 * g] * rs * nv[0], acc[et][4 * g + 1] * rs * nv[1]); w.y = pk2(acc[et][4 * g + 2] * rs * nv[2], acc[et][4 * g + 3] * rs * nv[3]);
            *(u32x2*)(dst + 32 * et + 8 * g + 4 * hi) = w;
        }
    __syncthreads();
}

__global__ void __launch_bounds__(NTHR, 2) hybrid_fwd(Params p0) {
    extern __shared__ __attribute__((aligned(16))) unsigned char lds_raw[];
    LAS unsigned char* lds = (LAS unsigned char*)lds_raw;
    cg::grid_group grid = cg::this_grid();
    const int lo = p0.ph_lo, hi = p0.ph_hi;
    if (threadIdx.x < 16) ((LAS unsigned*)(lds + BAR_LDS_OFF))[threadIdx.x] = 0u;
    __syncthreads();
    XcdBarrier xbar; xbar.bar = (unsigned*)(p0.ws + WS_CTL) + 4096; xbar.x = 0; xbar.st = nullptr;
    if (hi - lo > 1) xbar = xcd_barrier_post((unsigned*)(p0.ws + WS_CTL) + 4096, (volatile LAS unsigned*)(lds + BAR_LDS_OFF));
#define IN(k) (lo <= (k) && (k) < hi)
#define SEAM(k) do { if (IN(k) && IN((k) + 1)) { if ((k) == 0) grid.sync(); else xcd_barrier(xbar); } } while (0)
#define PHASE_VARS() int tid = threadIdx.x; asm volatile("" : "+v"(tid)); const int lane = tid & 63, wave = __builtin_amdgcn_readfirstlane(tid >> 6); \
    int bid = (int)blockIdx.x; asm volatile("" : "+s"(bid)); const int G = (int)gridDim.x; Params p = p0; { unsigned char* w_ = p0.ws; asm volatile("" : "+s"(w_)); p.ws = w_; } unsigned char* ws = p.ws; (void)ws; (void)lane; (void)wave; (void)bid; (void)G
    if (IN(0)) { PHASE_VARS(); prologue(p, lds, tid, wave, lane); }
    SEAM(0);
#pragma unroll 1
    for (int layer = 0; layer < 2; ++layer) {
        const int P = 1 + 8 * layer;
        if (IN(P)) { PHASE_VARS(); EpiScaled<0> E{(bf16_t*)(ws + WS_PROJ), NIN, (const float*)(ws + WS_SSQ)}; run_gemm(lds, (const bf16_t*)(ws + WS_XB), (const bf16_t*)(ws + WS_WIN + layer * WIN_L), T, NIN, DM, E, bid); }
        SEAM(P);
        if (IN(P + 1)) { PHASE_VARS();
            for (int u = bid; u < 128 * 30; u += G) prep_unit(p, layer, u, lds, tid, wave, lane);
#if MIX_STAGE < 3
            { u32x4* y4 = (u32x4*)(ws + WS_YCAT); const u32x4 z = {0u, 0u, 0u, 0u}; for (size_t e = (size_t)bid * NTHR + tid; e < (size_t)T * DM / 8; e += (size_t)G * NTHR) y4[e] = z; }
#endif
        }
        SEAM(P + 1);
        if (IN(P + 2)) { PHASE_VARS();
#if MIX_STAGE >= 1
            for (int q = bid; q < 512; q += G) m1_quad(p, q, lds, tid, wave, lane);
#endif
#if MIX_STAGE >= 3
            for (int wu = bid * 8 + wave; wu < 3072; wu += G * 8) sel_wave_unit(p, wu, lane);
#endif
        }
        SEAM(P + 2);
        if (IN(P + 3)) { PHASE_VARS();
            for (int u = bid; u < 65 + 512 + 3360; u += G) {
                if (u < 65) {
#if MIX_STAGE >= 1
                    scan_unit(p, u, tid);
#endif
                } else if (u < 577) {
#if MIX_STAGE >= 2
                    swa_unit(p, layer, u - 65, lds, tid, wave, lane);
#endif
                } else {
#if MIX_STAGE >= 3
                    moba_sel_unit(p, u - 577, lds, tid, wave, lane);
#endif
                }
            }
        }
        SEAM(P + 3);
        if (IN(P + 4)) { PHASE_VARS();
            for (int u = bid; u < 768 + 512; u += G) {
                if (u < 768) {
#if MIX_STAGE >= 3
                    moba_own_unit(p, u, lds, tid, wave, lane);
#endif
                } else {
#if MIX_STAGE >= 1
                    m3_quad(p, layer, u - 768, lds, tid, wave, lane);
#endif
                }
            }
        }
        SEAM(P + 4);
        if (IN(P + 5)) { PHASE_VARS(); EpiRes E{layer == 0 ? p.x : (const float*)p.out, p.out, (bf16_t*)(ws + WS_XB), (float*)(ws + WS_SSQ)}; run_gemm(lds, (const bf16_t*)(ws + WS_YCAT), (const bf16_t*)(ws + WS_WOUT + layer * WOUT_L), T, DM, DM, E, bid); }
        SEAM(P + 5);
        if (IN(P + 6)) { PHASE_VARS(); EpiScaled<1> E{(bf16_t*)(ws + WS_H), FF, (const float*)(ws + WS_SSQ)}; run_gemm(lds, (const bf16_t*)(ws + WS_XB), (const bf16_t*)(ws + WS_WUP + layer * WUP_L), T, FF, DM, E, bid); }
        SEAM(P + 6);
        if (IN(P + 7)) { PHASE_VARS(); EpiRes E{(const float*)p.out, p.out, layer == 0 ? (bf16_t*)(ws + WS_XB) : nullptr, layer == 0 ? (float*)(ws + WS_SSQ) : nullptr}; run_gemm(lds, (const bf16_t*)(ws + WS_H), (const bf16_t*)(ws + WS_WDN + layer * WDN_L), T, DM, FF, E, bid); }
        SEAM(P + 7);
    }
#undef IN
#undef SEAM
}

#ifndef N_LAUNCH_SPLIT
#define N_LAUNCH_SPLIT 0
#endif
extern "C" void kernel_launch(void* const* d_in, const int* in_sizes, int n_in, void* d_out, int out_size, void* d_ws, size_t ws_size, hipStream_t stream) {
    static int grid = 0;
    if (grid == 0) {
        if (n_in != 17 || in_sizes[0] != T * DM || out_size != T * DM || ws_size < WS_END) { fprintf(stderr, "kernel_launch: unexpected shapes (n_in %d, in0 %d, out %d, ws %zu); nothing launched\n", n_in, n_in > 0 ? in_sizes[0] : -1, out_size, ws_size); grid = -1; return; }
        int dev = 0, cus = 0, per_cu = 0;
        if (hipGetDevice(&dev) != hipSuccess || hipDeviceGetAttribute(&cus, hipDeviceAttributeMultiprocessorCount, dev) != hipSuccess) { grid = -1; return; }
        if (hipFuncSetAttribute((const void*)hybrid_fwd, hipFuncAttributeMaxDynamicSharedMemorySize, LDS_BYTES) != hipSuccess) { fprintf(stderr, "kernel_launch: hipFuncSetAttribute failed\n"); grid = -1; return; }
        if (hipOccupancyMaxActiveBlocksPerMultiprocessor(&per_cu, (const void*)hybrid_fwd, NTHR, LDS_BYTES) != hipSuccess || per_cu < 1) { fprintf(stderr, "kernel_launch: occupancy query says %d blocks per CU\n", per_cu); (void)hipGetLastError(); grid = -1; return; }
        grid = cus;
    }
    if (grid < 0) return;
    if (hipMemsetAsync((char*)d_ws + WS_CTL, 0, 65536, stream) != hipSuccess) { fprintf(stderr, "kernel_launch: memset of the barrier words failed\n"); return; }
    Params p{};
    const float** pp = (const float**)&p;
    for (int i = 0; i < 17; ++i) pp[i] = (const float*)d_in[i];
    p.out = (float*)d_out; p.ws = (unsigned char*)d_ws;
#if N_LAUNCH_SPLIT
    for (int ph = 0; ph < 17; ++ph) {
        p.ph_lo = ph; p.ph_hi = ph + 1; void* args[] = {&p};
        hipError_t e = hipLaunchCooperativeKernel((const void*)hybrid_fwd, dim3(grid), dim3(NTHR), args, LDS_BYTES, stream);
        if (e != hipSuccess) { fprintf(stderr, "cooperative launch failed: %s\n", hipGetErrorString(e)); break; }
    }
#else
    p.ph_lo = 0; p.ph_hi = 17; void* args[] = {&p};
    hipError_t e = hipLaunchCooperativeKernel((const void*)hybrid_fwd, dim3(grid), dim3(NTHR), args, LDS_BYTES, stream);
    if (e != hipSuccess) fprintf(stderr, "cooperative launch failed: %s (grid %d)\n", hipGetErrorString(e), grid);
#endif
}
```

```cpp
#include <hip/hip_runtime.h>
#include <hip/hip_cooperative_groups.h>
#include <cstdio>
#include <cstdint>
namespace cg = cooperative_groups;
namespace pg8 {
#define PG8_LAS __attribute__((address_space(3)))
typedef unsigned short bf16_t;
typedef short bf16x8 __attribute__((ext_vector_type(8)));
typedef float f32x4 __attribute__((ext_vector_type(4)));
typedef unsigned u32x4 __attribute__((ext_vector_type(4)));
constexpr int BM = 256, BK = 64, HALF = 128, HTB = HALF * BK * 2  , STAGE_BYTES = 8 * HTB, NXCD = 8, WGM = 8;

__host__ __device__ __forceinline__ int lds_byte(int r, int c) { const int st = (r >> 4) * 2 + (c >> 5), rr = r & 15, cc = c & 31, ob = rr * 64 + cc * 2; return st * 1024 + (ob ^ (((ob >> 9) & 1) << 5)); }
__host__ __device__ __forceinline__ void stage_rc(int b, int& R, int& C) { const int st = b / 1024, sb = b % 1024, swz = sb ^ (((sb >> 9) & 1) << 5); R = (st >> 1) * 16 + swz / 64; C = (st & 1) * 32 + (swz % 64) / 2; }
__host__ __device__ __forceinline__ int perm32(int rho) { const int n = rho >> 4, i = rho & 15; return 8 * (i >> 2) + 4 * n + (i & 3); }

struct Unit { int pm, pn; };
struct Gemm { const bf16_t* A; const bf16_t* Bt; int M, N, K; };

struct StaticOrder {
    int nM, nN, nwg, G, c;
    __host__ __device__ void init(int M, int N, int G_, int c_) { nM = M / BM; nN = N / BM; nwg = nM * nN; G = G_; c = c_; }
    __host__ __device__ bool next(int i, Unit& u) const {
        const long L = (long)i * G + c; if (L >= nwg) return false;
        int wgid = (int)L; { const int q = nwg / NXCD, r = nwg % NXCD, xcd = wgid % NXCD, off = wgid / NXCD; wgid = (xcd < r ? xcd * (q + 1) : r * (q + 1) + (xcd - r) * q) + off; }
        const int nig = WGM * nN, gid = wgid / nig, fm = gid * WGM, gsz = (nM - fm) < WGM ? (nM - fm) : WGM;
        u.pm = fm + ((wgid % nig) % gsz); u.pn = (wgid % nig) / gsz; return true;
    }
    __device__ __forceinline__ void a_ready(const Unit&) const {}
    __device__ __forceinline__ void done(const Unit&) const {}
};
__device__ __forceinline__ unsigned cvt_pk_bf16(float lo, float hi) { unsigned r; asm volatile("v_cvt_pk_bf16_f32 %0, %1, %2" : "=v"(r) : "v"(lo), "v"(hi)); return r; }
typedef float f32x2 __attribute__((ext_vector_type(2)));
template <class Epi, class Sched, bool ALIGN_EPI = false, bool SP2 = false>
__device__ __forceinline__ void gemm_phase(PG8_LAS unsigned char* lds, const Gemm g, const Sched& S, const Epi& E) {
    int tid_l = threadIdx.x; asm volatile("" : "+v"(tid_l)); const int tid = tid_l, wid = __builtin_amdgcn_readfirstlane(tid >> 6), lane = tid & 63, wr = wid >> 2, wc = wid & 3, fr = lane & 15, fq = lane >> 4;
    const int K = g.K, nt = K / BK;
    unsigned voffA[2], voffB[2];
#pragma unroll
    for (int i = 0; i < 2; ++i) { int R, C; stage_rc(tid * 16 + i * 8192, R, C); const int Rb = Epi::PERM ? ((R & ~31) + perm32(R & 31)) : R;
        voffA[i] = (unsigned)(R * K + C) * 2u; voffB[i] = (unsigned)(Rb * K + C) * 2u; }
    const size_t kstep = (size_t)(BK * 2);
    const size_t hstep = (size_t)HALF * K * 2;
    const size_t tstep = 2 * hstep;
    const unsigned ldsw = (unsigned)wid * 1024u;
    const int aoff = lds_byte(wr * 64 + fr, fq * 8), boff = lds_byte(wc * 32 + fr, fq * 8);
#define PG8_SA(b, h) (((b) * 2 + (h)) * HTB)
#define PG8_SB(b, h) ((4 + (b) * 2 + (h)) * HTB)
#define PG8_STAGE(bufoff, gbase, voff) do { _Pragma("unroll") for (int _i = 0; _i < 2; ++_i) \
        __builtin_amdgcn_global_load_lds((const unsigned*)((const char*)(gbase) + (voff)[_i]), (PG8_LAS unsigned*)(lds + (bufoff) + ldsw + _i * 8192), 16, 0, 0); } while (0)
#define PG8_LDA(dst, b, h) do { _Pragma("unroll") for (int m = 0; m < 4; ++m) _Pragma("unroll") for (int k = 0; k < 2; ++k) dst[m][k] = *(const PG8_LAS bf16x8*)(lds + PG8_SA(b, h) + aoff + m * 2048 + k * 1024); } while (0)
#define PG8_LDB(dst, b, h) do { _Pragma("unroll") for (int n = 0; n < 2; ++n) _Pragma("unroll") for (int k = 0; k < 2; ++k) dst[n][k] = *(const PG8_LAS bf16x8*)(lds + PG8_SB(b, h) + boff + n * 2048 + k * 1024); } while (0)
#define PG8_MMA(ai, bj, At, Bt) do { __builtin_amdgcn_s_setprio(1); _Pragma("unroll") for (int m = 0; m < 4; ++m) _Pragma("unroll") for (int n = 0; n < 2; ++n) _Pragma("unroll") for (int k = 0; k < 2; ++k) \
        acc[ai][bj][m][n] = __builtin_amdgcn_mfma_f32_16x16x32_bf16(Bt[n][k], At[m][k], acc[ai][bj][m][n], 0, 0, 0); __builtin_amdgcn_s_setprio(0); } while (0)
#define PG8_WAIT_V(n) asm volatile("s_waitcnt vmcnt(" #n ")" ::: "memory")
#define PG8_WAIT_L(n) asm volatile("s_waitcnt lgkmcnt(" #n ")" ::: "memory")
#define PG8_BAR __builtin_amdgcn_s_barrier()
#define PG8_SCHED __builtin_amdgcn_sched_barrier(0)
    Unit cur, nxt; int ui = 0;
    if (!S.next(0, cur)) return;
    f32x4 acc[2][2][4][2];
#pragma unroll
    for (int a = 0; a < 2; ++a)
#pragma unroll
        for (int b = 0; b < 2; ++b)
#pragma unroll
            for (int m = 0; m < 4; ++m)
#pragma unroll
                for (int n = 0; n < 2; ++n) acc[a][b][m][n] = (f32x4){0.f, 0.f, 0.f, 0.f};
    bf16x8 At[4][2], B0[2][2], B1[2][2];
    const char* cA = (const char*)g.A + (size_t)cur.pm * tstep; const char* cB = (const char*)g.Bt + (size_t)cur.pn * tstep;
    S.a_ready(cur);
    if constexpr (SP2) {
        PG8_STAGE(PG8_SB(0, 0), cB, voffB); PG8_STAGE(PG8_SB(0, 1), cB + hstep, voffB); PG8_STAGE(PG8_SA(0, 0), cA, voffA); PG8_STAGE(PG8_SA(0, 1), cA + hstep, voffA);
        if (wr == 1) PG8_BAR;
        PG8_WAIT_V(2); PG8_BAR;
        PG8_STAGE(PG8_SB(1, 0), cB + kstep, voffB); PG8_STAGE(PG8_SA(1, 0), cA + kstep, voffA); PG8_STAGE(PG8_SB(1, 1), cB + hstep + kstep, voffB);
        PG8_WAIT_V(6); PG8_BAR;
    } else {
        PG8_STAGE(PG8_SB(0, 0), cB, voffB); PG8_STAGE(PG8_SA(0, 0), cA, voffA); PG8_STAGE(PG8_SB(0, 1), cB + hstep, voffB); PG8_STAGE(PG8_SA(0, 1), cA + hstep, voffA);
        if (wr == 1) PG8_BAR;
        PG8_WAIT_V(4); PG8_BAR;
        PG8_STAGE(PG8_SB(1, 0), cB + kstep, voffB); PG8_STAGE(PG8_SA(1, 0), cA + kstep, voffA); PG8_STAGE(PG8_SB(1, 1), cB + hstep + kstep, voffB);
        PG8_WAIT_V(6); PG8_BAR;
    }
    for (;;) {
        const bool has_next = S.next(ui + 1, nxt);
        const char* nA = has_next ? (const char*)g.A + (size_t)nxt.pm * tstep : cA; const char* nB = has_next ? (const char*)g.Bt + (size_t)nxt.pn * tstep : cB;
        for (int t = 0; t < nt; t += 2) {
            const bool last = (t == nt - 2);
            const char* a1 = cA + (size_t)(t + 1) * kstep;
            const char* a2 = last ? nA : cA + (size_t)(t + 2) * kstep; const char* b2 = last ? nB : cB + (size_t)(t + 2) * kstep;
            const char* a3 = a2 + kstep; const char* b3 = b2 + kstep;
            if (last && has_next) S.a_ready(nxt);
            if constexpr (SP2) {
            PG8_LDB(B0, 0, 0); PG8_LDB(B1, 0, 1); PG8_SCHED; PG8_LDA(At, 0, 0); PG8_STAGE(PG8_SA(1, 1), a1 + hstep, voffA);
            PG8_WAIT_V(8); PG8_WAIT_L(0); PG8_BAR; PG8_MMA(0, 0, At, B0); PG8_MMA(0, 1, At, B1); PG8_BAR; PG8_SCHED;
            PG8_LDA(At, 0, 1); PG8_STAGE(PG8_SB(0, 0), b2, voffB); PG8_STAGE(PG8_SB(0, 1), b2 + hstep, voffB); PG8_STAGE(PG8_SA(0, 0), a2, voffA);
            PG8_WAIT_V(8); PG8_WAIT_L(0); PG8_BAR; PG8_MMA(1, 0, At, B0); PG8_MMA(1, 1, At, B1); PG8_BAR; PG8_SCHED;
            PG8_LDB(B0, 1, 0); PG8_LDB(B1, 1, 1); PG8_SCHED; PG8_LDA(At, 1, 0); PG8_STAGE(PG8_SA(0, 1), a2 + hstep, voffA);
            PG8_WAIT_V(8); PG8_WAIT_L(0); PG8_BAR; PG8_MMA(0, 0, At, B0); PG8_MMA(0, 1, At, B1); PG8_BAR; PG8_SCHED;
            PG8_LDA(At, 1, 1); PG8_STAGE(PG8_SB(1, 0), b3, voffB); PG8_STAGE(PG8_SB(1, 1), b3 + hstep, voffB); PG8_STAGE(PG8_SA(1, 0), a3, voffA);
            PG8_WAIT_V(8); PG8_WAIT_L(0); PG8_BAR; PG8_MMA(1, 0, At, B0); PG8_MMA(1, 1, At, B1); PG8_BAR; PG8_SCHED;
            } else {
            PG8_LDB(B0, 0, 0); PG8_SCHED; PG8_LDA(At, 0, 0); PG8_STAGE(PG8_SA(1, 1), a1 + hstep, voffA);
            PG8_WAIT_L(8); PG8_BAR; PG8_WAIT_L(0); PG8_MMA(0, 0, At, B0); PG8_BAR; PG8_SCHED;
            PG8_LDB(B1, 0, 1); PG8_STAGE(PG8_SB(0, 0), b2, voffB);
            PG8_BAR; PG8_WAIT_L(0); PG8_MMA(0, 1, At, B1); PG8_BAR;
            PG8_LDA(At, 0, 1); PG8_STAGE(PG8_SA(0, 0), a2, voffA);
            PG8_BAR; PG8_WAIT_L(0); PG8_MMA(1, 0, At, B0); PG8_BAR; PG8_SCHED;
            PG8_STAGE(PG8_SB(0, 1), b2 + hstep, voffB);
            PG8_WAIT_V(6); PG8_BAR; PG8_MMA(1, 1, At, B1); PG8_BAR;
            PG8_LDB(B0, 1, 0); PG8_SCHED; PG8_LDA(At, 1, 0); PG8_STAGE(PG8_SA(0, 1), a2 + hstep, voffA);
            PG8_WAIT_L(8); PG8_BAR; PG8_WAIT_L(0); PG8_MMA(0, 0, At, B0); PG8_BAR; PG8_SCHED;
            PG8_LDB(B1, 1, 1); PG8_STAGE(PG8_SB(1, 0), b3, voffB);
            PG8_BAR; PG8_WAIT_L(0); PG8_MMA(0, 1, At, B1); PG8_BAR;
            PG8_LDA(At, 1, 1); PG8_STAGE(PG8_SA(1, 0), a3, voffA);
            PG8_BAR; PG8_WAIT_L(0); PG8_MMA(1, 0, At, B0); PG8_BAR; PG8_SCHED;
            PG8_STAGE(PG8_SB(1, 1), b3 + hstep, voffB);
            PG8_WAIT_V(6); PG8_BAR; PG8_MMA(1, 1, At, B1); PG8_BAR;
            }
        }
        if constexpr (ALIGN_EPI) { if (wr == 0) PG8_BAR; }
        if constexpr (!Epi::AFTER_DRAIN) { E(acc, cur, wr, wc, fr, fq); S.done(cur); }
        if (!has_next) break;
#pragma unroll
        for (int a = 0; a < 2; ++a)
#pragma unroll
            for (int b = 0; b < 2; ++b)
#pragma unroll
                for (int m = 0; m < 4; ++m)
#pragma unroll
                    for (int n = 0; n < 2; ++n) acc[a][b][m][n] = (f32x4){0.f, 0.f, 0.f, 0.f};
        cur = nxt; cA = nA; cB = nB; ++ui;
        if constexpr (ALIGN_EPI) { if (wr == 1) PG8_BAR; }
    }
    PG8_WAIT_V(0);
    if constexpr (!ALIGN_EPI) { if (wr == 0) PG8_BAR; }
    PG8_BAR;
    if constexpr (Epi::AFTER_DRAIN) { E.fused(acc, cur, wr, wc, fr, fq, lds, wid, lane); S.done(cur); }
#undef PG8_SA
#undef PG8_SB
#undef PG8_STAGE
#undef PG8_LDA
#undef PG8_LDB
#undef PG8_MMA
#undef PG8_WAIT_V
#undef PG8_WAIT_L
#undef PG8_BAR
#undef PG8_SCHED
}
}

#ifndef MIX_STAGE
#define MIX_STAGE 3
#endif
using pg8::bf16_t; using pg8::bf16x8; using pg8::f32x4; using pg8::u32x4; using pg8::f32x2;
#define LAS __attribute__((address_space(3)))
typedef float f32x16 __attribute__((ext_vector_type(16)));
typedef unsigned u32x2 __attribute__((ext_vector_type(2)));
typedef __bf16 bf16x2_t __attribute__((ext_vector_type(2)));

constexpr int NB = 2, S = 16384, T = NB * S, DM = 1024, NIN = 2816, INW = 2824, FF = 4096;
constexpr int C_MQ = 0, C_MK = 384, C_MV = 768, C_SQ = 1152, C_SK = 1536, C_SV = 1664, C_XQK = 1792, C_XV = 2304, C_XO = 2560;
constexpr float EPS = 1e-6f;
constexpr float LOG2E = 1.4426950408889634f;
constexpr float QSCALE = 0.125f * LOG2E;
constexpr int NTHR = 512;

constexpr size_t MiB = 1ull << 20;
constexpr size_t WS_WIN = 1 * MiB, WIN_L = (size_t)NIN * DM * 2;
constexpr size_t WS_WOUT = 12 * MiB, WOUT_L = (size_t)DM * DM * 2;
constexpr size_t WS_WUP = 16 * MiB, WUP_L = (size_t)FF * DM * 2;
constexpr size_t WS_WDN = 32 * MiB, WDN_L = (size_t)DM * FF * 2;
constexpr size_t WS_WG = 48 * MiB;
constexpr size_t WS_COS = 49 * MiB, WS_SIN = 51 * MiB;
constexpr size_t WS_SSQ = 53 * MiB;
constexpr size_t WS_GATES = 55 * MiB;
constexpr size_t WS_KMEAN = 56 * MiB;
constexpr size_t WS_SEL = 57 * MiB;
constexpr size_t WS_MISC = 58 * MiB;
constexpr size_t WS_PML = 59 * MiB;
constexpr size_t WS_XB = 64 * MiB;
constexpr size_t WS_DC = 64 * MiB;
constexpr size_t WS_CST = 97 * MiB;
constexpr size_t WS_LQK = 128 * MiB;
constexpr size_t WS_YCAT = 160 * MiB;
constexpr size_t WS_PROJ = 224 * MiB;
constexpr size_t WS_PARTO = 400 * MiB;
constexpr size_t WS_H = 224 * MiB;
constexpr size_t WS_END = 480 * MiB;
static_assert(WS_WIN + 2 * WIN_L <= WS_WOUT && WS_DC + (size_t)2048 * 4160 * 4 <= WS_CST && WS_CST + (size_t)2049 * 4160 * 2 <= WS_LQK, "ws map");
static_assert(WS_PROJ + (size_t)T * NIN * 2 <= WS_PARTO && WS_PARTO + (size_t)12 * S * 3 * 64 * 2 <= WS_END && WS_H + (size_t)T * FF * 2 <= WS_END, "ws map 2");

constexpr int LDS_BYTES = 147456, BAR_LDS_OFF = 131072 + 64;
constexpr size_t WS_CTL = 0;

struct Params {
    const float* x; const float* ln1; const float* w_in; const float* conv_w; const float* conv_b; const float* igate_b; const float* fgate_b;
    const float* mlstm_norm; const float* moba_q_norm; const float* moba_k_norm; const float* swa_q_norm; const float* swa_k_norm; const float* swa_sinks;
    const float* w_out; const float* ln2; const float* w_up; const float* w_down;
    float* out; unsigned char* ws; int ph_lo, ph_hi;
};

__device__ __forceinline__ float wave_sum(float v) {
#pragma unroll
    for (int o = 1; o < 64; o <<= 1) v += __shfl_xor(v, o);
    return v;
}
__device__ __forceinline__ float wave_max(float v) {
#pragma unroll
    for (int o = 1; o < 64; o <<= 1) v = fmaxf(v, __shfl_xor(v, o));
    return v;
}
__device__ __forceinline__ unsigned pk2(float lo, float hi) { f32x2 v = {lo, hi}; bf16x2_t b = __builtin_convertvector(v, bf16x2_t); return __builtin_bit_cast(unsigned, b); }
__device__ __forceinline__ float bflo(unsigned w) { return __uint_as_float(w << 16); }
__device__ __forceinline__ float bfhi(unsigned w) { return __uint_as_float(w & 0xffff0000u); }
__device__ __forceinline__ void unpack8(const u32x4 w, float (&v)[8]) {
    v[0] = bflo(w.x); v[1] = bfhi(w.x); v[2] = bflo(w.y); v[3] = bfhi(w.y); v[4] = bflo(w.z); v[5] = bfhi(w.z); v[6] = bflo(w.w); v[7] = bfhi(w.w);
}
__device__ __forceinline__ u32x4 pack8(const float (&v)[8]) { u32x4 w; w.x = pk2(v[0], v[1]); w.y = pk2(v[2], v[3]); w.z = pk2(v[4], v[5]); w.w = pk2(v[6], v[7]); return w; }
#define LDS_WAIT() asm volatile("s_waitcnt lgkmcnt(0)" ::: "memory")
__device__ __forceinline__ float exp2_fast(float v) { return __builtin_amdgcn_exp2f(v); }

__device__ __forceinline__ float row_rstd(const float* ssq, int row, int fq) {
    const f32x4 p = *(const f32x4*)(ssq + (size_t)row * 16 + 4 * fq);
    float s = (p[0] + p[1]) + (p[2] + p[3]); s += __shfl_xor(s, 16); s += __shfl_xor(s, 32);
    return rsqrtf(s * (1.0f / 1024.0f) + EPS);
}
template <int ACT  > struct EpiScaled {
    static constexpr bool PERM = true, AFTER_DRAIN = false;
    bf16_t* O; int ldc; const float* ssq;
    __device__ __forceinline__ void operator()(const f32x4 (&acc)[2][2][4][2], const pg8::Unit& u, int wr, int wc, int fr, int fq) const {
        const int row0 = u.pm * pg8::BM + wr * 64 + fr, col0 = u.pn * pg8::BM + wc * 32 + 8 * fq;
#pragma unroll
        for (int ai = 0; ai < 2; ++ai)
#pragma unroll
            for (int m = 0; m < 4; ++m) {
                const int row = row0 + ai * pg8::HALF + m * 16;
                const float rs = row_rstd(ssq, row, fq);
                bf16_t* rowp = O + (size_t)row * ldc + col0;
#pragma unroll
                for (int bj = 0; bj < 2; ++bj) {
                    f32x4 v0 = acc[ai][bj][m][0] * rs, v1 = acc[ai][bj][m][1] * rs;
                    if (ACT == 1) {
#pragma unroll
                        for (int i = 0; i < 4; ++i) { const float a = fmaxf(v0[i], 0.f), b = fmaxf(v1[i], 0.f); v0[i] = a * a; v1[i] = b * b; }
                    }
                    u32x4 w; w.x = pk2(v0[0], v0[1]); w.y = pk2(v0[2], v0[3]); w.z = pk2(v1[0], v1[1]); w.w = pk2(v1[2], v1[3]);
                    *(u32x4*)(rowp + bj * pg8::HALF) = w;
                }
            }
    }
};
struct EpiRes {
    static constexpr bool PERM = true, AFTER_DRAIN = false;
    const float* res; float* out; bf16_t* xb; float* ssq;
    __device__ __forceinline__ void operator()(const f32x4 (&acc)[2][2][4][2], const pg8::Unit& u, int wr, int wc, int fr, int fq) const {
        const int row0 = u.pm * pg8::BM + wr * 64 + fr, col0 = u.pn * pg8::BM + wc * 32 + 8 * fq;
#pragma unroll
        for (int ai = 0; ai < 2; ++ai)
#pragma unroll
            for (int m = 0; m < 4; ++m) {
                const int row = row0 + ai * pg8::HALF + m * 16;
                const size_t off = (size_t)row * DM + col0;
                float part = 0.f;
#pragma unroll
                for (int bj = 0; bj < 2; ++bj) {
                    const f32x4 r0 = *(const f32x4*)(res + off + bj * pg8::HALF), r1 = *(const f32x4*)(res + off + bj * pg8::HALF + 4);
                    const f32x4 v0 = acc[ai][bj][m][0] + r0, v1 = acc[ai][bj][m][1] + r1;
                    *(f32x4*)(out + off + bj * pg8::HALF) = v0; *(f32x4*)(out + off + bj * pg8::HALF + 4) = v1;
                    if (xb) { u32x4 w; w.x = pk2(v0[0], v0[1]); w.y = pk2(v0[2], v0[3]); w.z = pk2(v1[0], v1[1]); w.w = pk2(v1[2], v1[3]); *(u32x4*)(xb + off + bj * pg8::HALF) = w; }
                    part += (v0[0] * v0[0] + v0[1] * v0[1]) + (v0[2] * v0[2] + v0[3] * v0[3]) + (v1[0] * v1[0] + v1[1] * v1[1]) + (v1[2] * v1[2] + v1[3] * v1[3]);
                }
                part += __shfl_xor(part, 16); part += __shfl_xor(part, 32);
                if (ssq && fq == 0) ssq[(size_t)row * 16 + u.pn * 4 + wc] = part;
            }
    }
};
template <class Epi> __device__ __forceinline__ void run_gemm(LAS unsigned char* lds, const bf16_t* A, const bf16_t* Bt, int M, int N, int K, const Epi& E, int bid) {
    pg8::Gemm g{A, Bt, M, N, K}; pg8::StaticOrder so; so.init(M, N, (int)gridDim.x, bid);
    pg8::gemm_phase<Epi, pg8::StaticOrder, true, true>(lds, g, so, E);
}

__device__ __forceinline__ void transpose_item(const float* W, int K, int ld, int nblk, const float* scale, bf16_t* WT, LAS float* scr, int item, int lane) {
    const int kb = item / nblk, nb = item % nblk, k0 = 64 * kb, n0 = 32 * nb;
#pragma unroll 8
    for (int i = 0; i < 32; ++i) {
        const int kk = 2 * i + (lane >> 5); float v = W[(size_t)(k0 + kk) * ld + n0 + (lane & 31)];
        if (scale) v *= scale[k0 + kk];
        scr[kk * 33 + (lane & 31)] = v;
    }
    LDS_WAIT();
    const int c = lane & 7;
#pragma unroll
    for (int j = 0; j < 4; ++j) {
        const int n = (lane >> 3) + 8 * j; const LAS float* s = scr + (8 * c) * 33 + n;
        u32x4 o; o.x = pk2(s[0 * 33], s[1 * 33]); o.y = pk2(s[2 * 33], s[3 * 33]); o.z = pk2(s[4 * 33], s[5 * 33]); o.w = pk2(s[6 * 33], s[7 * 33]);
        *(u32x4*)(WT + (size_t)(n0 + n) * K + k0 + 8 * c) = o;
    }
    LDS_WAIT();
}
__device__ __forceinline__ void rope_entry(int pos, int i, float& cs, float& sn) {
    const double R = 0.74989420933245582730;
    double inv = 1.0; { double b = R; int e = i; while (e) { if (e & 1) inv *= b; b *= b; e >>= 1; } }
    const double ang = (double)pos * inv;
    const double n = __builtin_rint(ang * 0.63661977236758134308);
    double y = __builtin_fma(-n, 1.57079632679489655800, ang); y = __builtin_fma(-n, 6.12323399573676603587e-17, y);
    const double y2 = y * y;
    double sp = -1.0 / 1307674368000.0; sp = sp * y2 + 1.0 / 6227020800.0; sp = sp * y2 - 1.0 / 39916800.0; sp = sp * y2 + 1.0 / 362880.0; sp = sp * y2 - 1.0 / 5040.0;
    sp = sp * y2 + 1.0 / 120.0; sp = sp * y2 - 1.0 / 6.0; sp = sp * y2 + 1.0; const double sy = sp * y;
    double cp = 1.0 / 20922789888000.0; cp = cp * y2 - 1.0 / 87178291200.0; cp = cp * y2 + 1.0 / 479001600.0; cp = cp * y2 - 1.0 / 3628800.0; cp = cp * y2 + 1.0 / 40320.0;
    cp = cp * y2 - 1.0 / 720.0; cp = cp * y2 + 1.0 / 24.0; cp = cp * y2 - 0.5; const double cy = cp * y2 + 1.0;
    const int q = (int)((long long)n & 3);
    const double s_ = (q == 0) ? sy : (q == 1) ? cy : (q == 2) ? -sy : -cy;
    const double c_ = (q == 0) ? cy : (q == 1) ? -sy : (q == 2) ? -cy : sy;
    cs = (float)c_; sn = (float)s_;
}
__device__ __forceinline__ void prologue(const Params& p, LAS unsigned char* lds, int tid, int wave, int lane) {
    unsigned char* ws = p.ws;
    const int G = (int)gridDim.x, gw = (int)blockIdx.x * 8 + wave, NGW = G * 8;
    LAS float* scr = (LAS float*)(lds + wave * 8704);
    constexpr int I_IN = 16 * 88, I_OUT = 16 * 32, I_UP = 16 * 128, I_DN = 64 * 32, I_L = I_IN + I_OUT + I_UP + I_DN;
    for (int it = gw; it < 2 * I_L; it += NGW) {
        const int l = it / I_L; int r = it % I_L;
        if (r < I_IN) { transpose_item(p.w_in + (size_t)l * DM * INW, DM, INW, 88, p.ln1 + l * DM, (bf16_t*)(ws + WS_WIN + l * WIN_L), scr, r, lane); continue; } r -= I_IN;
        if (r < I_OUT) { transpose_item(p.w_out + (size_t)l * DM * DM, DM, DM, 32, nullptr, (bf16_t*)(ws + WS_WOUT + l * WOUT_L), scr, r, lane); continue; } r -= I_OUT;
        if (r < I_UP) { transpose_item(p.w_up + (size_t)l * DM * FF, DM, FF, 128, p.ln2 + l * DM, (bf16_t*)(ws + WS_WUP + l * WUP_L), scr, r, lane); continue; } r -= I_UP;
        transpose_item(p.w_down + (size_t)l * FF * DM, FF, DM, 32, nullptr, (bf16_t*)(ws + WS_WDN + l * WDN_L), scr, r, lane);
    }
    { float* WG = (float*)(ws + WS_WG);
      for (int e = (int)blockIdx.x * NTHR + tid; e < 2 * 8 * DM; e += G * NTHR) { const int l = e >> 13, c = (e >> 10) & 7, k = e & 1023; WG[e] = p.ln1[l * DM + k] * p.w_in[((size_t)l * DM + k) * INW + NIN + c]; } }
    { float* COS = (float*)(ws + WS_COS); float* SIN = (float*)(ws + WS_SIN);
      for (int e = (int)blockIdx.x * NTHR + tid; e < S * 32; e += G * NTHR) { float c, s; rope_entry(e >> 5, e & 31, c, s); COS[e] = c; SIN[e] = s; } }
    { bf16_t* XB = (bf16_t*)(ws + WS_XB); float* SSQ = (float*)(ws + WS_SSQ);
      for (int m = gw; m < T; m += NGW) {
          const f32x4* xr = (const f32x4*)(p.x + (size_t)m * DM) + lane; f32x4 v[4]; float s = 0.f;
#pragma unroll
          for (int j = 0; j < 4; ++j) { v[j] = xr[64 * j]; s += (v[j][0] * v[j][0] + v[j][1] * v[j][1]) + (v[j][2] * v[j][2] + v[j][3] * v[j][3]); }
          s = wave_sum(s);
          u32x2* o8 = (u32x2*)(XB + (size_t)m * DM) + lane;
#pragma unroll
          for (int j = 0; j < 4; ++j) { u32x2 w; w.x = pk2(v[j][0], v[j][1]); w.y = pk2(v[j][2], v[j][3]); o8[64 * j] = w; }
          if (lane < 16) SSQ[(size_t)m * 16 + lane] = (lane == 0) ? s : 0.f;
      } }
}

__device__ __forceinline__ void prep_unit(const Params& p, int layer, int u, LAS unsigned char* lds, int tid, int wave, int lane) {
    unsigned char* ws = p.ws;
    const int blk = u / 30, job = u % 30;
    const int row0 = blk * 256, b = blk >> 6, pos0 = (blk & 63) * 256;
    bf16_t* PROJ = (bf16_t*)(ws + WS_PROJ);
    const int c = lane & 7, tl = lane >> 3;
    if (job < 20) {
        int col; const float* gw; float scale; bool iskm = false; int kh = 0;
        if (job < 6) { col = C_MQ + 64 * job; gw = p.moba_q_norm + layer * 64; scale = QSCALE; }
        else if (job < 12) { kh = job - 6; col = C_MK + 64 * kh; gw = p.moba_k_norm + layer * 64; scale = 1.f; iskm = true; }
        else if (job < 18) { col = C_SQ + 64 * (job - 12); gw = p.swa_q_norm + layer * 64; scale = QSCALE; }
        else { col = C_SK + 64 * (job - 18); gw = p.swa_k_norm + layer * 64; scale = 1.f; }
        float gv[8]; { const f32x4 g0 = *(const f32x4*)(gw + 8 * c), g1 = *(const f32x4*)(gw + 8 * c + 4); gv[0] = g0[0]; gv[1] = g0[1]; gv[2] = g0[2]; gv[3] = g0[3]; gv[4] = g1[0]; gv[5] = g1[1]; gv[6] = g1[2]; gv[7] = g1[3]; }
        float ks[8];
#pragma unroll
        for (int e = 0; e < 8; ++e) ks[e] = 0.f;
        const float* COS = (const float*)(ws + WS_COS); const float* SIN = (const float*)(ws + WS_SIN);
#pragma unroll
        for (int it = 0; it < 4; ++it) {
            const int tt = 32 * wave + 8 * it + tl;
            bf16_t* ptr = PROJ + (size_t)(row0 + tt) * NIN + col + 8 * c;
            const u32x4 w = *(const u32x4*)ptr; float v[8]; unpack8(w, v);
            float ss = 0.f;
#pragma unroll
            for (int e = 0; e < 8; ++e) ss += v[e] * v[e];
            ss += __shfl_xor(ss, 1); ss += __shfl_xor(ss, 2); ss += __shfl_xor(ss, 4);
            const float rs = rsqrtf(ss * (1.0f / 64.0f) + EPS);
            const int pos = pos0 + tt;
            const f32x4 c0 = *(const f32x4*)(COS + (size_t)pos * 32 + 8 * (c & 3)), c1 = *(const f32x4*)(COS + (size_t)pos * 32 + 8 * (c & 3) + 4);
            const f32x4 s0 = *(const f32x4*)(SIN + (size_t)pos * 32 + 8 * (c & 3)), s1 = *(const f32x4*)(SIN + (size_t)pos * 32 + 8 * (c & 3) + 4);
            float o[8];
#pragma unroll
            for (int e = 0; e < 8; ++e) {
                const float val = v[e] * rs * gv[e]; const float pr = __shfl_xor(val, 4);
                const float cs = (e < 4) ? c0[e & 3] : c1[e & 3], sn = (e < 4) ? s0[e & 3] : s1[e & 3];
                o[e] = (c < 4) ? (val * cs - pr * sn) : (val * cs + pr * sn);
                ks[e] += o[e];
                o[e] *= scale;
            }
            *(u32x4*)ptr = pack8(o);
        }
        if (iskm) {
#pragma unroll
            for (int e = 0; e < 8; ++e) { ks[e] += __shfl_xor(ks[e], 8); ks[e] += __shfl_xor(ks[e], 16); ks[e] += __shfl_xor(ks[e], 32); }
            LAS float* red = (LAS float*)lds;
            if (tl == 0) {
#pragma unroll
                for (int e = 0; e < 8; ++e) red[wave * 64 + 8 * c + e] = ks[e];
            }
            __syncthreads();
            if (tid < 64) {
                float s = 0.f;
#pragma unroll
                for (int w8 = 0; w8 < 8; ++w8) s += red[w8 * 64 + tid];
                float* KM = (float*)(ws + WS_KMEAN);
                KM[((size_t)((b * 6 + kh) * 64 + (blk & 63))) * 64 + tid] = s * (1.0f / 256.0f);
            }
            __syncthreads();
        }
    } else if (job < 28) {
        const int cj = job - 20, col = C_XQK + 64 * cj; const float osc = (cj >= 4) ? 0.125f : 1.f;
        bf16_t* LQK = (bf16_t*)(ws + WS_LQK);
        float cw[4][8], cb[8];
#pragma unroll
        for (int jj = 0; jj < 4; ++jj) { const float* wp = p.conv_w + ((size_t)layer * 4 + jj) * 512 + 64 * cj + 8 * c; const f32x4 a = *(const f32x4*)wp, bq = *(const f32x4*)(wp + 4);
            cw[jj][0] = a[0]; cw[jj][1] = a[1]; cw[jj][2] = a[2]; cw[jj][3] = a[3]; cw[jj][4] = bq[0]; cw[jj][5] = bq[1]; cw[jj][6] = bq[2]; cw[jj][7] = bq[3]; }
        { const float* bp = p.conv_b + (size_t)layer * 512 + 64 * cj + 8 * c; const f32x4 a = *(const f32x4*)bp, bq = *(const f32x4*)(bp + 4);
          cb[0] = a[0]; cb[1] = a[1]; cb[2] = a[2]; cb[3] = a[3]; cb[4] = bq[0]; cb[5] = bq[1]; cb[6] = bq[2]; cb[7] = bq[3]; }
#pragma unroll
        for (int it = 0; it < 4; ++it) {
            const int tt = 32 * wave + 8 * it + tl, pos = pos0 + tt; const size_t row = (size_t)row0 + tt;
            float acc[8];
#pragma unroll
            for (int e = 0; e < 8; ++e) acc[e] = cb[e];
#pragma unroll
            for (int jj = 0; jj < 4; ++jj) {
                if (pos - 3 + jj >= 0) {
                    const u32x4 w = *(const u32x4*)(PROJ + (row - 3 + jj) * NIN + col + 8 * c); float v[8]; unpack8(w, v);
#pragma unroll
                    for (int e = 0; e < 8; ++e) acc[e] += cw[jj][e] * v[e];
                }
            }
            float o[8];
#pragma unroll
            for (int e = 0; e < 8; ++e) { const float y = acc[e]; o[e] = y / (1.f + __expf(-y)) * osc; }
            *(u32x4*)(LQK + row * 512 + 64 * cj + 8 * c) = pack8(o);
        }
    } else {
        const int gh = job - 28;
        const float* WG = (const float*)(ws + WS_WG) + (size_t)layer * 8 * DM + (size_t)gh * 4 * DM;
        const bf16_t* XB = (const bf16_t*)(ws + WS_XB); const float* SSQ = (const float*)(ws + WS_SSQ); float* GT = (float*)(ws + WS_GATES);
        float wg[4][16];
#pragma unroll
        for (int cc = 0; cc < 4; ++cc)
#pragma unroll
            for (int hf = 0; hf < 2; ++hf) { const float* wp = WG + cc * DM + 512 * hf + 8 * lane; const f32x4 a = *(const f32x4*)wp, bq = *(const f32x4*)(wp + 4);
                wg[cc][8 * hf + 0] = a[0]; wg[cc][8 * hf + 1] = a[1]; wg[cc][8 * hf + 2] = a[2]; wg[cc][8 * hf + 3] = a[3]; wg[cc][8 * hf + 4] = bq[0]; wg[cc][8 * hf + 5] = bq[1]; wg[cc][8 * hf + 6] = bq[2]; wg[cc][8 * hf + 7] = bq[3]; }
        float bias = 0.f; if (lane < 4) bias = (gh == 0) ? p.igate_b[layer * 4 + lane] : p.fgate_b[layer * 4 + lane];
#pragma unroll 1
        for (int rr = 0; rr < 32; ++rr) {
            const size_t row = (size_t)row0 + 32 * wave + rr;
            const u32x4 a0 = *(const u32x4*)(XB + row * DM + 8 * lane), a1 = *(const u32x4*)(XB + row * DM + 512 + 8 * lane);
            float xv[16]; { float t0[8], t1[8]; unpack8(a0, t0); unpack8(a1, t1);
#pragma unroll
                for (int e = 0; e < 8; ++e) { xv[e] = t0[e]; xv[8 + e] = t1[e]; } }
            float d[4];
#pragma unroll
            for (int cc = 0; cc < 4; ++cc) { float s = 0.f;
#pragma unroll
                for (int k = 0; k < 16; ++k) s += xv[k] * wg[cc][k];
                d[cc] = wave_sum(s); }
            float sp = SSQ[row * 16 + (lane & 15)]; sp += __shfl_xor(sp, 1); sp += __shfl_xor(sp, 2); sp += __shfl_xor(sp, 4); sp += __shfl_xor(sp, 8);
            const float rs = rsqrtf(sp * (1.0f / 1024.0f) + EPS);
            float dv = d[0]; dv = (lane == 1) ? d[1] : dv; dv = (lane == 2) ? d[2] : dv; dv = (lane == 3) ? d[3] : dv;
            if (lane < 4) GT[row * 8 + 4 * gh + lane] = dv * rs + bias;
        }
    }
}

#define RLX_AGENT __ATOMIC_RELAXED, __HIP_MEMORY_SCOPE_AGENT
#define XB_TMO      128
#define XB_XCNT(j)  (256  + 64 * (j))
#define XB_XSUB(j)  (1280 + 64 * (j))
#define XB_XGEN(j)  (2304 + 64 * (j))
#define XB_TOP      3328
#define XB_TOPGEN   3392
#define XCD_BAR_WORDS 3456
#define XB_SPIN_CAP (1u << 18)

__device__ __forceinline__ unsigned xb_ld(unsigned* p)              { return __hip_atomic_load(p, __ATOMIC_RELAXED, __HIP_MEMORY_SCOPE_AGENT); }
__device__ __forceinline__ unsigned xb_add(unsigned* p, unsigned v) { return __hip_atomic_fetch_add(p, v, __ATOMIC_RELAXED, __HIP_MEMORY_SCOPE_AGENT); }
__device__ __forceinline__ unsigned xb_xcc_id() { return (unsigned)__builtin_amdgcn_s_getreg((3 << 11) | 20) & 0xFu; }
#define XB_SPIN(cond, bar) do { unsigned _sp = 0; while (cond) { __builtin_amdgcn_s_sleep(1); \
    if ((++_sp & 255u) == 0u) { if (xb_ld(&(bar)[XB_TMO])) break; if (_sp > XB_SPIN_CAP) { atomicAdd(&(bar)[XB_TMO], 1u); break; } } } } while (0)

struct XcdBarrier {
    unsigned* bar; unsigned x;
    volatile LAS unsigned* st;
};

__device__ __forceinline__ XcdBarrier xcd_barrier_post(unsigned* bar, volatile LAS unsigned* st) {
    XcdBarrier b; b.bar = bar; b.x = xb_xcc_id(); b.st = st;
    if (threadIdx.x == 0) (void)xb_add(&bar[XB_XCNT(b.x)], 1u);
    return b;
}
__device__ __forceinline__ void xcd_barrier_complete(unsigned* bar, unsigned x, unsigned& nloc, unsigned& nx) {
    const unsigned G = gridDim.x * gridDim.y * gridDim.z;
    unsigned sum, cnt, mine, sp = 0u;
    for (;;) {
        sum = 0u; cnt = 0u; mine = 0u;
#pragma unroll
        for (unsigned j = 0; j < 16; ++j) { const unsigned c = xb_ld(&bar[XB_XCNT(j)]); sum += c; cnt += (c > 0u) ? 1u : 0u; mine = (j == x) ? c : mine; }
        if (sum == G) break;
        __builtin_amdgcn_s_sleep(1);
        if ((++sp & 255u) == 0u) { if (xb_ld(&bar[XB_TMO])) break; if (sp > XB_SPIN_CAP) { atomicAdd(&bar[XB_TMO], 1u); break; } }
    }
    nloc = mine > 0u ? mine : 1u; nx = cnt > 0u ? cnt : 1u;
}

__device__ __forceinline__ void xcd_barrier(const XcdBarrier& b) {
    asm volatile("s_waitcnt vmcnt(0)" ::: "memory");
    __syncthreads();
    if (threadIdx.x == 0) {
        unsigned* bar = b.bar;
        __builtin_amdgcn_s_waitcnt(0);
        unsigned nloc = b.st[0], nx = b.st[1];
        if (nloc == 0u) { xcd_barrier_complete(bar, b.x, nloc, nx); b.st[0] = nloc; b.st[1] = nx; }
        const unsigned old = xb_add(&bar[XB_XSUB(b.x)], 1u);
        const unsigned gen = old / nloc;
        if (old + 1u == (gen + 1u) * nloc) {
            __builtin_amdgcn_fence(__ATOMIC_RELEASE, "agent");
            asm volatile("s_waitcnt vmcnt(0)" ::: "memory");
            const unsigned og = xb_add(&bar[XB_TOP], 1u);
            const unsigned tg = og / nx;
            if (og + 1u == (tg + 1u) * nx) xb_add(&bar[XB_TOPGEN], 1u);
            else XB_SPIN(xb_ld(&bar[XB_TOPGEN]) == tg, bar);
            __builtin_amdgcn_fence(__ATOMIC_ACQUIRE, "agent");
            xb_add(&bar[XB_XGEN(b.x)], 1u);
            asm volatile("s_waitcnt vmcnt(0)" ::: "memory");
        } else {
            XB_SPIN(xb_ld(&bar[XB_XGEN(b.x)]) == gen, bar);
            __builtin_amdgcn_fence(__ATOMIC_ACQUIRE, "agent");
            asm volatile("s_waitcnt vmcnt(0)" ::: "memory");
        }
    }
    __syncthreads();
}

constexpr int KP = 72, VP = 260;
constexpr int AT_KS = 0, AT_VT = 256 * KP * 2, AT_LIST = AT_VT + 64 * VP * 2, AT_CNT = AT_LIST + 8192;
__device__ __forceinline__ void stage_kv256(LAS unsigned char* lds, const bf16_t* kb, const bf16_t* vb, long row0, long rowmin, int tid) {
#pragma unroll
    for (int i = 0; i < 4; ++i) {
        const int chunk = i * NTHR + tid, row = chunk >> 3, c8 = chunk & 7;
        long gr = row0 + row; gr = gr < rowmin ? rowmin : gr;
        const u32x4 kv = *(const u32x4*)(kb + gr * NIN + 8 * c8);
        const u32x4 vv = *(const u32x4*)(vb + gr * NIN + 8 * c8);
        *(LAS u32x4*)(lds + AT_KS + (row * KP + 8 * c8) * 2) = kv;
        LAS bf16_t* vt = (LAS bf16_t*)(lds + AT_VT) + (8 * c8) * VP + row;
        vt[0 * VP] = (bf16_t)(vv.x & 0xffffu); vt[1 * VP] = (bf16_t)(vv.x >> 16); vt[2 * VP] = (bf16_t)(vv.y & 0xffffu); vt[3 * VP] = (bf16_t)(vv.y >> 16);
        vt[4 * VP] = (bf16_t)(vv.z & 0xffffu); vt[5 * VP] = (bf16_t)(vv.z >> 16); vt[6 * VP] = (bf16_t)(vv.w & 0xffffu); vt[7 * VP] = (bf16_t)(vv.w >> 16);
    }
}
__device__ __forceinline__ void attn_tile(const LAS unsigned char* lds, const bf16x8 (&qf)[4], int kmin, int kmax, int r32, int hi, f32x16 (&o)[2], float& mrow, float& lrow) {
    const LAS unsigned char* kbase = lds + AT_KS + (r32 * KP + 8 * hi) * 2;
    const LAS unsigned char* vbase = lds + AT_VT + (r32 * VP + 4 * hi) * 2;
    const int klo = kmin - 4 * hi, khi = kmax - 4 * hi;
#pragma unroll
    for (int dt = 0; dt < 2; ++dt)
#pragma unroll
        for (int r = 0; r < 16; ++r) o[dt][r] = 0.f;
    float m = -INFINITY, l = 0.f;
#pragma unroll 1
    for (int kt = 0; kt < 8; ++kt) {
        f32x16 s;
#pragma unroll
        for (int r = 0; r < 16; ++r) s[r] = 0.f;
#pragma unroll
        for (int d0 = 0; d0 < 4; ++d0) {
            const bf16x8 kf = *(const LAS bf16x8*)(kbase + (32 * kt * KP + 16 * d0) * 2);
            s = __builtin_amdgcn_mfma_f32_32x32x16_bf16(kf, qf[d0], s, 0, 0, 0);
        }
        float tmx = -INFINITY;
#pragma unroll
        for (int r = 0; r < 16; ++r) {
            const int kv = 32 * kt + (r & 3) + 8 * (r >> 2);
            const float v = (kv >= klo && kv <= khi) ? s[r] : -INFINITY;
            s[r] = v; tmx = fmaxf(tmx, v);
        }
        tmx = fmaxf(tmx, __shfl_xor(tmx, 32));
        const float mn = fmaxf(m, tmx), mu = (mn == -INFINITY) ? 0.f : mn;
        const float sc = exp2_fast(m - mu);
        float sum = 0.f;
#pragma unroll
        for (int r = 0; r < 16; ++r) { const float pv = exp2_fast(s[r] - mu); s[r] = pv; sum += pv; }
        sum += __shfl_xor(sum, 32);
        l = l * sc + sum; m = mn;
#pragma unroll
        for (int dt = 0; dt < 2; ++dt)
#pragma unroll
            for (int r = 0; r < 16; ++r) o[dt][r] *= sc;
#pragma unroll
        for (int j = 0; j < 2; ++j) {
            u32x4 pw; pw.x = pk2(s[8 * j + 0], s[8 * j + 1]); pw.y = pk2(s[8 * j + 2], s[8 * j + 3]); pw.z = pk2(s[8 * j + 4], s[8 * j + 5]); pw.w = pk2(s[8 * j + 6], s[8 * j + 7]);
            const bf16x8 pb = __builtin_bit_cast(bf16x8, pw);
#pragma unroll
            for (int dt = 0; dt < 2; ++dt) {
                const LAS unsigned char* vp = vbase + (32 * dt * VP + 32 * kt + 16 * j) * 2;
                const u32x2 lo = *(const LAS u32x2*)vp, hi2 = *(const LAS u32x2*)(vp + 16);
                u32x4 vw; vw.x = lo.x; vw.y = lo.y; vw.z = hi2.x; vw.w = hi2.y;
                o[dt] = __builtin_amdgcn_mfma_f32_32x32x16_bf16(__builtin_bit_cast(bf16x8, vw), pb, o[dt], 0, 0, 0);
            }
        }
    }
    mrow = m; lrow = l;
}
__device__ __forceinline__ void store_orow_bf16(bf16_t* dst, const f32x16 (&o)[2], float sc, int hi) {
#pragma unroll
    for (int dt = 0; dt < 2; ++dt)
#pragma unroll
        for (int g = 0; g < 4; ++g) { u32x2 w; w.x = pk2(o[dt][4 * g] * sc, o[dt][4 * g + 1] * sc); w.y = pk2(o[dt][4 * g + 2] * sc, o[dt][4 * g + 3] * sc); *(u32x2*)(dst + 32 * dt + 8 * g + 4 * hi) = w; }
}
__device__ __forceinline__ void load_qf(bf16x8 (&qf)[4], const bf16_t* qrow, int hi) {
#pragma unroll
    for (int d0 = 0; d0 < 4; ++d0) qf[d0] = *(const bf16x8*)(qrow + 16 * d0 + 8 * hi);
}

__device__ __forceinline__ void swa_unit(const Params& p, int layer, int u, LAS unsigned char* lds, int tid, int wave, int lane) {
    const int kh = u & 1, n = (u >> 1) & 127, b = u >> 8;
    const bf16_t* PROJ = (const bf16_t*)(p.ws + WS_PROJ); bf16_t* YC = (bf16_t*)(p.ws + WS_YCAT);
    const long rowb = (long)b * S;
    stage_kv256(lds, PROJ + C_SK + 64 * kh, PROJ + C_SV + 64 * kh, rowb + 128 * (n - 1), rowb, tid);
    __syncthreads();
    const int r32 = lane & 31, hi = lane >> 5;
    for (int tl = wave; tl < 12; tl += 8) {
        const int qh = 3 * kh + (tl >> 2), rt = tl & 3, qi = 32 * rt + r32; const long row = rowb + 128 * n + qi;
        bf16x8 qf[4]; load_qf(qf, PROJ + row * NIN + C_SQ + 64 * qh, hi);
        int kmin = qi + 1; if (n == 0 && kmin < 128) kmin = 128;
        f32x16 o[2]; float m, l; attn_tile(lds, qf, kmin, qi + 128, r32, hi, o, m, l);
        l += exp2_fast(p.swa_sinks[layer * 6 + qh] * LOG2E - m);
        store_orow_bf16(YC + row * DM + 640 + 64 * qh, o, 1.0f / l, hi);
    }
    __syncthreads();
}

__device__ __forceinline__ void sel_wave_unit(const Params& p, int wu, int lane) {
    const int bh = wu >> 8, i = wu & 255, b = bh / 6, h = bh % 6, t0 = i * 64, blk = t0 >> 8;
    unsigned sel = 0xFFFFFFu;
    if (blk > 0) {
        const bf16_t* qp = (const bf16_t*)(p.ws + WS_PROJ) + ((size_t)b * S + t0 + lane) * NIN + C_MQ + 64 * h;
        float q[64];
#pragma unroll
        for (int c8 = 0; c8 < 8; ++c8) { const u32x4 w = *(const u32x4*)(qp + 8 * c8); float v[8]; unpack8(w, v);
#pragma unroll
            for (int e = 0; e < 8; ++e) q[8 * c8 + e] = v[e]; }
        float v0 = -INFINITY, v1 = -INFINITY, v2 = -INFINITY; unsigned i0 = 255u, i1 = 255u, i2 = 255u;
        const float* km = (const float*)(p.ws + WS_KMEAN) + (size_t)bh * 64 * 64;
        for (int j = 0; j < blk; ++j) {
            const f32x4* kr = (const f32x4*)(km + j * 64); float g0 = 0.f, g1 = 0.f;
#pragma unroll
            for (int d4 = 0; d4 < 16; d4 += 2) { const f32x4 ka = kr[d4], kb = kr[d4 + 1];
                g0 += q[4 * d4] * ka[0] + q[4 * d4 + 1] * ka[1] + q[4 * d4 + 2] * ka[2] + q[4 * d4 + 3] * ka[3];
                g1 += q[4 * d4 + 4] * kb[0] + q[4 * d4 + 5] * kb[1] + q[4 * d4 + 6] * kb[2] + q[4 * d4 + 7] * kb[3]; }
            const float g = g0 + g1; const unsigned ju = (unsigned)j;
            if (g > v0) { v2 = v1; i2 = i1; v1 = v0; i1 = i0; v0 = g; i0 = ju; }
            else if (g > v1) { v2 = v1; i2 = i1; v1 = g; i1 = ju; }
            else if (g > v2) { v2 = g; i2 = ju; }
        }
        sel = i0 | (i1 << 8) | (i2 << 16);
    }
    ((unsigned*)(p.ws + WS_SEL))[(size_t)bh * S + t0 + lane] = sel;
}
__device__ __forceinline__ void moba_sel_unit(const Params& p, int v, LAS unsigned char* lds, int tid, int wave, int lane) {
    const int bh = v % 12, w = v / 12, b = bh / 6, h = bh % 6;
    int j = 0, c = w; for (;;) { const int nc = (63 - j + 7) >> 3; if (c < nc) break; c -= nc; ++j; }
    const int tstart = 256 * (j + 1) + 2048 * c;
    LAS unsigned* list = (LAS unsigned*)(lds + AT_LIST); LAS unsigned* cnt = (LAS unsigned*)(lds + AT_CNT);
    if (tid == 0) *cnt = 0u;
    __syncthreads();
    const unsigned* SEL = (const unsigned*)(p.ws + WS_SEL) + (size_t)bh * S;
#pragma unroll
    for (int i = 0; i < 4; ++i) {
        const int tq = i * NTHR + tid, t = tstart + tq;
        if (t < S) {
            const unsigned sel = SEL[t]; int rk = -1;
            if ((sel & 0xffu) == (unsigned)j) rk = 0; else if (((sel >> 8) & 0xffu) == (unsigned)j) rk = 1; else if (((sel >> 16) & 0xffu) == (unsigned)j) rk = 2;
            if (rk >= 0) { const unsigned pos = __hip_atomic_fetch_add(cnt, 1u, __ATOMIC_RELAXED, __HIP_MEMORY_SCOPE_WORKGROUP); list[pos] = (unsigned)tq | ((unsigned)rk << 12); }
        }
    }
    __syncthreads();
    const int n = (int)*cnt;
    if (n > 0) {
        const bf16_t* PROJ = (const bf16_t*)(p.ws + WS_PROJ);
        stage_kv256(lds, PROJ + C_MK + 64 * h, PROJ + C_MV + 64 * h, (long)b * S + 256 * j, 0, tid);
        __syncthreads();
        const int r32 = lane & 31, hi = lane >> 5, ntl = (n + 31) >> 5;
        float* PML = (float*)(p.ws + WS_PML); bf16_t* PO = (bf16_t*)(p.ws + WS_PARTO);
        for (int tl = wave; tl < ntl; tl += 8) {
            const int idx = 32 * tl + r32; const bool valid = idx < n;
            const unsigned e = list[valid ? idx : 0]; const int t = tstart + (int)(e & 0x7ffu), rk = (int)(e >> 12);
            const long row = (long)b * S + t;
            bf16x8 qf[4]; load_qf(qf, PROJ + row * NIN + C_MQ + 64 * h, hi);
            f32x16 o[2]; float m, l; attn_tile(lds, qf, 0, 255, r32, hi, o, m, l);
            if (valid) {
                const size_t base = ((size_t)bh * S + t) * 3 + rk;
                if (hi == 0) { PML[base * 2] = m; PML[base * 2 + 1] = l; }
                store_orow_bf16(PO + base * 64, o, 1.0f, hi);
            }
        }
    }
    __syncthreads();
}
__device__ __forceinline__ void moba_own_unit(const Params& p, int u, LAS unsigned char* lds, int tid, int wave, int lane) {
    const int bh = u % 12, blk = u / 12, b = bh / 6, h = bh % 6;
    const bf16_t* PROJ = (const bf16_t*)(p.ws + WS_PROJ); bf16_t* YC = (bf16_t*)(p.ws + WS_YCAT);
    stage_kv256(lds, PROJ + C_MK + 64 * h, PROJ + C_MV + 64 * h, (long)b * S + 256 * blk, 0, tid);
    __syncthreads();
    const int r32 = lane & 31, hi = lane >> 5, qi = 32 * wave + r32, t = 256 * blk + qi; const long row = (long)b * S + t;
    bf16x8 qf[4]; load_qf(qf, PROJ + row * NIN + C_MQ + 64 * h, hi);
    f32x16 o[2]; float m, l; attn_tile(lds, qf, 0, qi, r32, hi, o, m, l);
    const int nv = blk < 3 ? blk : 3;
    const float* PML = (const float*)(p.ws + WS_PML); const bf16_t* PO = (const bf16_t*)(p.ws + WS_PARTO);
    const size_t base = ((size_t)bh * S + t) * 3;
    float mr[3], lr[3]; float M = m;
#pragma unroll
    for (int r = 0; r < 3; ++r) { mr[r] = -INFINITY; lr[r] = 0.f; if (r < nv) { const f32x2 ml = *(const f32x2*)(PML + (base + r) * 2); mr[r] = ml[0]; lr[r] = ml[1]; M = fmaxf(M, mr[r]); } }
    const float w0 = exp2_fast(m - M); float L = l * w0;
#pragma unroll
    for (int dt = 0; dt < 2; ++dt)
#pragma unroll
        for (int r = 0; r < 16; ++r) o[dt][r] *= w0;
#pragma unroll
    for (int r = 0; r < 3; ++r) {
        if (r < nv) {
            const float wr_ = exp2_fast(mr[r] - M); L += wr_ * lr[r];
            const bf16_t* src = PO + (base + r) * 64;
#pragma unroll
            for (int dt = 0; dt < 2; ++dt)
#pragma unroll
                for (int g = 0; g < 4; ++g) { const u32x2 wv = *(const u32x2*)(src + 32 * dt + 8 * g + 4 * hi);
                    o[dt][4 * g] += wr_ * bflo(wv.x); o[dt][4 * g + 1] += wr_ * bfhi(wv.x); o[dt][4 * g + 2] += wr_ * bflo(wv.y); o[dt][4 * g + 3] += wr_ * bfhi(wv.y); }
        }
    }
    store_orow_bf16(YC + row * DM + 64 * h, o, 1.0f / L, hi);
    __syncthreads();
}

__device__ __forceinline__ float log_sigmoid(float f) { return fminf(f, 0.f) - log1pf(__expf(-fabsf(f))); }
__device__ __forceinline__ float wave_incl_scan(float v, int lane) {
#pragma unroll
    for (int o = 1; o < 64; o <<= 1) { const float t = __shfl_up(v, o); if (lane >= o) v += t; }
    return v;
}
constexpr int MP = 72;
constexpr int M1_KT = 0, M1_VT = 64 * MP * 2, M1_W = M1_VT + 96 * MP * 2, M1_SUB = M1_W + 256;
__device__ __forceinline__ void m1_quad(const Params& p, int quad, LAS unsigned char* lds, int tid, int wave, int lane) {
    const int sub = wave >> 1, wp = wave & 1, unit = quad * 4 + sub, bh = unit >> 8, c = unit & 255, b = bh >> 2, h = bh & 3;
    const long row0 = (long)b * S + 64 * c;
    LAS unsigned char* L = lds + sub * M1_SUB;
    LAS float* wv = (LAS float*)(L + M1_W);
    const float* GT = (const float*)(p.ws + WS_GATES);
    if (wp == 0) {
        const float ig = GT[(row0 + lane) * 8 + h], fg = GT[(row0 + lane) * 8 + 4 + h];
        const float bs = wave_incl_scan(log_sigmoid(fg), lane);
        const float a = __shfl(bs, 63), g = a - bs + ig, mg = wave_max(g);
        wv[lane] = __expf(g - mg);
        if (lane == 0) { float* MISC = (float*)(p.ws + WS_MISC); MISC[unit] = a; MISC[2048 + unit] = mg; }
    }
    __syncthreads();
    const bf16_t* LQK = (const bf16_t*)(p.ws + WS_LQK); const bf16_t* PROJ = (const bf16_t*)(p.ws + WS_PROJ);
    const int tp = wp * 64 + lane;
#pragma unroll
    for (int i = 0; i < 4; ++i) {
        const int chunk = i * 128 + tp, s = chunk >> 3, c8 = chunk & 7;
        const u32x4 kw = *(const u32x4*)(LQK + (row0 + s) * 512 + 256 + 64 * h + 8 * c8);
        const u32x4 vw = *(const u32x4*)(PROJ + (row0 + s) * NIN + C_XV + 64 * h + 8 * c8);
        float kf[8]; unpack8(kw, kf); const float ws_ = wv[s];
        LAS bf16_t* kt = (LAS bf16_t*)(L + M1_KT) + (8 * c8) * MP + s;
#pragma unroll
        for (int e = 0; e < 8; e += 2) { const unsigned pw = pk2(kf[e] * ws_, kf[e + 1] * ws_); kt[e * MP] = (bf16_t)(pw & 0xffffu); kt[(e + 1) * MP] = (bf16_t)(pw >> 16); }
        LAS bf16_t* vt = (LAS bf16_t*)(L + M1_VT) + (8 * c8) * MP + s;
        vt[0 * MP] = (bf16_t)(vw.x & 0xffffu); vt[1 * MP] = (bf16_t)(vw.x >> 16); vt[2 * MP] = (bf16_t)(vw.y & 0xffffu); vt[3 * MP] = (bf16_t)(vw.y >> 16);
        vt[4 * MP] = (bf16_t)(vw.z & 0xffffu); vt[5 * MP] = (bf16_t)(vw.z >> 16); vt[6 * MP] = (bf16_t)(vw.w & 0xffffu); vt[7 * MP] = (bf16_t)(vw.w >> 16);
    }
#pragma unroll
    for (int i = 0; i < 16; ++i) { const int e = i * 128 + tp, rr = e >> 6, ss = e & 63; ((LAS bf16_t*)(L + M1_VT))[(64 + rr) * MP + ss] = (rr == 0) ? (bf16_t)0x3F80u : (bf16_t)0u; }
    __syncthreads();
    const int r32 = lane & 31, hi = lane >> 5;
    f32x16 acc[3];
#pragma unroll
    for (int et = 0; et < 3; ++et)
#pragma unroll
        for (int r = 0; r < 16; ++r) acc[et][r] = 0.f;
#pragma unroll
    for (int ks = 0; ks < 4; ++ks) {
        const bf16x8 bfr = *(const LAS bf16x8*)(L + M1_KT + ((32 * wp + r32) * MP + 16 * ks + 8 * hi) * 2);
#pragma unroll
        for (int et = 0; et < 3; ++et) {
            const bf16x8 afr = *(const LAS bf16x8*)(L + M1_VT + ((32 * et + r32) * MP + 16 * ks + 8 * hi) * 2);
            acc[et] = __builtin_amdgcn_mfma_f32_32x32x16_bf16(afr, bfr, acc[et], 0, 0, 0);
        }
    }
    float* DC = (float*)(p.ws + WS_DC) + (size_t)unit * 4160;
    const int d = 32 * wp + r32;
#pragma unroll
    for (int et = 0; et < 2; ++et)
#pragma unroll
        for (int r = 0; r < 16; ++r) { const int e = 32 * et + (r & 3) + 8 * (r >> 2) + 4 * hi; DC[e * 64 + d] = acc[et][r]; }
    if (hi == 0) DC[64 * 64 + d] = acc[2][0];
    __syncthreads();
}
__device__ __forceinline__ void scan_unit(const Params& p, int su, LAS unsigned char* lds, int tid) {
    const int e0 = su * NTHR, bh0 = e0 / 4160;
    const float* MISC = (const float*)(p.ws + WS_MISC); float* MS = (float*)(p.ws + WS_MISC) + 4096;
    const float* __restrict__ DC = (const float*)(p.ws + WS_DC); bf16_t* __restrict__ CST = (bf16_t*)(p.ws + WS_CST);
    LAS float* la = (LAS float*)lds; LAS float* lmg = la + 512; LAS float* ldec = la + 1024; LAS float* lsc = la + 1536;
    { const int which = tid >> 8, c = tid & 255, bh = bh0 + which;
      la[tid] = (bh < 8) ? MISC[bh * 256 + c] : 0.f; lmg[tid] = (bh < 8) ? MISC[2048 + bh * 256 + c] : 0.f; }
    __syncthreads();
    if (tid < 2) {
        const int bh = bh0 + tid; const bool own = (bh < 8) && (bh * 4160 >= e0) && (bh * 4160 < e0 + NTHR);
        float m = 0.f;
        for (int c = 0; c < 256; ++c) {
            if (own) MS[bh * 256 + c] = m;
            const float a = la[tid * 256 + c], mg = lmg[tid * 256 + c], mn = fmaxf(a + m, mg);
            ldec[tid * 256 + c] = __expf(a + m - mn); lsc[tid * 256 + c] = __expf(mg - mn); m = mn;
        }
    }
    __syncthreads();
    const int e = e0 + tid, bh = e / 4160, idx = e - bh * 4160, which = bh - bh0;
    const float* __restrict__ dcp = DC + (size_t)bh * 256 * 4160 + idx; bf16_t* __restrict__ csp = CST + (size_t)bh * 256 * 4160 + idx;
    float C = 0.f;
#pragma unroll 1
    for (int c0 = 0; c0 < 256; c0 += 32) {
        float dcv[32];
#pragma unroll
        for (int k = 0; k < 32; ++k) dcv[k] = dcp[(size_t)(c0 + k) * 4160];
#pragma unroll
        for (int k = 0; k < 32; ++k) {
            csp[(size_t)(c0 + k) * 4160] = (bf16_t)(pk2(C, 0.f) & 0xffffu);
            C = ldec[which * 256 + c0 + k] * C + lsc[which * 256 + c0 + k] * dcv[k];
        }
    }
    __syncthreads();
}
constexpr int M3_K = 0, M3_VT = 64 * MP * 2, M3_CS = 2 * 64 * MP * 2, M3_BS = M3_CS + 256, M3_SUB = M3_BS + 256;
__device__ __forceinline__ void m3_quad(const Params& p, int layer, int quad, LAS unsigned char* lds, int tid, int wave, int lane) {
    const int sub = wave >> 1, wp = wave & 1, unit = quad * 4 + sub, bh = unit >> 8, c = unit & 255, b = bh >> 2, h = bh & 3;
    const long row0 = (long)b * S + 64 * c;
    LAS unsigned char* L = lds + sub * M3_SUB;
    LAS float* cs = (LAS float*)(L + M3_CS); LAS float* bsv = (LAS float*)(L + M3_BS);
    const float* GT = (const float*)(p.ws + WS_GATES);
    if (wp == 0) {
        const float ig = GT[(row0 + lane) * 8 + h], fg = GT[(row0 + lane) * 8 + 4 + h];
        const float bs = wave_incl_scan(log_sigmoid(fg), lane);
        cs[lane] = ig - bs; bsv[lane] = bs;
    }
    const bf16_t* LQK = (const bf16_t*)(p.ws + WS_LQK); const bf16_t* PROJ = (const bf16_t*)(p.ws + WS_PROJ);
    const int tp = wp * 64 + lane;
#pragma unroll
    for (int i = 0; i < 4; ++i) {
        const int chunk = i * 128 + tp, s = chunk >> 3, c8 = chunk & 7;
        const u32x4 kw = *(const u32x4*)(LQK + (row0 + s) * 512 + 256 + 64 * h + 8 * c8);
        const u32x4 vw = *(const u32x4*)(PROJ + (row0 + s) * NIN + C_XV + 64 * h + 8 * c8);
        *(LAS u32x4*)(L + M3_K + (s * MP + 8 * c8) * 2) = kw;
        LAS bf16_t* vt = (LAS bf16_t*)(L + M3_VT) + (8 * c8) * MP + s;
        vt[0 * MP] = (bf16_t)(vw.x & 0xffffu); vt[1 * MP] = (bf16_t)(vw.x >> 16); vt[2 * MP] = (bf16_t)(vw.y & 0xffffu); vt[3 * MP] = (bf16_t)(vw.y >> 16);
        vt[4 * MP] = (bf16_t)(vw.z & 0xffffu); vt[5 * MP] = (bf16_t)(vw.z >> 16); vt[6 * MP] = (bf16_t)(vw.w & 0xffffu); vt[7 * MP] = (bf16_t)(vw.w >> 16);
    }
    __syncthreads();
    const int r32 = lane & 31, hi = lane >> 5, t = 32 * wp + r32; const long row = row0 + t;
    bf16x8 qf[4]; load_qf(qf, LQK + row * 512 + 64 * h, hi);
    f32x16 sT[2];
#pragma unroll
    for (int st = 0; st < 2; ++st) {
        f32x16 a;
#pragma unroll
        for (int r = 0; r < 16; ++r) a[r] = 0.f;
#pragma unroll
        for (int d0 = 0; d0 < 4; ++d0) {
            const bf16x8 kf = *(const LAS bf16x8*)(L + M3_K + ((32 * st + r32) * MP + 16 * d0 + 8 * hi) * 2);
            a = __builtin_amdgcn_mfma_f32_32x32x16_bf16(kf, qf[d0], a, 0, 0, 0);
        }
        sT[st] = a;
    }
    const float b_t = bsv[t], m_c = ((const float*)(p.ws + WS_MISC))[4096 + unit], inter = b_t + m_c;
    f32x16 dm[2]; float mx = inter;
#pragma unroll
    for (int st = 0; st < 2; ++st)
#pragma unroll
        for (int g = 0; g < 4; ++g) {
            const f32x4 c4 = *(const LAS f32x4*)(cs + 32 * st + 8 * g + 4 * hi);
#pragma unroll
            for (int e2 = 0; e2 < 4; ++e2) { const int s = 32 * st + 8 * g + 4 * hi + e2; const float dv = (s <= t) ? (b_t + c4[e2]) : -INFINITY; dm[st][4 * g + e2] = dv; mx = fmaxf(mx, dv); }
        }
    mx = fmaxf(mx, __shfl_xor(mx, 32));
    const float w_inter = __expf(inter - mx);
    float den = 0.f;
#pragma unroll
    for (int st = 0; st < 2; ++st)
#pragma unroll
        for (int r = 0; r < 16; ++r) { const float qk = sT[st][r] * __expf(dm[st][r] - mx); sT[st][r] = qk; den += qk; }
    den += __shfl_xor(den, 32);
    f32x16 acc[3];
    const bf16_t* CST = (const bf16_t*)(p.ws + WS_CST) + (size_t)unit * 4160;
#pragma unroll
    for (int et = 0; et < 3; ++et) {
        f32x16 a;
#pragma unroll
        for (int r = 0; r < 16; ++r) a[r] = 0.f;
#pragma unroll
        for (int d0 = 0; d0 < 4; ++d0) {
            const bf16x8 cf = *(const bf16x8*)(CST + (32 * et + r32) * 64 + 16 * d0 + 8 * hi);
            a = __builtin_amdgcn_mfma_f32_32x32x16_bf16(cf, qf[d0], a, 0, 0, 0);
        }
        acc[et] = a;
    }
    const float qn = __shfl(acc[2][0], r32);
#pragma unroll
    for (int et = 0; et < 2; ++et)
#pragma unroll
        for (int r = 0; r < 16; ++r) acc[et][r] *= w_inter;
#pragma unroll
    for (int st = 0; st < 2; ++st)
#pragma unroll
        for (int j = 0; j < 2; ++j) {
            u32x4 pw; pw.x = pk2(sT[st][8 * j + 0], sT[st][8 * j + 1]); pw.y = pk2(sT[st][8 * j + 2], sT[st][8 * j + 3]); pw.z = pk2(sT[st][8 * j + 4], sT[st][8 * j + 5]); pw.w = pk2(sT[st][8 * j + 6], sT[st][8 * j + 7]);
            const bf16x8 pb = __builtin_bit_cast(bf16x8, pw);
#pragma unroll
            for (int et = 0; et < 2; ++et) {
                const LAS unsigned char* vp = L + M3_VT + ((32 * et + r32) * MP + 32 * st + 16 * j + 4 * hi) * 2;
                const u32x2 lo = *(const LAS u32x2*)vp, hi2 = *(const LAS u32x2*)(vp + 16);
                u32x4 vw; vw.x = lo.x; vw.y = lo.y; vw.z = hi2.x; vw.w = hi2.y;
                acc[et] = __builtin_amdgcn_mfma_f32_32x32x16_bf16(__builtin_bit_cast(bf16x8, vw), pb, acc[et], 0, 0, 0);
            }
        }
    const float dtot = w_inter * qn + den, inv = 1.0f / fmaxf(fabsf(dtot), __expf(-mx));
    float ss = 0.f;
#pragma unroll
    for (int et = 0; et < 2; ++et)
#pragma unroll
        for (int g = 0; g < 4; ++g) {
            const u32x2 xw = *(const u32x2*)(PROJ + row * NIN + C_XO + 64 * h + 32 * et + 8 * g + 4 * hi);
            const float xo[4] = {bflo(xw.x), bfhi(xw.x), bflo(xw.y), bfhi(xw.y)};
#pragma unroll
            for (int e2 = 0; e2 < 4; ++e2) { const float hv = acc[et][4 * g + e2] * inv / (1.f + __expf(-xo[e2])); acc[et][4 * g + e2] = hv; ss += hv * hv; }
        }
    ss += __shfl_xor(ss, 32);
    const float rs = rsqrtf(ss * (1.0f / 64.0f) + EPS);
    const float* nw = p.mlstm_norm + (size_t)layer * 256 + 64 * h;
    bf16_t* dst = (bf16_t*)(p.ws + WS_YCAT) + row * DM + 384 + 64 * h;
#pragma unroll
    for (int et = 0; et < 2; ++et)
#pragma unroll
        for (int g = 0; g < 4; ++g) {
            const f32x4 nv = *(const f32x4*)(nw + 32 * et + 8 * g + 4 * hi);
            u32x2 w; w.x = pk2(acc[et][4 * g] * rs * nv[0], acc[et][4 * g + 1] * rs * nv[1]); w.y = pk2(acc[et][4 * g + 2] * rs * nv[2], acc[et][4 * g + 3] * rs * nv[3]);
            *(u32x2*)(dst + 32 * et + 8 * g + 4 * hi) = w;
        }
    __syncthreads();
}

#ifndef REPEAT_MASK
#define REPEAT_MASK 0
#endif
__global__ void __launch_bounds__(NTHR, 2) hybrid_fwd(Params p0) {
    extern __shared__ __attribute__((aligned(16))) unsigned char lds_raw[];
    LAS unsigned char* lds = (LAS unsigned char*)lds_raw;
    cg::grid_group grid = cg::this_grid();
    const int lo = p0.ph_lo, hi = p0.ph_hi;
    if (threadIdx.x < 16) ((LAS unsigned*)(lds + BAR_LDS_OFF))[threadIdx.x] = 0u;
    __syncthreads();
    XcdBarrier xbar; xbar.bar = (unsigned*)(p0.ws + WS_CTL) + 4096; xbar.x = 0; xbar.st = nullptr;
    if (hi - lo > 1) xbar = xcd_barrier_post((unsigned*)(p0.ws + WS_CTL) + 4096, (volatile LAS unsigned*)(lds + BAR_LDS_OFF));
#define IN(k) (lo <= (k) && (k) < hi)
#define SEAM(k) do { if (IN(k) && IN((k) + 1)) { if ((k) == 0) grid.sync(); else xcd_barrier(xbar); } } while (0)
#define PHASE_VARS() int tid = threadIdx.x; asm volatile("" : "+v"(tid)); const int lane = tid & 63, wave = __builtin_amdgcn_readfirstlane(tid >> 6); \
    int bid = (int)blockIdx.x; asm volatile("" : "+s"(bid)); const int G = (int)gridDim.x; Params p = p0; { unsigned char* w_ = p0.ws; asm volatile("" : "+s"(w_)); p.ws = w_; } unsigned char* ws = p.ws; (void)ws; (void)lane; (void)wave; (void)bid; (void)G
    for (int rep_ = 0; rep_ < ((REPEAT_MASK & 1) ? 2 : 1); ++rep_) { if (rep_) xcd_barrier(xbar);
        if (IN(0)) { PHASE_VARS(); prologue(p, lds, tid, wave, lane); }
    }
        SEAM(0);
#pragma unroll 1
    for (int layer = 0; layer < 2; ++layer) {
        const int P = 1 + 8 * layer;
        for (int rep_ = 0; rep_ < ((REPEAT_MASK & 2) ? 2 : 1); ++rep_) { if (rep_) xcd_barrier(xbar);
        if (IN(P)) { PHASE_VARS(); EpiScaled<0> E{(bf16_t*)(ws + WS_PROJ), NIN, (const float*)(ws + WS_SSQ)}; run_gemm(lds, (const bf16_t*)(ws + WS_XB), (const bf16_t*)(ws + WS_WIN + layer * WIN_L), T, NIN, DM, E, bid); }
        }
        SEAM(P);
        if (IN(P + 1)) { PHASE_VARS();
            for (int u = bid; u < 128 * 30; u += G) prep_unit(p, layer, u, lds, tid, wave, lane);
#if MIX_STAGE < 3
            { u32x4* y4 = (u32x4*)(ws + WS_YCAT); const u32x4 z = {0u, 0u, 0u, 0u}; for (size_t e = (size_t)bid * NTHR + tid; e < (size_t)T * DM / 8; e += (size_t)G * NTHR) y4[e] = z; }
#endif
        }
        SEAM(P + 1);
        for (int rep_ = 0; rep_ < ((REPEAT_MASK & 4) ? 2 : 1); ++rep_) { if (rep_) xcd_barrier(xbar);
        if (IN(P + 2)) { PHASE_VARS();
#if MIX_STAGE >= 1
            for (int q = bid; q < 512; q += G) m1_quad(p, q, lds, tid, wave, lane);
#endif
#if MIX_STAGE >= 3
            for (int wu = bid * 8 + wave; wu < 3072; wu += G * 8) sel_wave_unit(p, wu, lane);
#endif
        }
        }
        SEAM(P + 2);
        for (int rep_ = 0; rep_ < ((REPEAT_MASK & 8) ? 2 : 1); ++rep_) { if (rep_) xcd_barrier(xbar);
        if (IN(P + 3)) { PHASE_VARS();
            for (int u = bid; u < 65 + 512 + 3360; u += G) {
                if (u < 65) {
#if MIX_STAGE >= 1
                    scan_unit(p, u, lds, tid);
#endif
                } else if (u < 577) {
#if MIX_STAGE >= 2
                    swa_unit(p, layer, u - 65, lds, tid, wave, lane);
#endif
                } else {
#if MIX_STAGE >= 3
                    moba_sel_unit(p, u - 577, lds, tid, wave, lane);
#endif
                }
            }
        }
        }
        SEAM(P + 3);
        for (int rep_ = 0; rep_ < ((REPEAT_MASK & 16) ? 2 : 1); ++rep_) { if (rep_) xcd_barrier(xbar);
        if (IN(P + 4)) { PHASE_VARS();
            for (int u = bid; u < 768 + 512; u += G) {
                if (u < 768) {
#if MIX_STAGE >= 3
                    moba_own_unit(p, u, lds, tid, wave, lane);
#endif
                } else {
#if MIX_STAGE >= 1
                    m3_quad(p, layer, u - 768, lds, tid, wave, lane);
#endif
                }
            }
        }
        }
        SEAM(P + 4);
        if (IN(P + 5)) { PHASE_VARS(); EpiRes E{layer == 0 ? p.x : (const float*)p.out, p.out, (bf16_t*)(ws + WS_XB), (float*)(ws + WS_SSQ)}; run_gemm(lds, (const bf16_t*)(ws + WS_YCAT), (const bf16_t*)(ws + WS_WOUT + layer * WOUT_L), T, DM, DM, E, bid); }
        SEAM(P + 5);
        for (int rep_ = 0; rep_ < ((REPEAT_MASK & 32) ? 2 : 1); ++rep_) { if (rep_) xcd_barrier(xbar);
        if (IN(P + 6)) { PHASE_VARS(); EpiScaled<1> E{(bf16_t*)(ws + WS_H), FF, (const float*)(ws + WS_SSQ)}; run_gemm(lds, (const bf16_t*)(ws + WS_XB), (const bf16_t*)(ws + WS_WUP + layer * WUP_L), T, FF, DM, E, bid); }
        }
        SEAM(P + 6);
        if (IN(P + 7)) { PHASE_VARS(); EpiRes E{(const float*)p.out, p.out, layer == 0 ? (bf16_t*)(ws + WS_XB) : nullptr, layer == 0 ? (float*)(ws + WS_SSQ) : nullptr}; run_gemm(lds, (const bf16_t*)(ws + WS_H), (const bf16_t*)(ws + WS_WDN + layer * WDN_L), T, DM, FF, E, bid); }
        SEAM(P + 7);
    }
#undef IN
#undef SEAM
}

#ifndef N_LAUNCH_SPLIT
#define N_LAUNCH_SPLIT 0
#endif
extern "C" void kernel_launch(void* const* d_in, const int* in_sizes, int n_in, void* d_out, int out_size, void* d_ws, size_t ws_size, hipStream_t stream) {
    static int grid = 0;
    if (grid == 0) {
        if (n_in != 17 || in_sizes[0] != T * DM || out_size != T * DM || ws_size < WS_END) { fprintf(stderr, "kernel_launch: unexpected shapes (n_in %d, in0 %d, out %d, ws %zu); nothing launched\n", n_in, n_in > 0 ? in_sizes[0] : -1, out_size, ws_size); grid = -1; return; }
        int dev = 0, cus = 0, per_cu = 0;
        if (hipGetDevice(&dev) != hipSuccess || hipDeviceGetAttribute(&cus, hipDeviceAttributeMultiprocessorCount, dev) != hipSuccess) { grid = -1; return; }
        if (hipFuncSetAttribute((const void*)hybrid_fwd, hipFuncAttributeMaxDynamicSharedMemorySize, LDS_BYTES) != hipSuccess) { fprintf(stderr, "kernel_launch: hipFuncSetAttribute failed\n"); grid = -1; return; }
        if (hipOccupancyMaxActiveBlocksPerMultiprocessor(&per_cu, (const void*)hybrid_fwd, NTHR, LDS_BYTES) != hipSuccess || per_cu < 1) { fprintf(stderr, "kernel_launch: occupancy query says %d blocks per CU\n", per_cu); (void)hipGetLastError(); grid = -1; return; }
        grid = cus;
    }
    if (grid < 0) return;
    if (hipMemsetAsync((char*)d_ws + WS_CTL, 0, 65536, stream) != hipSuccess) { fprintf(stderr, "kernel_launch: memset of the barrier words failed\n"); return; }
    Params p{};
    const float** pp = (const float**)&p;
    for (int i = 0; i < 17; ++i) pp[i] = (const float*)d_in[i];
    p.out = (float*)d_out; p.ws = (unsigned char*)d_ws;
#if N_LAUNCH_SPLIT
    for (int ph = 0; ph < 17; ++ph) {
        p.ph_lo = ph; p.ph_hi = ph + 1; void* args[] = {&p};
        hipError_t e = hipLaunchCooperativeKernel((const void*)hybrid_fwd, dim3(grid), dim3(NTHR), args, LDS_BYTES, stream);
        if (e != hipSuccess) { fprintf(stderr, "cooperative launch failed: %s\n", hipGetErrorString(e)); break; }
    }
#else
    p.ph_lo = 0; p.ph_hi = 17; void* args[] = {&p};
    hipError_t e = hipLaunchCooperativeKernel((const void*)hybrid_fwd, dim3(grid), dim3(NTHR), args, LDS_BYTES, stream);
    if (e != hipSuccess) fprintf(stderr, "cooperative launch failed: %s (grid %d)\n", hipGetErrorString(e), grid);
#endif
}
```

```cpp
#include <hip/hip_runtime.h>
#include <hip/hip_cooperative_groups.h>
#include <cstdio>
#include <cstdint>
namespace cg = cooperative_groups;
namespace pg8 {
#define PG8_LAS __attribute__((address_space(3)))
typedef unsigned short bf16_t;
typedef short bf16x8 __attribute__((ext_vector_type(8)));
typedef float f32x4 __attribute__((ext_vector_type(4)));
typedef unsigned u32x4 __attribute__((ext_vector_type(4)));
constexpr int BM = 256, BK = 64, HALF = 128, HTB = HALF * BK * 2  , STAGE_BYTES = 8 * HTB, NXCD = 8, WGM = 8;

__host__ __device__ __forceinline__ int lds_byte(int r, int c) { const int st = (r >> 4) * 2 + (c >> 5), rr = r & 15, cc = c & 31, ob = rr * 64 + cc * 2; return st * 1024 + (ob ^ (((ob >> 9) & 1) << 5)); }
__host__ __device__ __forceinline__ void stage_rc(int b, int& R, int& C) { const int st = b / 1024, sb = b % 1024, swz = sb ^ (((sb >> 9) & 1) << 5); R = (st >> 1) * 16 + swz / 64; C = (st & 1) * 32 + (swz % 64) / 2; }
__host__ __device__ __forceinline__ int perm32(int rho) { const int n = rho >> 4, i = rho & 15; return 8 * (i >> 2) + 4 * n + (i & 3); }

struct Unit { int pm, pn; };
struct Gemm { const bf16_t* A; const bf16_t* Bt; int M, N, K; };

struct StaticOrder {
    int nM, nN, nwg, G, c;
    __host__ __device__ void init(int M, int N, int G_, int c_) { nM = M / BM; nN = N / BM; nwg = nM * nN; G = G_; c = c_; }
    __host__ __device__ bool next(int i, Unit& u) const {
        const long L = (long)i * G + c; if (L >= nwg) return false;
        int wgid = (int)L; { const int q = nwg / NXCD, r = nwg % NXCD, xcd = wgid % NXCD, off = wgid / NXCD; wgid = (xcd < r ? xcd * (q + 1) : r * (q + 1) + (xcd - r) * q) + off; }
        const int nig = WGM * nN, gid = wgid / nig, fm = gid * WGM, gsz = (nM - fm) < WGM ? (nM - fm) : WGM;
        u.pm = fm + ((wgid % nig) % gsz); u.pn = (wgid % nig) / gsz; return true;
    }
    __device__ __forceinline__ void a_ready(const Unit&) const {}
    __device__ __forceinline__ void done(const Unit&) const {}
};
__device__ __forceinline__ unsigned cvt_pk_bf16(float lo, float hi) { unsigned r; asm volatile("v_cvt_pk_bf16_f32 %0, %1, %2" : "=v"(r) : "v"(lo), "v"(hi)); return r; }
typedef float f32x2 __attribute__((ext_vector_type(2)));
template <class Epi, class Sched, bool ALIGN_EPI = false, bool SP2 = false>
__device__ __forceinline__ void gemm_phase(PG8_LAS unsigned char* lds, const Gemm g, const Sched& S, const Epi& E) {
    int tid_l = threadIdx.x; asm volatile("" : "+v"(tid_l)); const int tid = tid_l, wid = __builtin_amdgcn_readfirstlane(tid >> 6), lane = tid & 63, wr = wid >> 2, wc = wid & 3, fr = lane & 15, fq = lane >> 4;
    const int K = g.K, nt = K / BK;
    unsigned voffA[2], voffB[2];
#pragma unroll
    for (int i = 0; i < 2; ++i) { int R, C; stage_rc(tid * 16 + i * 8192, R, C); const int Rb = Epi::PERM ? ((R & ~31) + perm32(R & 31)) : R;
        voffA[i] = (unsigned)(R * K + C) * 2u; voffB[i] = (unsigned)(Rb * K + C) * 2u; }
    const size_t kstep = (size_t)(BK * 2);
    const size_t hstep = (size_t)HALF * K * 2;
    const size_t tstep = 2 * hstep;
    const unsigned ldsw = (unsigned)wid * 1024u;
    const int aoff = lds_byte(wr * 64 + fr, fq * 8), boff = lds_byte(wc * 32 + fr, fq * 8);
#define PG8_SA(b, h) (((b) * 2 + (h)) * HTB)
#define PG8_SB(b, h) ((4 + (b) * 2 + (h)) * HTB)
#define PG8_STAGE(bufoff, gbase, voff) do { _Pragma("unroll") for (int _i = 0; _i < 2; ++_i) \
        __builtin_amdgcn_global_load_lds((const unsigned*)((const char*)(gbase) + (voff)[_i]), (PG8_LAS unsigned*)(lds + (bufoff) + ldsw + _i * 8192), 16, 0, 0); } while (0)
#define PG8_LDA(dst, b, h) do { _Pragma("unroll") for (int m = 0; m < 4; ++m) _Pragma("unroll") for (int k = 0; k < 2; ++k) dst[m][k] = *(const PG8_LAS bf16x8*)(lds + PG8_SA(b, h) + aoff + m * 2048 + k * 1024); } while (0)
#define PG8_LDB(dst, b, h) do { _Pragma("unroll") for (int n = 0; n < 2; ++n) _Pragma("unroll") for (int k = 0; k < 2; ++k) dst[n][k] = *(const PG8_LAS bf16x8*)(lds + PG8_SB(b, h) + boff + n * 2048 + k * 1024); } while (0)
#define PG8_MMA(ai, bj, At, Bt) do { __builtin_amdgcn_s_setprio(1); _Pragma("unroll") for (int m = 0; m < 4; ++m) _Pragma("unroll") for (int n = 0; n < 2; ++n) _Pragma("unroll") for (int k = 0; k < 2; ++k) \
        acc[ai][bj][m][n] = __builtin_amdgcn_mfma_f32_16x16x32_bf16(Bt[n][k], At[m][k], acc[ai][bj][m][n], 0, 0, 0); __builtin_amdgcn_s_setprio(0); } while (0)
#define PG8_WAIT_V(n) asm volatile("s_waitcnt vmcnt(" #n ")" ::: "memory")
#define PG8_WAIT_L(n) asm volatile("s_waitcnt lgkmcnt(" #n ")" ::: "memory")
#define PG8_BAR __builtin_amdgcn_s_barrier()
#define PG8_SCHED __builtin_amdgcn_sched_barrier(0)
    Unit cur, nxt; int ui = 0;
    if (!S.next(0, cur)) return;
    f32x4 acc[2][2][4][2];
#pragma unroll
    for (int a = 0; a < 2; ++a)
#pragma unroll
        for (int b = 0; b < 2; ++b)
#pragma unroll
            for (int m = 0; m < 4; ++m)
#pragma unroll
                for (int n = 0; n < 2; ++n) acc[a][b][m][n] = (f32x4){0.f, 0.f, 0.f, 0.f};
    bf16x8 At[4][2], B0[2][2], B1[2][2];
    const char* cA = (const char*)g.A + (size_t)cur.pm * tstep; const char* cB = (const char*)g.Bt + (size_t)cur.pn * tstep;
    S.a_ready(cur);
    if constexpr (SP2) {
        PG8_STAGE(PG8_SB(0, 0), cB, voffB); PG8_STAGE(PG8_SB(0, 1), cB + hstep, voffB); PG8_STAGE(PG8_SA(0, 0), cA, voffA); PG8_STAGE(PG8_SA(0, 1), cA + hstep, voffA);
        if (wr == 1) PG8_BAR;
        PG8_WAIT_V(2); PG8_BAR;
        PG8_STAGE(PG8_SB(1, 0), cB + kstep, voffB); PG8_STAGE(PG8_SA(1, 0), cA + kstep, voffA); PG8_STAGE(PG8_SB(1, 1), cB + hstep + kstep, voffB);
        PG8_WAIT_V(6); PG8_BAR;
    } else {
        PG8_STAGE(PG8_SB(0, 0), cB, voffB); PG8_STAGE(PG8_SA(0, 0), cA, voffA); PG8_STAGE(PG8_SB(0, 1), cB + hstep, voffB); PG8_STAGE(PG8_SA(0, 1), cA + hstep, voffA);
        if (wr == 1) PG8_BAR;
        PG8_WAIT_V(4); PG8_BAR;
        PG8_STAGE(PG8_SB(1, 0), cB + kstep, voffB); PG8_STAGE(PG8_SA(1, 0), cA + kstep, voffA); PG8_STAGE(PG8_SB(1, 1), cB + hstep + kstep, voffB);
        PG8_WAIT_V(6); PG8_BAR;
    }
    for (;;) {
        const bool has_next = S.next(ui + 1, nxt);
        const char* nA = has_next ? (const char*)g.A + (size_t)nxt.pm * tstep : cA; const char* nB = has_next ? (const char*)g.Bt + (size_t)nxt.pn * tstep : cB;
        for (int t = 0; t < nt; t += 2) {
            const bool last = (t == nt - 2);
            const char* a1 = cA + (size_t)(t + 1) * kstep;
            const char* a2 = last ? nA : cA + (size_t)(t + 2) * kstep; const char* b2 = last ? nB : cB + (size_t)(t + 2) * kstep;
            const char* a3 = a2 + kstep; const char* b3 = b2 + kstep;
            if (last && has_next) S.a_ready(nxt);
            if constexpr (SP2) {
            PG8_LDB(B0, 0, 0); PG8_LDB(B1, 0, 1); PG8_SCHED; PG8_LDA(At, 0, 0); PG8_STAGE(PG8_SA(1, 1), a1 + hstep, voffA);
            PG8_WAIT_V(8); PG8_WAIT_L(0); PG8_BAR; PG8_MMA(0, 0, At, B0); PG8_MMA(0, 1, At, B1); PG8_BAR; PG8_SCHED;
            PG8_LDA(At, 0, 1); PG8_STAGE(PG8_SB(0, 0), b2, voffB); PG8_STAGE(PG8_SB(0, 1), b2 + hstep, voffB); PG8_STAGE(PG8_SA(0, 0), a2, voffA);
            PG8_WAIT_V(8); PG8_WAIT_L(0); PG8_BAR; PG8_MMA(1, 0, At, B0); PG8_MMA(1, 1, At, B1); PG8_BAR; PG8_SCHED;
            PG8_LDB(B0, 1, 0); PG8_LDB(B1, 1, 1); PG8_SCHED; PG8_LDA(At, 1, 0); PG8_STAGE(PG8_SA(0, 1), a2 + hstep, voffA);
            PG8_WAIT_V(8); PG8_WAIT_L(0); PG8_BAR; PG8_MMA(0, 0, At, B0); PG8_MMA(0, 1, At, B1); PG8_BAR; PG8_SCHED;
            PG8_LDA(At, 1, 1); PG8_STAGE(PG8_SB(1, 0), b3, voffB); PG8_STAGE(PG8_SB(1, 1), b3 + hstep, voffB); PG8_STAGE(PG8_SA(1, 0), a3, voffA);
            PG8_WAIT_V(8); PG8_WAIT_L(0); PG8_BAR; PG8_MMA(1, 0, At, B0); PG8_MMA(1, 1, At, B1); PG8_BAR; PG8_SCHED;
            } else {
            PG8_LDB(B0, 0, 0); PG8_SCHED; PG8_LDA(At, 0, 0); PG8_STAGE(PG8_SA(1, 1), a1 + hstep, voffA);
            PG8_WAIT_L(8); PG8_BAR; PG8_WAIT_L(0); PG8_MMA(0, 0, At, B0); PG8_BAR; PG8_SCHED;
            PG8_LDB(B1, 0, 1); PG8_STAGE(PG8_SB(0, 0), b2, voffB);
            PG8_BAR; PG8_WAIT_L(0); PG8_MMA(0, 1, At, B1); PG8_BAR;
            PG8_LDA(At, 0, 1); PG8_STAGE(PG8_SA(0, 0), a2, voffA);
            PG8_BAR; PG8_WAIT_L(0); PG8_MMA(1, 0, At, B0); PG8_BAR; PG8_SCHED;
            PG8_STAGE(PG8_SB(0, 1), b2 + hstep, voffB);
            PG8_WAIT_V(6); PG8_BAR; PG8_MMA(1, 1, At, B1); PG8_BAR;
            PG8_LDB(B0, 1, 0); PG8_SCHED; PG8_LDA(At, 1, 0); PG8_STAGE(PG8_SA(0, 1), a2 + hstep, voffA);
            PG8_WAIT_L(8); PG8_BAR; PG8_WAIT_L(0); PG8_MMA(0, 0, At, B0); PG8_BAR; PG8_SCHED;
            PG8_LDB(B1, 1, 1); PG8_STAGE(PG8_SB(1, 0), b3, voffB);
            PG8_BAR; PG8_WAIT_L(0); PG8_MMA(0, 1, At, B1); PG8_BAR;
            PG8_LDA(At, 1, 1); PG8_STAGE(PG8_SA(1, 0), a3, voffA);
            PG8_BAR; PG8_WAIT_L(0); PG8_MMA(1, 0, At, B0); PG8_BAR; PG8_SCHED;
            PG8_STAGE(PG8_SB(1, 1), b3 + hstep, voffB);
            PG8_WAIT_V(6); PG8_BAR; PG8_MMA(1, 1, At, B1); PG8_BAR;
            }
        }
        if constexpr (ALIGN_EPI) { if (wr == 0) PG8_BAR; }
        if constexpr (!Epi::AFTER_DRAIN) { E(acc, cur, wr, wc, fr, fq); S.done(cur); }
        if (!has_next) break;
#pragma unroll
        for (int a = 0; a < 2; ++a)
#pragma unroll
            for (int b = 0; b < 2; ++b)
#pragma unroll
                for (int m = 0; m < 4; ++m)
#pragma unroll
                    for (int n = 0; n < 2; ++n) acc[a][b][m][n] = (f32x4){0.f, 0.f, 0.f, 0.f};
        cur = nxt; cA = nA; cB = nB; ++ui;
        if constexpr (ALIGN_EPI) { if (wr == 1) PG8_BAR; }
    }
    PG8_WAIT_V(0);
    if constexpr (!ALIGN_EPI) { if (wr == 0) PG8_BAR; }
    PG8_BAR;
    if constexpr (Epi::AFTER_DRAIN) { E.fused(acc, cur, wr, wc, fr, fq, lds, wid, lane); S.done(cur); }
#undef PG8_SA
#undef PG8_SB
#undef PG8_STAGE
#undef PG8_LDA
#undef PG8_LDB
#undef PG8_MMA
#undef PG8_WAIT_V
#undef PG8_WAIT_L
#undef PG8_BAR
#undef PG8_SCHED
}
}

#ifndef MIX_STAGE
#define MIX_STAGE 3
#endif
using pg8::bf16_t; using pg8::bf16x8; using pg8::f32x4; using pg8::u32x4; using pg8::f32x2;
#define LAS __attribute__((address_space(3)))
typedef float f32x16 __attribute__((ext_vector_type(16)));
typedef unsigned u32x2 __attribute__((ext_vector_type(2)));
typedef __bf16 bf16x2_t __attribute__((ext_vector_type(2)));

constexpr int NB = 2, S = 16384, T = NB * S, DM = 1024, NIN = 2816, INW = 2824, FF = 4096;
constexpr int C_MQ = 0, C_MK = 384, C_MV = 768, C_SQ = 1152, C_SK = 1536, C_SV = 1664, C_XQK = 1792, C_XV = 2304, C_XO = 2560;
constexpr float EPS = 1e-6f;
constexpr float LOG2E = 1.4426950408889634f;
constexpr float QSCALE = 0.125f * LOG2E;
constexpr int NTHR = 512;

constexpr size_t MiB = 1ull << 20;
constexpr size_t WS_WIN = 1 * MiB, WIN_L = (size_t)NIN * DM * 2;
constexpr size_t WS_WOUT = 12 * MiB, WOUT_L = (size_t)DM * DM * 2;
constexpr size_t WS_WUP = 16 * MiB, WUP_L = (size_t)FF * DM * 2;
constexpr size_t WS_WDN = 32 * MiB, WDN_L = (size_t)DM * FF * 2;
constexpr size_t WS_WG = 48 * MiB;
constexpr size_t WS_COS = 49 * MiB, WS_SIN = 51 * MiB;
constexpr size_t WS_SSQ = 53 * MiB;
constexpr size_t WS_GATES = 55 * MiB;
constexpr size_t WS_KMH = 56 * MiB, WS_KML = 56 * MiB + 262144;
constexpr size_t WS_SEL = 57 * MiB;
constexpr size_t WS_MISC = 58 * MiB;
constexpr size_t WS_PML = 59 * MiB;
constexpr size_t WS_XB = 64 * MiB;
constexpr size_t WS_DC = 64 * MiB;
constexpr size_t WS_CST = 97 * MiB;
constexpr size_t WS_LQK = 128 * MiB;
constexpr size_t WS_YCAT = 160 * MiB;
constexpr size_t WS_PROJ = 224 * MiB;
constexpr size_t WS_PARTO = 400 * MiB;
constexpr size_t WS_H = 224 * MiB;
constexpr size_t WS_END = 480 * MiB;
static_assert(WS_WIN + 2 * WIN_L <= WS_WOUT && WS_DC + (size_t)2048 * 4160 * 4 <= WS_CST && WS_CST + (size_t)2049 * 4160 * 2 <= WS_LQK, "ws map");
static_assert(WS_PROJ + (size_t)T * NIN * 2 <= WS_PARTO && WS_PARTO + (size_t)12 * S * 3 * 64 * 2 <= WS_END && WS_H + (size_t)T * FF * 2 <= WS_END, "ws map 2");

constexpr int LDS_BYTES = 147456, BAR_LDS_OFF = 131072 + 64;
constexpr size_t WS_CTL = 0;

struct Params {
    const float* x; const float* ln1; const float* w_in; const float* conv_w; const float* conv_b; const float* igate_b; const float* fgate_b;
    const float* mlstm_norm; const float* moba_q_norm; const float* moba_k_norm; const float* swa_q_norm; const float* swa_k_norm; const float* swa_sinks;
    const float* w_out; const float* ln2; const float* w_up; const float* w_down;
    float* out; unsigned char* ws; int ph_lo, ph_hi;
};

__device__ __forceinline__ float wave_sum(float v) {
#pragma unroll
    for (int o = 1; o < 64; o <<= 1) v += __shfl_xor(v, o);
    return v;
}
__device__ __forceinline__ float wave_max(float v) {
#pragma unroll
    for (int o = 1; o < 64; o <<= 1) v = fmaxf(v, __shfl_xor(v, o));
    return v;
}
__device__ __forceinline__ unsigned pk2(float lo, float hi) { f32x2 v = {lo, hi}; bf16x2_t b = __builtin_convertvector(v, bf16x2_t); return __builtin_bit_cast(unsigned, b); }
__device__ __forceinline__ float bflo(unsigned w) { return __uint_as_float(w << 16); }
__device__ __forceinline__ float bfhi(unsigned w) { return __uint_as_float(w & 0xffff0000u); }
__device__ __forceinline__ void unpack8(const u32x4 w, float (&v)[8]) {
    v[0] = bflo(w.x); v[1] = bfhi(w.x); v[2] = bflo(w.y); v[3] = bfhi(w.y); v[4] = bflo(w.z); v[5] = bfhi(w.z); v[6] = bflo(w.w); v[7] = bfhi(w.w);
}
__device__ __forceinline__ u32x4 pack8(const float (&v)[8]) { u32x4 w; w.x = pk2(v[0], v[1]); w.y = pk2(v[2], v[3]); w.z = pk2(v[4], v[5]); w.w = pk2(v[6], v[7]); return w; }
#define LDS_WAIT() asm volatile("s_waitcnt lgkmcnt(0)" ::: "memory")
__device__ __forceinline__ float exp2_fast(float v) { return __builtin_amdgcn_exp2f(v); }

__device__ __forceinline__ float row_rstd(const float* ssq, int row, int fq) {
    const f32x4 p = *(const f32x4*)(ssq + (size_t)row * 16 + 4 * fq);
    float s = (p[0] + p[1]) + (p[2] + p[3]); s += __shfl_xor(s, 16); s += __shfl_xor(s, 32);
    return rsqrtf(s * (1.0f / 1024.0f) + EPS);
}
template <int ACT  > struct EpiScaled {
    static constexpr bool PERM = true, AFTER_DRAIN = false;
    bf16_t* O; int ldc; const float* ssq;
    __device__ __forceinline__ void operator()(const f32x4 (&acc)[2][2][4][2], const pg8::Unit& u, int wr, int wc, int fr, int fq) const {
        const int row0 = u.pm * pg8::BM + wr * 64 + fr, col0 = u.pn * pg8::BM + wc * 32 + 8 * fq;
#pragma unroll
        for (int ai = 0; ai < 2; ++ai)
#pragma unroll
            for (int m = 0; m < 4; ++m) {
                const int row = row0 + ai * pg8::HALF + m * 16;
                const float rs = row_rstd(ssq, row, fq);
                bf16_t* rowp = O + (size_t)row * ldc + col0;
#pragma unroll
                for (int bj = 0; bj < 2; ++bj) {
                    f32x4 v0 = acc[ai][bj][m][0] * rs, v1 = acc[ai][bj][m][1] * rs;
                    if (ACT == 1) {
#pragma unroll
                        for (int i = 0; i < 4; ++i) { const float a = fmaxf(v0[i], 0.f), b = fmaxf(v1[i], 0.f); v0[i] = a * a; v1[i] = b * b; }
                    }
                    u32x4 w; w.x = pk2(v0[0], v0[1]); w.y = pk2(v0[2], v0[3]); w.z = pk2(v1[0], v1[1]); w.w = pk2(v1[2], v1[3]);
                    *(u32x4*)(rowp + bj * pg8::HALF) = w;
                }
            }
    }
};
struct EpiRes {
    static constexpr bool PERM = true, AFTER_DRAIN = false;
    const float* res; float* out; bf16_t* xb; float* ssq;
    __device__ __forceinline__ void operator()(const f32x4 (&acc)[2][2][4][2], const pg8::Unit& u, int wr, int wc, int fr, int fq) const {
        const int row0 = u.pm * pg8::BM + wr * 64 + fr, col0 = u.pn * pg8::BM + wc * 32 + 8 * fq;
#pragma unroll
        for (int ai = 0; ai < 2; ++ai)
#pragma unroll
            for (int m = 0; m < 4; ++m) {
                const int row = row0 + ai * pg8::HALF + m * 16;
                const size_t off = (size_t)row * DM + col0;
                float part = 0.f;
#pragma unroll
                for (int bj = 0; bj < 2; ++bj) {
                    const f32x4 r0 = *(const f32x4*)(res + off + bj * pg8::HALF), r1 = *(const f32x4*)(res + off + bj * pg8::HALF + 4);
                    const f32x4 v0 = acc[ai][bj][m][0] + r0, v1 = acc[ai][bj][m][1] + r1;
                    *(f32x4*)(out + off + bj * pg8::HALF) = v0; *(f32x4*)(out + off + bj * pg8::HALF + 4) = v1;
                    if (xb) { u32x4 w; w.x = pk2(v0[0], v0[1]); w.y = pk2(v0[2], v0[3]); w.z = pk2(v1[0], v1[1]); w.w = pk2(v1[2], v1[3]); *(u32x4*)(xb + off + bj * pg8::HALF) = w; }
                    part += (v0[0] * v0[0] + v0[1] * v0[1]) + (v0[2] * v0[2] + v0[3] * v0[3]) + (v1[0] * v1[0] + v1[1] * v1[1]) + (v1[2] * v1[2] + v1[3] * v1[3]);
                }
                part += __shfl_xor(part, 16); part += __shfl_xor(part, 32);
                if (ssq && fq == 0) ssq[(size_t)row * 16 + u.pn * 4 + wc] = part;
            }
    }
};
template <class Epi> __device__ __forceinline__ void run_gemm(LAS unsigned char* lds, const bf16_t* A, const bf16_t* Bt, int M, int N, int K, const Epi& E, int bid) {
    pg8::Gemm g{A, Bt, M, N, K}; pg8::StaticOrder so; so.init(M, N, (int)gridDim.x, bid);
    pg8::gemm_phase<Epi, pg8::StaticOrder, true, true>(lds, g, so, E);
}

__device__ __forceinline__ void transpose_item(const float* W, int K, int ld, int nblk, const float* scale, bf16_t* WT, LAS float* scr, int item, int lane) {
    const int kb = item / nblk, nb = item % nblk, k0 = 64 * kb, n0 = 32 * nb;
    float tv[32];
#pragma unroll
    for (int i = 0; i < 32; ++i) { const int kk = 2 * i + (lane >> 5); tv[i] = W[(size_t)(k0 + kk) * ld + n0 + (lane & 31)]; }
    if (scale) {
#pragma unroll
        for (int i = 0; i < 32; ++i) tv[i] *= scale[k0 + 2 * i + (lane >> 5)];
    }
#pragma unroll
    for (int i = 0; i < 32; ++i) scr[(2 * i + (lane >> 5)) * 33 + (lane & 31)] = tv[i];
    LDS_WAIT();
    const int c = lane & 7;
#pragma unroll
    for (int j = 0; j < 4; ++j) {
        const int n = (lane >> 3) + 8 * j; const LAS float* s = scr + (8 * c) * 33 + n;
        u32x4 o; o.x = pk2(s[0 * 33], s[1 * 33]); o.y = pk2(s[2 * 33], s[3 * 33]); o.z = pk2(s[4 * 33], s[5 * 33]); o.w = pk2(s[6 * 33], s[7 * 33]);
        *(u32x4*)(WT + (size_t)(n0 + n) * K + k0 + 8 * c) = o;
    }
    LDS_WAIT();
}
__device__ __forceinline__ void rope_entry(int pos, int i, float& cs, float& sn) {
    const double R = 0.74989420933245582730;
    double inv = 1.0; { double b = R; int e = i; while (e) { if (e & 1) inv *= b; b *= b; e >>= 1; } }
    const double ang = (double)pos * inv;
    const double n = __builtin_rint(ang * 0.63661977236758134308);
    double y = __builtin_fma(-n, 1.57079632679489655800, ang); y = __builtin_fma(-n, 6.12323399573676603587e-17, y);
    const double y2 = y * y;
    double sp = -1.0 / 1307674368000.0; sp = sp * y2 + 1.0 / 6227020800.0; sp = sp * y2 - 1.0 / 39916800.0; sp = sp * y2 + 1.0 / 362880.0; sp = sp * y2 - 1.0 / 5040.0;
    sp = sp * y2 + 1.0 / 120.0; sp = sp * y2 - 1.0 / 6.0; sp = sp * y2 + 1.0; const double sy = sp * y;
    double cp = 1.0 / 20922789888000.0; cp = cp * y2 - 1.0 / 87178291200.0; cp = cp * y2 + 1.0 / 479001600.0; cp = cp * y2 - 1.0 / 3628800.0; cp = cp * y2 + 1.0 / 40320.0;
    cp = cp * y2 - 1.0 / 720.0; cp = cp * y2 + 1.0 / 24.0; cp = cp * y2 - 0.5; const double cy = cp * y2 + 1.0;
    const int q = (int)((long long)n & 3);
    const double s_ = (q == 0) ? sy : (q == 1) ? cy : (q == 2) ? -sy : -cy;
    const double c_ = (q == 0) ? cy : (q == 1) ? -sy : (q == 2) ? -cy : sy;
    cs = (float)c_; sn = (float)s_;
}
__device__ __forceinline__ void prologue(const Params& p, LAS unsigned char* lds, int tid, int wave, int lane) {
    unsigned char* ws = p.ws;
    const int G = (int)gridDim.x, gw = (int)blockIdx.x * 8 + wave, NGW = G * 8;
    LAS float* scr = (LAS float*)(lds + wave * 8704);
    constexpr int I_IN = 16 * 88, I_OUT = 16 * 32, I_UP = 16 * 128, I_DN = 64 * 32, I_L = I_IN + I_OUT + I_UP + I_DN;
    for (int it = gw; it < 2 * I_L; it += NGW) {
        const int l = it / I_L; int r = it % I_L;
        if (r < I_IN) { transpose_item(p.w_in + (size_t)l * DM * INW, DM, INW, 88, p.ln1 + l * DM, (bf16_t*)(ws + WS_WIN + l * WIN_L), scr, r, lane); continue; } r -= I_IN;
        if (r < I_OUT) { transpose_item(p.w_out + (size_t)l * DM * DM, DM, DM, 32, nullptr, (bf16_t*)(ws + WS_WOUT + l * WOUT_L), scr, r, lane); continue; } r -= I_OUT;
        if (r < I_UP) { transpose_item(p.w_up + (size_t)l * DM * FF, DM, FF, 128, p.ln2 + l * DM, (bf16_t*)(ws + WS_WUP + l * WUP_L), scr, r, lane); continue; } r -= I_UP;
        transpose_item(p.w_down + (size_t)l * FF * DM, FF, DM, 32, nullptr, (bf16_t*)(ws + WS_WDN + l * WDN_L), scr, r, lane);
    }
    { float* WG = (float*)(ws + WS_WG);
      for (int e = (int)blockIdx.x * NTHR + tid; e < 2 * 8 * DM; e += G * NTHR) { const int l = e >> 13, c = (e >> 10) & 7, k = e & 1023; WG[e] = p.ln1[l * DM + k] * p.w_in[((size_t)l * DM + k) * INW + NIN + c]; } }
    { float* COS = (float*)(ws + WS_COS); float* SIN = (float*)(ws + WS_SIN);
      for (int e = (int)blockIdx.x * NTHR + tid; e < S * 32; e += G * NTHR) { float c, s; rope_entry(e >> 5, e & 31, c, s); COS[e] = c; SIN[e] = s; } }
    { bf16_t* XB = (bf16_t*)(ws + WS_XB); float* SSQ = (float*)(ws + WS_SSQ);
      for (int m0 = gw * 4; m0 < T; m0 += NGW * 4) {
          f32x4 v[4][4];
#pragma unroll
          for (int rr = 0; rr < 4; ++rr) { const f32x4* xr = (const f32x4*)(p.x + (size_t)(m0 + rr) * DM) + lane;
#pragma unroll
              for (int j = 0; j < 4; ++j) v[rr][j] = xr[64 * j]; }
#pragma unroll
          for (int rr = 0; rr < 4; ++rr) {
              float s = 0.f;
#pragma unroll
              for (int j = 0; j < 4; ++j) s += (v[rr][j][0] * v[rr][j][0] + v[rr][j][1] * v[rr][j][1]) + (v[rr][j][2] * v[rr][j][2] + v[rr][j][3] * v[rr][j][3]);
              s = wave_sum(s);
              u32x2* o8 = (u32x2*)(XB + (size_t)(m0 + rr) * DM) + lane;
#pragma unroll
              for (int j = 0; j < 4; ++j) { u32x2 w; w.x = pk2(v[rr][j][0], v[rr][j][1]); w.y = pk2(v[rr][j][2], v[rr][j][3]); o8[64 * j] = w; }
              if (lane < 16) SSQ[(size_t)(m0 + rr) * 16 + lane] = (lane == 0) ? s : 0.f;
          }
      } }
}

__device__ __forceinline__ void prep_unit(const Params& p, int layer, int u, LAS unsigned char* lds, int tid, int wave, int lane) {
    unsigned char* ws = p.ws;
    const int blk = u / 30, job = u % 30;
    const int row0 = blk * 256, b = blk >> 6, pos0 = (blk & 63) * 256;
    bf16_t* PROJ = (bf16_t*)(ws + WS_PROJ);
    const int c = lane & 7, tl = lane >> 3;
    if (job < 20) {
        int col; const float* gw; float scale; bool iskm = false; int kh = 0;
        if (job < 6) { col = C_MQ + 64 * job; gw = p.moba_q_norm + layer * 64; scale = QSCALE; }
        else if (job < 12) { kh = job - 6; col = C_MK + 64 * kh; gw = p.moba_k_norm + layer * 64; scale = 1.f; iskm = true; }
        else if (job < 18) { col = C_SQ + 64 * (job - 12); gw = p.swa_q_norm + layer * 64; scale = QSCALE; }
        else { col = C_SK + 64 * (job - 18); gw = p.swa_k_norm + layer * 64; scale = 1.f; }
        float gv[8]; { const f32x4 g0 = *(const f32x4*)(gw + 8 * c), g1 = *(const f32x4*)(gw + 8 * c + 4); gv[0] = g0[0]; gv[1] = g0[1]; gv[2] = g0[2]; gv[3] = g0[3]; gv[4] = g1[0]; gv[5] = g1[1]; gv[6] = g1[2]; gv[7] = g1[3]; }
        float ks[8];
#pragma unroll
        for (int e = 0; e < 8; ++e) ks[e] = 0.f;
        const float* COS = (const float*)(ws + WS_COS); const float* SIN = (const float*)(ws + WS_SIN);
#pragma unroll
        for (int it = 0; it < 4; ++it) {
            const int tt = 32 * wave + 8 * it + tl;
            bf16_t* ptr = PROJ + (size_t)(row0 + tt) * NIN + col + 8 * c;
            const u32x4 w = *(const u32x4*)ptr; float v[8]; unpack8(w, v);
            float ss = 0.f;
#pragma unroll
            for (int e = 0; e < 8; ++e) ss += v[e] * v[e];
            ss += __shfl_xor(ss, 1); ss += __shfl_xor(ss, 2); ss += __shfl_xor(ss, 4);
            const float rs = rsqrtf(ss * (1.0f / 64.0f) + EPS);
            const int pos = pos0 + tt;
            const f32x4 c0 = *(const f32x4*)(COS + (size_t)pos * 32 + 8 * (c & 3)), c1 = *(const f32x4*)(COS + (size_t)pos * 32 + 8 * (c & 3) + 4);
            const f32x4 s0 = *(const f32x4*)(SIN + (size_t)pos * 32 + 8 * (c & 3)), s1 = *(const f32x4*)(SIN + (size_t)pos * 32 + 8 * (c & 3) + 4);
            float o[8];
#pragma unroll
            for (int e = 0; e < 8; ++e) {
                const float val = v[e] * rs * gv[e]; const float pr = __shfl_xor(val, 4);
                const float cs = (e < 4) ? c0[e & 3] : c1[e & 3], sn = (e < 4) ? s0[e & 3] : s1[e & 3];
                o[e] = (c < 4) ? (val * cs - pr * sn) : (val * cs + pr * sn);
                ks[e] += o[e];
                o[e] *= scale;
            }
            *(u32x4*)ptr = pack8(o);
        }
        if (iskm) {
#pragma unroll
            for (int e = 0; e < 8; ++e) { ks[e] += __shfl_xor(ks[e], 8); ks[e] += __shfl_xor(ks[e], 16); ks[e] += __shfl_xor(ks[e], 32); }
            LAS float* red = (LAS float*)lds;
            if (tl == 0) {
#pragma unroll
                for (int e = 0; e < 8; ++e) red[wave * 64 + 8 * c + e] = ks[e];
            }
            __syncthreads();
            if (tid < 64) {
                float s = 0.f;
#pragma unroll
                for (int w8 = 0; w8 < 8; ++w8) s += red[w8 * 64 + tid];
                const float mean = s * (1.0f / 256.0f); const unsigned hb = pk2(mean, 0.f) & 0xffffu; const unsigned lb = pk2(mean - bflo(hb), 0.f) & 0xffffu;
                const size_t ki = ((size_t)((b * 6 + kh) * 64 + (blk & 63))) * 64 + tid;
                ((bf16_t*)(ws + WS_KMH))[ki] = (bf16_t)hb; ((bf16_t*)(ws + WS_KML))[ki] = (bf16_t)lb;
            }
            __syncthreads();
        }
    } else if (job < 28) {
        const int cj = job - 20, col = C_XQK + 64 * cj; const float osc = (cj >= 4) ? 0.125f : 1.f;
        bf16_t* LQK = (bf16_t*)(ws + WS_LQK);
        float cw[4][8], cb[8];
#pragma unroll
        for (int jj = 0; jj < 4; ++jj) { const float* wp = p.conv_w + ((size_t)layer * 4 + jj) * 512 + 64 * cj + 8 * c; const f32x4 a = *(const f32x4*)wp, bq = *(const f32x4*)(wp + 4);
            cw[jj][0] = a[0]; cw[jj][1] = a[1]; cw[jj][2] = a[2]; cw[jj][3] = a[3]; cw[jj][4] = bq[0]; cw[jj][5] = bq[1]; cw[jj][6] = bq[2]; cw[jj][7] = bq[3]; }
        { const float* bp = p.conv_b + (size_t)layer * 512 + 64 * cj + 8 * c; const f32x4 a = *(const f32x4*)bp, bq = *(const f32x4*)(bp + 4);
          cb[0] = a[0]; cb[1] = a[1]; cb[2] = a[2]; cb[3] = a[3]; cb[4] = bq[0]; cb[5] = bq[1]; cb[6] = bq[2]; cb[7] = bq[3]; }
#pragma unroll
        for (int it = 0; it < 4; ++it) {
            const int tt = 32 * wave + 8 * it + tl, pos = pos0 + tt; const size_t row = (size_t)row0 + tt;
            float acc[8];
#pragma unroll
            for (int e = 0; e < 8; ++e) acc[e] = cb[e];
#pragma unroll
            for (int jj = 0; jj < 4; ++jj) {
                if (pos - 3 + jj >= 0) {
                    const u32x4 w = *(const u32x4*)(PROJ + (row - 3 + jj) * NIN + col + 8 * c); float v[8]; unpack8(w, v);
#pragma unroll
                    for (int e = 0; e < 8; ++e) acc[e] += cw[jj][e] * v[e];
                }
            }
            float o[8];
#pragma unroll
            for (int e = 0; e < 8; ++e) { const float y = acc[e]; o[e] = y / (1.f + __expf(-y)) * osc; }
            *(u32x4*)(LQK + row * 512 + 64 * cj + 8 * c) = pack8(o);
        }
    } else {
        const int gh = job - 28;
        const float* WG = (const float*)(ws + WS_WG) + (size_t)layer * 8 * DM + (size_t)gh * 4 * DM;
        const bf16_t* XB = (const bf16_t*)(ws + WS_XB); const float* SSQ = (const float*)(ws + WS_SSQ); float* GT = (float*)(ws + WS_GATES);
        float wg[4][16];
#pragma unroll
        for (int cc = 0; cc < 4; ++cc)
#pragma unroll
            for (int hf = 0; hf < 2; ++hf) { const float* wp = WG + cc * DM + 512 * hf + 8 * lane; const f32x4 a = *(const f32x4*)wp, bq = *(const f32x4*)(wp + 4);
                wg[cc][8 * hf + 0] = a[0]; wg[cc][8 * hf + 1] = a[1]; wg[cc][8 * hf + 2] = a[2]; wg[cc][8 * hf + 3] = a[3]; wg[cc][8 * hf + 4] = bq[0]; wg[cc][8 * hf + 5] = bq[1]; wg[cc][8 * hf + 6] = bq[2]; wg[cc][8 * hf + 7] = bq[3]; }
        float bias = 0.f; if (lane < 4) bias = (gh == 0) ? p.igate_b[layer * 4 + lane] : p.fgate_b[layer * 4 + lane];
#pragma unroll 1
        for (int rr = 0; rr < 32; ++rr) {
            const size_t row = (size_t)row0 + 32 * wave + rr;
            const u32x4 a0 = *(const u32x4*)(XB + row * DM + 8 * lane), a1 = *(const u32x4*)(XB + row * DM + 512 + 8 * lane);
            float xv[16]; { float t0[8], t1[8]; unpack8(a0, t0); unpack8(a1, t1);
#pragma unroll
                for (int e = 0; e < 8; ++e) { xv[e] = t0[e]; xv[8 + e] = t1[e]; } }
            float d[4];
#pragma unroll
            for (int cc = 0; cc < 4; ++cc) { float s = 0.f;
#pragma unroll
                for (int k = 0; k < 16; ++k) s += xv[k] * wg[cc][k];
                d[cc] = wave_sum(s); }
            float sp = SSQ[row * 16 + (lane & 15)]; sp += __shfl_xor(sp, 1); sp += __shfl_xor(sp, 2); sp += __shfl_xor(sp, 4); sp += __shfl_xor(sp, 8);
            const float rs = rsqrtf(sp * (1.0f / 1024.0f) + EPS);
            float dv = d[0]; dv = (lane == 1) ? d[1] : dv; dv = (lane == 2) ? d[2] : dv; dv = (lane == 3) ? d[3] : dv;
            if (lane < 4) GT[row * 8 + 4 * gh + lane] = dv * rs + bias;
        }
    }
}

#define RLX_AGENT __ATOMIC_RELAXED, __HIP_MEMORY_SCOPE_AGENT
#define XB_TMO      128
#define XB_XCNT(j)  (256  + 64 * (j))
#define XB_XSUB(j)  (1280 + 64 * (j))
#define XB_XGEN(j)  (2304 + 64 * (j))
#define XB_TOP      3328
#define XB_TOPGEN   3392
#define XCD_BAR_WORDS 3456
#define XB_SPIN_CAP (1u << 18)

__device__ __forceinline__ unsigned xb_ld(unsigned* p)              { return __hip_atomic_load(p, __ATOMIC_RELAXED, __HIP_MEMORY_SCOPE_AGENT); }
__device__ __forceinline__ unsigned xb_add(unsigned* p, unsigned v) { return __hip_atomic_fetch_add(p, v, __ATOMIC_RELAXED, __HIP_MEMORY_SCOPE_AGENT); }
__device__ __forceinline__ unsigned xb_xcc_id() { return (unsigned)__builtin_amdgcn_s_getreg((3 << 11) | 20) & 0xFu; }
#define XB_SPIN(cond, bar) do { unsigned _sp = 0; while (cond) { __builtin_amdgcn_s_sleep(1); \
    if ((++_sp & 255u) == 0u) { if (xb_ld(&(bar)[XB_TMO])) break; if (_sp > XB_SPIN_CAP) { atomicAdd(&(bar)[XB_TMO], 1u); break; } } } } while (0)

struct XcdBarrier {
    unsigned* bar; unsigned x;
    volatile LAS unsigned* st;
};

__device__ __forceinline__ XcdBarrier xcd_barrier_post(unsigned* bar, volatile LAS unsigned* st) {
    XcdBarrier b; b.bar = bar; b.x = xb_xcc_id(); b.st = st;
    if (threadIdx.x == 0) (void)xb_add(&bar[XB_XCNT(b.x)], 1u);
    return b;
}
__device__ __forceinline__ void xcd_barrier_complete(unsigned* bar, unsigned x, unsigned& nloc, unsigned& nx) {
    const unsigned G = gridDim.x * gridDim.y * gridDim.z;
    unsigned sum, cnt, mine, sp = 0u;
    for (;;) {
        sum = 0u; cnt = 0u; mine = 0u;
#pragma unroll
        for (unsigned j = 0; j < 16; ++j) { const unsigned c = xb_ld(&bar[XB_XCNT(j)]); sum += c; cnt += (c > 0u) ? 1u : 0u; mine = (j == x) ? c : mine; }
        if (sum == G) break;
        __builtin_amdgcn_s_sleep(1);
        if ((++sp & 255u) == 0u) { if (xb_ld(&bar[XB_TMO])) break; if (sp > XB_SPIN_CAP) { atomicAdd(&bar[XB_TMO], 1u); break; } }
    }
    nloc = mine > 0u ? mine : 1u; nx = cnt > 0u ? cnt : 1u;
}

__device__ __forceinline__ void xcd_barrier(const XcdBarrier& b) {
    asm volatile("s_waitcnt vmcnt(0)" ::: "memory");
    __syncthreads();
    if (threadIdx.x == 0) {
        unsigned* bar = b.bar;
        __builtin_amdgcn_s_waitcnt(0);
        unsigned nloc = b.st[0], nx = b.st[1];
        if (nloc == 0u) { xcd_barrier_complete(bar, b.x, nloc, nx); b.st[0] = nloc; b.st[1] = nx; }
        const unsigned old = xb_add(&bar[XB_XSUB(b.x)], 1u);
        const unsigned gen = old / nloc;
        if (old + 1u == (gen + 1u) * nloc) {
            __builtin_amdgcn_fence(__ATOMIC_RELEASE, "agent");
            asm volatile("s_waitcnt vmcnt(0)" ::: "memory");
            const unsigned og = xb_add(&bar[XB_TOP], 1u);
            const unsigned tg = og / nx;
            if (og + 1u == (tg + 1u) * nx) xb_add(&bar[XB_TOPGEN], 1u);
            else XB_SPIN(xb_ld(&bar[XB_TOPGEN]) == tg, bar);
            __builtin_amdgcn_fence(__ATOMIC_ACQUIRE, "agent");
            xb_add(&bar[XB_XGEN(b.x)], 1u);
            asm volatile("s_waitcnt vmcnt(0)" ::: "memory");
        } else {
            XB_SPIN(xb_ld(&bar[XB_XGEN(b.x)]) == gen, bar);
            __builtin_amdgcn_fence(__ATOMIC_ACQUIRE, "agent");
            asm volatile("s_waitcnt vmcnt(0)" ::: "memory");
        }
    }
    __syncthreads();
}

constexpr int KP = 72, VP = 260;
constexpr int AT_KS = 0, AT_VT = 256 * KP * 2, AT_LIST = AT_VT + 64 * VP * 2, AT_CNT = AT_LIST + 16384;
__device__ __forceinline__ void stage_kv256(LAS unsigned char* lds, const bf16_t* kb, const bf16_t* vb, long row0, long rowmin, int tid) {
#pragma unroll
    for (int i = 0; i < 4; ++i) {
        const int chunk = i * NTHR + tid, row = chunk >> 3, c8 = chunk & 7;
        long gr = row0 + row; gr = gr < rowmin ? rowmin : gr;
        const u32x4 kv = *(const u32x4*)(kb + gr * NIN + 8 * c8);
        const u32x4 vv = *(const u32x4*)(vb + gr * NIN + 8 * c8);
        *(LAS u32x4*)(lds + AT_KS + (row * KP + 8 * c8) * 2) = kv;
        LAS bf16_t* vt = (LAS bf16_t*)(lds + AT_VT) + (8 * c8) * VP + row;
        vt[0 * VP] = (bf16_t)(vv.x & 0xffffu); vt[1 * VP] = (bf16_t)(vv.x >> 16); vt[2 * VP] = (bf16_t)(vv.y & 0xffffu); vt[3 * VP] = (bf16_t)(vv.y >> 16);
        vt[4 * VP] = (bf16_t)(vv.z & 0xffffu); vt[5 * VP] = (bf16_t)(vv.z >> 16); vt[6 * VP] = (bf16_t)(vv.w & 0xffffu); vt[7 * VP] = (bf16_t)(vv.w >> 16);
    }
}
__device__ __forceinline__ void attn_tile(const LAS unsigned char* lds, const bf16x8 (&qf)[4], int kmin, int kmax, int r32, int hi, f32x16 (&o)[2], float& mrow, float& lrow) {
    const LAS unsigned char* kbase = lds + AT_KS + (r32 * KP + 8 * hi) * 2;
    const LAS unsigned char* vbase = lds + AT_VT + (r32 * VP + 4 * hi) * 2;
    const int klo = kmin - 4 * hi, khi = kmax - 4 * hi;
#pragma unroll
    for (int dt = 0; dt < 2; ++dt)
#pragma unroll
        for (int r = 0; r < 16; ++r) o[dt][r] = 0.f;
    float m = -INFINITY, l = 0.f;
#pragma unroll 1
    for (int kt = 0; kt < 8; ++kt) {
        f32x16 s;
#pragma unroll
        for (int r = 0; r < 16; ++r) s[r] = 0.f;
#pragma unroll
        for (int d0 = 0; d0 < 4; ++d0) {
            const bf16x8 kf = *(const LAS bf16x8*)(kbase + (32 * kt * KP + 16 * d0) * 2);
            s = __builtin_amdgcn_mfma_f32_32x32x16_bf16(kf, qf[d0], s, 0, 0, 0);
        }
        float tmx = -INFINITY;
#pragma unroll
        for (int r = 0; r < 16; ++r) {
            const int kv = 32 * kt + (r & 3) + 8 * (r >> 2);
            const float v = (kv >= klo && kv <= khi) ? s[r] : -INFINITY;
            s[r] = v; tmx = fmaxf(tmx, v);
        }
        tmx = fmaxf(tmx, __shfl_xor(tmx, 32));
        const float mn = fmaxf(m, tmx), mu = (mn == -INFINITY) ? 0.f : mn;
        const float sc = exp2_fast(m - mu);
        float sum = 0.f;
#pragma unroll
        for (int r = 0; r < 16; ++r) { const float pv = exp2_fast(s[r] - mu); s[r] = pv; sum += pv; }
        sum += __shfl_xor(sum, 32);
        l = l * sc + sum; m = mn;
#pragma unroll
        for (int dt = 0; dt < 2; ++dt)
#pragma unroll
            for (int r = 0; r < 16; ++r) o[dt][r] *= sc;
#pragma unroll
        for (int j = 0; j < 2; ++j) {
            u32x4 pw; pw.x = pk2(s[8 * j + 0], s[8 * j + 1]); pw.y = pk2(s[8 * j + 2], s[8 * j + 3]); pw.z = pk2(s[8 * j + 4], s[8 * j + 5]); pw.w = pk2(s[8 * j + 6], s[8 * j + 7]);
            const bf16x8 pb = __builtin_bit_cast(bf16x8, pw);
#pragma unroll
            for (int dt = 0; dt < 2; ++dt) {
                const LAS unsigned char* vp = vbase + (32 * dt * VP + 32 * kt + 16 * j) * 2;
                const u32x2 lo = *(const LAS u32x2*)vp, hi2 = *(const LAS u32x2*)(vp + 16);
                u32x4 vw; vw.x = lo.x; vw.y = lo.y; vw.z = hi2.x; vw.w = hi2.y;
                o[dt] = __builtin_amdgcn_mfma_f32_32x32x16_bf16(__builtin_bit_cast(bf16x8, vw), pb, o[dt], 0, 0, 0);
            }
        }
    }
    mrow = m; lrow = l;
}
__device__ __forceinline__ void store_orow_bf16(bf16_t* dst, const f32x16 (&o)[2], float sc, int hi) {
#pragma unroll
    for (int dt = 0; dt < 2; ++dt)
#pragma unroll
        for (int g = 0; g < 4; ++g) { u32x2 w; w.x = pk2(o[dt][4 * g] * sc, o[dt][4 * g + 1] * sc); w.y = pk2(o[dt][4 * g + 2] * sc, o[dt][4 * g + 3] * sc); *(u32x2*)(dst + 32 * dt + 8 * g + 4 * hi) = w; }
}
__device__ __forceinline__ void load_qf(bf16x8 (&qf)[4], const bf16_t* qrow, int hi) {
#pragma unroll
    for (int d0 = 0; d0 < 4; ++d0) qf[d0] = *(const bf16x8*)(qrow + 16 * d0 + 8 * hi);
}

__device__ __forceinline__ void swa_unit(const Params& p, int layer, int u, LAS unsigned char* lds, int tid, int wave, int lane) {
    const int kh = u & 1, n = (u >> 1) & 127, b = u >> 8;
    const bf16_t* PROJ = (const bf16_t*)(p.ws + WS_PROJ); bf16_t* YC = (bf16_t*)(p.ws + WS_YCAT);
    const long rowb = (long)b * S;
    stage_kv256(lds, PROJ + C_SK + 64 * kh, PROJ + C_SV + 64 * kh, rowb + 128 * (n - 1), rowb, tid);
    __syncthreads();
    const int r32 = lane & 31, hi = lane >> 5;
    for (int tl = wave; tl < 12; tl += 8) {
        const int qh = 3 * kh + (tl >> 2), rt = tl & 3, qi = 32 * rt + r32; const long row = rowb + 128 * n + qi;
        bf16x8 qf[4]; load_qf(qf, PROJ + row * NIN + C_SQ + 64 * qh, hi);
        int kmin = qi + 1; if (n == 0 && kmin < 128) kmin = 128;
        f32x16 o[2]; float m, l; attn_tile(lds, qf, kmin, qi + 128, r32, hi, o, m, l);
        l += exp2_fast(p.swa_sinks[layer * 6 + qh] * LOG2E - m);
        store_orow_bf16(YC + row * DM + 640 + 64 * qh, o, 1.0f / l, hi);
    }
    __syncthreads();
}

#define TOP3_INSERT(g, ju) do { if ((g) > v0) { v2 = v1; i2 = i1; v1 = v0; i1 = i0; v0 = (g); i0 = (ju); } else if ((g) > v1) { v2 = v1; i2 = i1; v1 = (g); i1 = (ju); } else if ((g) > v2) { v2 = (g); i2 = (ju); } } while (0)
__device__ __forceinline__ void sel_wave_unit(const Params& p, int wu, int lane) {
    const int bh = wu >> 8, i = wu & 255, b = bh / 6, h = bh % 6, t0 = i * 64, blk = t0 >> 8;
    unsigned* SEL = (unsigned*)(p.ws + WS_SEL) + (size_t)bh * S + t0;
    if (blk == 0) { SEL[lane] = 0xFFFFFFu; return; }
    const int r32 = lane & 31, hi = lane >> 5;
    const bf16_t* KH = (const bf16_t*)(p.ws + WS_KMH) + (size_t)bh * 4096; const bf16_t* KL = (const bf16_t*)(p.ws + WS_KML) + (size_t)bh * 4096;
    const bf16_t* PROJ = (const bf16_t*)(p.ws + WS_PROJ);
    const int njt = (blk > 32) ? 2 : 1;
#pragma unroll 1
    for (int qt = 0; qt < 2; ++qt) {
        bf16x8 qf[4]; load_qf(qf, PROJ + ((size_t)b * S + t0 + 32 * qt + r32) * NIN + C_MQ + 64 * h, hi);
        float v0 = -INFINITY, v1 = -INFINITY, v2 = -INFINITY; unsigned i0 = 255u, i1 = 255u, i2 = 255u;
#pragma unroll 1
        for (int jt = 0; jt < njt; ++jt) {
            f32x16 acc;
#pragma unroll
            for (int r = 0; r < 16; ++r) acc[r] = 0.f;
#pragma unroll
            for (int d0 = 0; d0 < 4; ++d0) {
                const bf16x8 ah = *(const bf16x8*)(KH + (32 * jt + r32) * 64 + 16 * d0 + 8 * hi), al = *(const bf16x8*)(KL + (32 * jt + r32) * 64 + 16 * d0 + 8 * hi);
                acc = __builtin_amdgcn_mfma_f32_32x32x16_bf16(ah, qf[d0], acc, 0, 0, 0);
                acc = __builtin_amdgcn_mfma_f32_32x32x16_bf16(al, qf[d0], acc, 0, 0, 0);
            }
#pragma unroll
            for (int r = 0; r < 16; ++r) { const int j = 32 * jt + (r & 3) + 8 * (r >> 2) + 4 * hi; const float g = (j < blk) ? acc[r] : -INFINITY; const unsigned ju = (unsigned)j; TOP3_INSERT(g, ju); }
        }
        const float p0 = __shfl_xor(v0, 32), p1 = __shfl_xor(v1, 32), p2 = __shfl_xor(v2, 32);
        const unsigned q0 = (unsigned)__shfl_xor((int)i0, 32), q1 = (unsigned)__shfl_xor((int)i1, 32), q2 = (unsigned)__shfl_xor((int)i2, 32);
        TOP3_INSERT(p0, q0); TOP3_INSERT(p1, q1); TOP3_INSERT(p2, q2);
        if (hi == 0) SEL[32 * qt + r32] = i0 | (i1 << 8) | (i2 << 16);
    }
}
__device__ __forceinline__ void moba_sel_unit(const Params& p, int v, LAS unsigned char* lds, int tid, int wave, int lane) {
    const int bh = v % 12, w = v / 12, b = bh / 6, h = bh % 6;
    int j = 0, c = w; for (;;) { const int nc = (63 - j + 15) >> 4; if (c < nc) break; c -= nc; ++j; }
    const int tstart = 256 * (j + 1) + 4096 * c;
    const bf16_t* PROJ = (const bf16_t*)(p.ws + WS_PROJ);
    u32x4 kreg[4], vreg[4];
    { const bf16_t* kb = PROJ + C_MK + 64 * h; const bf16_t* vb = PROJ + C_MV + 64 * h; const long row0 = (long)b * S + 256 * j;
#pragma unroll
      for (int i = 0; i < 4; ++i) { const int chunk = i * NTHR + tid, row = chunk >> 3, c8 = chunk & 7; kreg[i] = *(const u32x4*)(kb + (row0 + row) * NIN + 8 * c8); vreg[i] = *(const u32x4*)(vb + (row0 + row) * NIN + 8 * c8); } }
    LAS unsigned* list = (LAS unsigned*)(lds + AT_LIST); LAS unsigned* cnt = (LAS unsigned*)(lds + AT_CNT);
    if (tid == 0) *cnt = 0u;
    __syncthreads();
    const unsigned* SEL = (const unsigned*)(p.ws + WS_SEL) + (size_t)bh * S;
    unsigned selv[8];
#pragma unroll
    for (int i = 0; i < 8; ++i) { const int t = tstart + i * NTHR + tid; selv[i] = (t < S) ? SEL[t] : 0xFFFFFFu; }
#pragma unroll
    for (int i = 0; i < 8; ++i) {
        const unsigned sel = selv[i]; int rk = -1;
        if ((sel & 0xffu) == (unsigned)j) rk = 0; else if (((sel >> 8) & 0xffu) == (unsigned)j) rk = 1; else if (((sel >> 16) & 0xffu) == (unsigned)j) rk = 2;
        if (rk >= 0) { const unsigned pos = __hip_atomic_fetch_add(cnt, 1u, __ATOMIC_RELAXED, __HIP_MEMORY_SCOPE_WORKGROUP); list[pos] = (unsigned)(i * NTHR + tid) | ((unsigned)rk << 16); }
    }
#pragma unroll
    for (int i = 0; i < 4; ++i) {
        const int chunk = i * NTHR + tid, row = chunk >> 3, c8 = chunk & 7;
        *(LAS u32x4*)(lds + AT_KS + (row * KP + 8 * c8) * 2) = kreg[i];
        LAS bf16_t* vt = (LAS bf16_t*)(lds + AT_VT) + (8 * c8) * VP + row; const u32x4 vv = vreg[i];
        vt[0 * VP] = (bf16_t)(vv.x & 0xffffu); vt[1 * VP] = (bf16_t)(vv.x >> 16); vt[2 * VP] = (bf16_t)(vv.y & 0xffffu); vt[3 * VP] = (bf16_t)(vv.y >> 16);
        vt[4 * VP] = (bf16_t)(vv.z & 0xffffu); vt[5 * VP] = (bf16_t)(vv.z >> 16); vt[6 * VP] = (bf16_t)(vv.w & 0xffffu); vt[7 * VP] = (bf16_t)(vv.w >> 16);
    }
    __syncthreads();
    const int n = (int)*cnt;
    {
        const int r32 = lane & 31, hi = lane >> 5, ntl = (n + 31) >> 5;
        float* PML = (float*)(p.ws + WS_PML); bf16_t* PO = (bf16_t*)(p.ws + WS_PARTO);
        for (int tl = wave; tl < ntl; tl += 8) {
            const int idx = 32 * tl + r32; const bool valid = idx < n;
            const unsigned e = list[valid ? idx : 0]; const int t = tstart + (int)(e & 0xffffu), rk = (int)(e >> 16);
            const long row = (long)b * S + t;
            bf16x8 qf[4]; load_qf(qf, PROJ + row * NIN + C_MQ + 64 * h, hi);
            f32x16 o[2]; float m, l; attn_tile(lds, qf, 0, 255, r32, hi, o, m, l);
            if (valid) {
                const size_t base = ((size_t)bh * S + t) * 3 + rk;
                if (hi == 0) { PML[base * 2] = m; PML[base * 2 + 1] = l; }
                store_orow_bf16(PO + base * 64, o, 1.0f, hi);
            }
        }
    }
    __syncthreads();
}
__device__ __forceinline__ void moba_own_unit(const Params& p, int u, LAS unsigned char* lds, int tid, int wave, int lane) {
    const int bh = u % 12, blk = u / 12, b = bh / 6, h = bh % 6;
    const bf16_t* PROJ = (const bf16_t*)(p.ws + WS_PROJ); bf16_t* YC = (bf16_t*)(p.ws + WS_YCAT);
    stage_kv256(lds, PROJ + C_MK + 64 * h, PROJ + C_MV + 64 * h, (long)b * S + 256 * blk, 0, tid);
    __syncthreads();
    const int r32 = lane & 31, hi = lane >> 5, qi = 32 * wave + r32, t = 256 * blk + qi; const long row = (long)b * S + t;
    bf16x8 qf[4]; load_qf(qf, PROJ + row * NIN + C_MQ + 64 * h, hi);
    f32x16 o[2]; float m, l; attn_tile(lds, qf, 0, qi, r32, hi, o, m, l);
    const int nv = blk < 3 ? blk : 3;
    const float* PML = (const float*)(p.ws + WS_PML); const bf16_t* PO = (const bf16_t*)(p.ws + WS_PARTO);
    const size_t base = ((size_t)bh * S + t) * 3;
    float mr[3], lr[3]; float M = m;
#pragma unroll
    for (int r = 0; r < 3; ++r) { mr[r] = -INFINITY; lr[r] = 0.f; if (r < nv) { const f32x2 ml = *(const f32x2*)(PML + (base + r) * 2); mr[r] = ml[0]; lr[r] = ml[1]; M = fmaxf(M, mr[r]); } }
    const float w0 = exp2_fast(m - M); float L = l * w0;
#pragma unroll
    for (int dt = 0; dt < 2; ++dt)
#pragma unroll
        for (int r = 0; r < 16; ++r) o[dt][r] *= w0;
#pragma unroll
    for (int r = 0; r < 3; ++r) {
        if (r < nv) {
            const float wr_ = exp2_fast(mr[r] - M); L += wr_ * lr[r];
            const bf16_t* src = PO + (base + r) * 64;
#pragma unroll
            for (int dt = 0; dt < 2; ++dt)
#pragma unroll
                for (int g = 0; g < 4; ++g) { const u32x2 wv = *(const u32x2*)(src + 32 * dt + 8 * g + 4 * hi);
                    o[dt][4 * g] += wr_ * bflo(wv.x); o[dt][4 * g + 1] += wr_ * bfhi(wv.x); o[dt][4 * g + 2] += wr_ * bflo(wv.y); o[dt][4 * g + 3] += wr_ * bfhi(wv.y); }
        }
    }
    store_orow_bf16(YC + row * DM + 64 * h, o, 1.0f / L, hi);
    __syncthreads();
}

__device__ __forceinline__ float log_sigmoid(float f) { return fminf(f, 0.f) - log1pf(__expf(-fabsf(f))); }
__device__ __forceinline__ float wave_incl_scan(float v, int lane) {
#pragma unroll
    for (int o = 1; o < 64; o <<= 1) { const float t = __shfl_up(v, o); if (lane >= o) v += t; }
    return v;
}
constexpr int MP = 72;
constexpr int M1_KT = 0, M1_VT = 64 * MP * 2, M1_W = M1_VT + 96 * MP * 2, M1_SUB = M1_W + 256;
__device__ __forceinline__ void m1_quad(const Params& p, int quad, LAS unsigned char* lds, int tid, int wave, int lane) {
    const int sub = wave >> 1, wp = wave & 1, unit = quad * 4 + sub, bh = unit >> 8, c = unit & 255, b = bh >> 2, h = bh & 3;
    const long row0 = (long)b * S + 64 * c;
    LAS unsigned char* L = lds + sub * M1_SUB;
    LAS float* wv = (LAS float*)(L + M1_W);
    const float* GT = (const float*)(p.ws + WS_GATES);
    if (wp == 0) {
        const float ig = GT[(row0 + lane) * 8 + h], fg = GT[(row0 + lane) * 8 + 4 + h];
        const float bs = wave_incl_scan(log_sigmoid(fg), lane);
        const float a = __shfl(bs, 63), g = a - bs + ig, mg = wave_max(g);
        wv[lane] = __expf(g - mg);
        if (lane == 0) { float* MISC = (float*)(p.ws + WS_MISC); MISC[unit] = a; MISC[2048 + unit] = mg; }
    }
    __syncthreads();
    const bf16_t* LQK = (const bf16_t*)(p.ws + WS_LQK); const bf16_t* PROJ = (const bf16_t*)(p.ws + WS_PROJ);
    const int tp = wp * 64 + lane;
#pragma unroll
    for (int i = 0; i < 4; ++i) {
        const int chunk = i * 128 + tp, s = chunk >> 3, c8 = chunk & 7;
        const u32x4 kw = *(const u32x4*)(LQK + (row0 + s) * 512 + 256 + 64 * h + 8 * c8);
        const u32x4 vw = *(const u32x4*)(PROJ + (row0 + s) * NIN + C_XV + 64 * h + 8 * c8);
        float kf[8]; unpack8(kw, kf); const float ws_ = wv[s];
        LAS bf16_t* kt = (LAS bf16_t*)(L + M1_KT) + (8 * c8) * MP + s;
#pragma unroll
        for (int e = 0; e < 8; e += 2) { const unsigned pw = pk2(kf[e] * ws_, kf[e + 1] * ws_); kt[e * MP] = (bf16_t)(pw & 0xffffu); kt[(e + 1) * MP] = (bf16_t)(pw >> 16); }
        LAS bf16_t* vt = (LAS bf16_t*)(L + M1_VT) + (8 * c8) * MP + s;
        vt[0 * MP] = (bf16_t)(vw.x & 0xffffu); vt[1 * MP] = (bf16_t)(vw.x >> 16); vt[2 * MP] = (bf16_t)(vw.y & 0xffffu); vt[3 * MP] = (bf16_t)(vw.y >> 16);
        vt[4 * MP] = (bf16_t)(vw.z & 0xffffu); vt[5 * MP] = (bf16_t)(vw.z >> 16); vt[6 * MP] = (bf16_t)(vw.w & 0xffffu); vt[7 * MP] = (bf16_t)(vw.w >> 16);
    }
#pragma unroll
    for (int i = 0; i < 16; ++i) { const int e = i * 128 + tp, rr = e >> 6, ss = e & 63; ((LAS bf16_t*)(L + M1_VT))[(64 + rr) * MP + ss] = (rr == 0) ? (bf16_t)0x3F80u : (bf16_t)0u; }
    __syncthreads();
    const int r32 = lane & 31, hi = lane >> 5;
    f32x16 acc[3];
#pragma unroll
    for (int et = 0; et < 3; ++et)
#pragma unroll
        for (int r = 0; r < 16; ++r) acc[et][r] = 0.f;
#pragma unroll
    for (int ks = 0; ks < 4; ++ks) {
        const bf16x8 bfr = *(const LAS bf16x8*)(L + M1_KT + ((32 * wp + r32) * MP + 16 * ks + 8 * hi) * 2);
#pragma unroll
        for (int et = 0; et < 3; ++et) {
            const bf16x8 afr = *(const LAS bf16x8*)(L + M1_VT + ((32 * et + r32) * MP + 16 * ks + 8 * hi) * 2);
            acc[et] = __builtin_amdgcn_mfma_f32_32x32x16_bf16(afr, bfr, acc[et], 0, 0, 0);
        }
    }
    float* DC = (float*)(p.ws + WS_DC) + (size_t)unit * 4160;
    const int d = 32 * wp + r32;
#pragma unroll
    for (int et = 0; et < 2; ++et)
#pragma unroll
        for (int r = 0; r < 16; ++r) { const int e = 32 * et + (r & 3) + 8 * (r >> 2) + 4 * hi; DC[e * 64 + d] = acc[et][r]; }
    if (hi == 0) DC[64 * 64 + d] = acc[2][0];
    __syncthreads();
}
__device__ __forceinline__ void scan_unit(const Params& p, int su, LAS unsigned char* lds, int tid) {
    const int e0 = su * NTHR, bh0 = e0 / 4160;
    const float* MISC = (const float*)(p.ws + WS_MISC); float* MS = (float*)(p.ws + WS_MISC) + 4096;
    const float* __restrict__ DC = (const float*)(p.ws + WS_DC); bf16_t* __restrict__ CST = (bf16_t*)(p.ws + WS_CST);
    LAS float* la = (LAS float*)lds; LAS float* lmg = la + 512; LAS float* ldec = la + 1024; LAS float* lsc = la + 1536;
    { const int which = tid >> 8, c = tid & 255, bh = bh0 + which;
      la[tid] = (bh < 8) ? MISC[bh * 256 + c] : 0.f; lmg[tid] = (bh < 8) ? MISC[2048 + bh * 256 + c] : 0.f; }
    __syncthreads();
    if (tid < 2) {
        const int bh = bh0 + tid; const bool own = (bh < 8) && (bh * 4160 >= e0) && (bh * 4160 < e0 + NTHR);
        float m = 0.f;
        for (int c = 0; c < 256; ++c) {
            if (own) MS[bh * 256 + c] = m;
            const float a = la[tid * 256 + c], mg = lmg[tid * 256 + c], mn = fmaxf(a + m, mg);
            ldec[tid * 256 + c] = __expf(a + m - mn); lsc[tid * 256 + c] = __expf(mg - mn); m = mn;
        }
    }
    __syncthreads();
    const int e = e0 + tid, bh = e / 4160, idx = e - bh * 4160, which = bh - bh0;
    const float* __restrict__ dcp = DC + (size_t)bh * 256 * 4160 + idx; bf16_t* __restrict__ csp = CST + (size_t)bh * 256 * 4160 + idx;
    float C = 0.f;
#pragma unroll 1
    for (int c0 = 0; c0 < 256; c0 += 32) {
        float dcv[32];
#pragma unroll
        for (int k = 0; k < 32; ++k) dcv[k] = dcp[(size_t)(c0 + k) * 4160];
#pragma unroll
        for (int k = 0; k < 32; ++k) {
            csp[(size_t)(c0 + k) * 4160] = (bf16_t)(pk2(C, 0.f) & 0xffffu);
            C = ldec[which * 256 + c0 + k] * C + lsc[which * 256 + c0 + k] * dcv[k];
        }
    }
    __syncthreads();
}
constexpr int M3_K = 0, M3_VT = 64 * MP * 2, M3_CS = 2 * 64 * MP * 2, M3_BS = M3_CS + 256, M3_SUB = M3_BS + 256;
__device__ __forceinline__ void m3_quad(const Params& p, int layer, int quad, LAS unsigned char* lds, int tid, int wave, int lane) {
    const int sub = wave >> 1, wp = wave & 1, unit = quad * 4 + sub, bh = unit >> 8, c = unit & 255, b = bh >> 2, h = bh & 3;
    const long row0 = (long)b * S + 64 * c;
    LAS unsigned char* L = lds + sub * M3_SUB;
    LAS float* cs = (LAS float*)(L + M3_CS); LAS float* bsv = (LAS float*)(L + M3_BS);
    const float* GT = (const float*)(p.ws + WS_GATES);
    if (wp == 0) {
        const float ig = GT[(row0 + lane) * 8 + h], fg = GT[(row0 + lane) * 8 + 4 + h];
        const float bs = wave_incl_scan(log_sigmoid(fg), lane);
        cs[lane] = ig - bs; bsv[lane] = bs;
    }
    const bf16_t* LQK = (const bf16_t*)(p.ws + WS_LQK); const bf16_t* PROJ = (const bf16_t*)(p.ws + WS_PROJ);
    const int tp = wp * 64 + lane;
#pragma unroll
    for (int i = 0; i < 4; ++i) {
        const int chunk = i * 128 + tp, s = chunk >> 3, c8 = chunk & 7;
        const u32x4 kw = *(const u32x4*)(LQK + (row0 + s) * 512 + 256 + 64 * h + 8 * c8);
        const u32x4 vw = *(const u32x4*)(PROJ + (row0 + s) * NIN + C_XV + 64 * h + 8 * c8);
        *(LAS u32x4*)(L + M3_K + (s * MP + 8 * c8) * 2) = kw;
        LAS bf16_t* vt = (LAS bf16_t*)(L + M3_VT) + (8 * c8) * MP + s;
        vt[0 * MP] = (bf16_t)(vw.x & 0xffffu); vt[1 * MP] = (bf16_t)(vw.x >> 16); vt[2 * MP] = (bf16_t)(vw.y & 0xffffu); vt[3 * MP] = (bf16_t)(vw.y >> 16);
        vt[4 * MP] = (bf16_t)(vw.z & 0xffffu); vt[5 * MP] = (bf16_t)(vw.z >> 16); vt[6 * MP] = (bf16_t)(vw.w & 0xffffu); vt[7 * MP] = (bf16_t)(vw.w >> 16);
    }
    __syncthreads();
    const int r32 = lane & 31, hi = lane >> 5, t = 32 * wp + r32; const long row = row0 + t;
    bf16x8 qf[4]; load_qf(qf, LQK + row * 512 + 64 * h, hi);
    f32x16 sT[2];
#pragma unroll
    for (int st = 0; st < 2; ++st) {
        f32x16 a;
#pragma unroll
        for (int r = 0; r < 16; ++r) a[r] = 0.f;
#pragma unroll
        for (int d0 = 0; d0 < 4; ++d0) {
            const bf16x8 kf = *(const LAS bf16x8*)(L + M3_K + ((32 * st + r32) * MP + 16 * d0 + 8 * hi) * 2);
            a = __builtin_amdgcn_mfma_f32_32x32x16_bf16(kf, qf[d0], a, 0, 0, 0);
        }
        sT[st] = a;
    }
    const float b_t = bsv[t], m_c = ((const float*)(p.ws + WS_MISC))[4096 + unit], inter = b_t + m_c;
    f32x16 dm[2]; float mx = inter;
#pragma unroll
    for (int st = 0; st < 2; ++st)
#pragma unroll
        for (int g = 0; g < 4; ++g) {
            const f32x4 c4 = *(const LAS f32x4*)(cs + 32 * st + 8 * g + 4 * hi);
#pragma unroll
            for (int e2 = 0; e2 < 4; ++e2) { const int s = 32 * st + 8 * g + 4 * hi + e2; const float dv = (s <= t) ? (b_t + c4[e2]) : -INFINITY; dm[st][4 * g + e2] = dv; mx = fmaxf(mx, dv); }
        }
    mx = fmaxf(mx, __shfl_xor(mx, 32));
    const float w_inter = __expf(inter - mx);
    float den = 0.f;
#pragma unroll
    for (int st = 0; st < 2; ++st)
#pragma unroll
        for (int r = 0; r < 16; ++r) { const float qk = sT[st][r] * __expf(dm[st][r] - mx); sT[st][r] = qk; den += qk; }
    den += __shfl_xor(den, 32);
    f32x16 acc[3];
    const bf16_t* CST = (const bf16_t*)(p.ws + WS_CST) + (size_t)unit * 4160;
#pragma unroll
    for (int et = 0; et < 3; ++et) {
        f32x16 a;
#pragma unroll
        for (int r = 0; r < 16; ++r) a[r] = 0.f;
#pragma unroll
        for (int d0 = 0; d0 < 4; ++d0) {
            const bf16x8 cf = *(const bf16x8*)(CST + (32 * et + r32) * 64 + 16 * d0 + 8 * hi);
            a = __builtin_amdgcn_mfma_f32_32x32x16_bf16(cf, qf[d0], a, 0, 0, 0);
        }
        acc[et] = a;
    }
    const float qn = __shfl(acc[2][0], r32);
#pragma unroll
    for (int et = 0; et < 2; ++et)
#pragma unroll
        for (int r = 0; r < 16; ++r) acc[et][r] *= w_inter;
#pragma unroll
    for (int st = 0; st < 2; ++st)
#pragma unroll
        for (int j = 0; j < 2; ++j) {
            u32x4 pw; pw.x = pk2(sT[st][8 * j + 0], sT[st][8 * j + 1]); pw.y = pk2(sT[st][8 * j + 2], sT[st][8 * j + 3]); pw.z = pk2(sT[st][8 * j + 4], sT[st][8 * j + 5]); pw.w = pk2(sT[st][8 * j + 6], sT[st][8 * j + 7]);
            const bf16x8 pb = __builtin_bit_cast(bf16x8, pw);
#pragma unroll
            for (int et = 0; et < 2; ++et) {
                const LAS unsigned char* vp = L + M3_VT + ((32 * et + r32) * MP + 32 * st + 16 * j + 4 * hi) * 2;
                const u32x2 lo = *(const LAS u32x2*)vp, hi2 = *(const LAS u32x2*)(vp + 16);
                u32x4 vw; vw.x = lo.x; vw.y = lo.y; vw.z = hi2.x; vw.w = hi2.y;
                acc[et] = __builtin_amdgcn_mfma_f32_32x32x16_bf16(__builtin_bit_cast(bf16x8, vw), pb, acc[et], 0, 0, 0);
            }
        }
    const float dtot = w_inter * qn + den, inv = 1.0f / fmaxf(fabsf(dtot), __expf(-mx));
    float ss = 0.f;
#pragma unroll
    for (int et = 0; et < 2; ++et)
#pragma unroll
        for (int g = 0; g < 4; ++g) {
            const u32x2 xw = *(const u32x2*)(PROJ + row * NIN + C_XO + 64 * h + 32 * et + 8 * g + 4 * hi);
            const float xo[4] = {bflo(xw.x), bfhi(xw.x), bflo(xw.y), bfhi(xw.y)};
#pragma unroll
            for (int e2 = 0; e2 < 4; ++e2) { const float hv = acc[et][4 * g + e2] * inv / (1.f + __expf(-xo[e2])); acc[et][4 * g + e2] = hv; ss += hv * hv; }
        }
    ss += __shfl_xor(ss, 32);
    const float rs = rsqrtf(ss * (1.0f / 64.0f) + EPS);
    const float* nw = p.mlstm_norm + (size_t)layer * 256 + 64 * h;
    bf16_t* dst = (bf16_t*)(p.ws + WS_YCAT) + row * DM + 384 + 64 * h;
#pragma unroll
    for (int et = 0; et < 2; ++et)
#pragma unroll
        for (int g = 0; g < 4; ++g) {
            const f32x4 nv = *(const f32x4*)(nw + 32 * et + 8 * g + 4 * hi);
            u32x2 w; w.x = pk2(acc[et][4 * g] * rs * nv[0], acc[et][4 * g + 1] * rs * nv[1]); w.y = pk2(acc[et][4 * g + 2] * rs * nv[2], acc[et][4 * g + 3] * rs * nv[3]);
            *(u32x2*)(dst + 32 * et + 8 * g + 4 * hi) = w;
        }
    __syncthreads();
}

#ifndef REPEAT_MASK
#define REPEAT_MASK 0
#endif
__global__ void __launch_bounds__(NTHR, 2) hybrid_fwd(Params p0) {
    extern __shared__ __attribute__((aligned(16))) unsigned char lds_raw[];
    LAS unsigned char* lds = (LAS unsigned char*)lds_raw;
    cg::grid_group grid = cg::this_grid();
    const int lo = p0.ph_lo, hi = p0.ph_hi;
    if (threadIdx.x < 16) ((LAS unsigned*)(lds + BAR_LDS_OFF))[threadIdx.x] = 0u;
    __syncthreads();
    XcdBarrier xbar; xbar.bar = (unsigned*)(p0.ws + WS_CTL) + 4096; xbar.x = 0; xbar.st = nullptr;
    if (hi - lo > 1) xbar = xcd_barrier_post((unsigned*)(p0.ws + WS_CTL) + 4096, (volatile LAS unsigned*)(lds + BAR_LDS_OFF));
#define IN(k) (lo <= (k) && (k) < hi)
#define SEAM(k) do { if (IN(k) && IN((k) + 1)) { if ((k) == 0) grid.sync(); else xcd_barrier(xbar); } } while (0)
#define PHASE_VARS() int tid = threadIdx.x; asm volatile("" : "+v"(tid)); const int lane = tid & 63, wave = __builtin_amdgcn_readfirstlane(tid >> 6); \
    int bid = (int)blockIdx.x; asm volatile("" : "+s"(bid)); const int G = (int)gridDim.x; Params p = p0; { unsigned char* w_ = p0.ws; asm volatile("" : "+s"(w_)); p.ws = w_; } unsigned char* ws = p.ws; (void)ws; (void)lane; (void)wave; (void)bid; (void)G
    for (int rep_ = 0; rep_ < ((REPEAT_MASK & 1) ? 2 : 1); ++rep_) { if (rep_) xcd_barrier(xbar);
        if (IN(0)) { PHASE_VARS(); prologue(p, lds, tid, wave, lane); }
    }
        SEAM(0);
#pragma unroll 1
    for (int layer = 0; layer < 2; ++layer) {
        const int P = 1 + 8 * layer;
        for (int rep_ = 0; rep_ < ((REPEAT_MASK & 2) ? 2 : 1); ++rep_) { if (rep_) xcd_barrier(xbar);
        if (IN(P)) { PHASE_VARS(); EpiScaled<0> E{(bf16_t*)(ws + WS_PROJ), NIN, (const float*)(ws + WS_SSQ)}; run_gemm(lds, (const bf16_t*)(ws + WS_XB), (const bf16_t*)(ws + WS_WIN + layer * WIN_L), T, NIN, DM, E, bid); }
        }
        SEAM(P);
        if (IN(P + 1)) { PHASE_VARS();
            for (int u = bid; u < 128 * 30; u += G) prep_unit(p, layer, u, lds, tid, wave, lane);
#if MIX_STAGE < 3
            { u32x4* y4 = (u32x4*)(ws + WS_YCAT); const u32x4 z = {0u, 0u, 0u, 0u}; for (size_t e = (size_t)bid * NTHR + tid; e < (size_t)T * DM / 8; e += (size_t)G * NTHR) y4[e] = z; }
#endif
        }
        SEAM(P + 1);
        for (int rep_ = 0; rep_ < ((REPEAT_MASK & 4) ? 2 : 1); ++rep_) { if (rep_) xcd_barrier(xbar);
        if (IN(P + 2)) { PHASE_VARS();
#if MIX_STAGE >= 1
            for (int q = bid; q < 512; q += G) m1_quad(p, q, lds, tid, wave, lane);
#endif
#if MIX_STAGE >= 3
            for (int wu = bid * 8 + wave; wu < 3072; wu += G * 8) sel_wave_unit(p, wu, lane);
#endif
        }
        }
        SEAM(P + 2);
        for (int rep_ = 0; rep_ < ((REPEAT_MASK & 8) ? 2 : 1); ++rep_) { if (rep_) xcd_barrier(xbar);
        if (IN(P + 3)) { PHASE_VARS();
            for (int u = bid; u < 65 + 512 + 1872; u += G) {
                if (u < 65) {
#if MIX_STAGE >= 1
                    scan_unit(p, u, lds, tid);
#endif
                } else if (u < 577) {
#if MIX_STAGE >= 2
                    swa_unit(p, layer, u - 65, lds, tid, wave, lane);
#endif
                } else {
#if MIX_STAGE >= 3
                    moba_sel_unit(p, u - 577, lds, tid, wave, lane);
#endif
                }
            }
        }
        }
        SEAM(P + 3);
        for (int rep_ = 0; rep_ < ((REPEAT_MASK & 16) ? 2 : 1); ++rep_) { if (rep_) xcd_barrier(xbar);
        if (IN(P + 4)) { PHASE_VARS();
            for (int u = bid; u < 768 + 512; u += G) {
                if (u < 768) {
#if MIX_STAGE >= 3
                    moba_own_unit(p, u, lds, tid, wave, lane);
#endif
                } else {
#if MIX_STAGE >= 1
                    m3_quad(p, layer, u - 768, lds, tid, wave, lane);
#endif
                }
            }
        }
        }
        SEAM(P + 4);
        if (IN(P + 5)) { PHASE_VARS(); EpiRes E{layer == 0 ? p.x : (const float*)p.out, p.out, (bf16_t*)(ws + WS_XB), (float*)(ws + WS_SSQ)}; run_gemm(lds, (const bf16_t*)(ws + WS_YCAT), (const bf16_t*)(ws + WS_WOUT + layer * WOUT_L), T, DM, DM, E, bid); }
        SEAM(P + 5);
        for (int rep_ = 0; rep_ < ((REPEAT_MASK & 32) ? 2 : 1); ++rep_) { if (rep_) xcd_barrier(xbar);
        if (IN(P + 6)) { PHASE_VARS(); EpiScaled<1> E{(bf16_t*)(ws + WS_H), FF, (const float*)(ws + WS_SSQ)}; run_gemm(lds, (const bf16_t*)(ws + WS_XB), (const bf16_t*)(ws + WS_WUP + layer * WUP_L), T, FF, DM, E, bid); }
        }
        SEAM(P + 6);
        if (IN(P + 7)) { PHASE_VARS(); EpiRes E{(const float*)p.out, p.out, layer == 0 ? (bf16_t*)(ws + WS_XB) : nullptr, layer == 0 ? (float*)(ws + WS_SSQ) : nullptr}; run_gemm(lds, (const bf16_t*)(ws + WS_H), (const bf16_t*)(ws + WS_WDN + layer * WDN_L), T, DM, FF, E, bid); }
        SEAM(P + 7);
    }
#undef IN
#undef SEAM
}

#ifndef N_LAUNCH_SPLIT
#define N_LAUNCH_SPLIT 0
#endif
extern "C" void kernel_launch(void* const* d_in, const int* in_sizes, int n_in, void* d_out, int out_size, void* d_ws, size_t ws_size, hipStream_t stream) {
    static int grid = 0;
    if (grid == 0) {
        if (n_in != 17 || in_sizes[0] != T * DM || out_size != T * DM || ws_size < WS_END) { fprintf(stderr, "kernel_launch: unexpected shapes (n_in %d, in0 %d, out %d, ws %zu); nothing launched\n", n_in, n_in > 0 ? in_sizes[0] : -1, out_size, ws_size); grid = -1; return; }
        int dev = 0, cus = 0, per_cu = 0;
        if (hipGetDevice(&dev) != hipSuccess || hipDeviceGetAttribute(&cus, hipDeviceAttributeMultiprocessorCount, dev) != hipSuccess) { grid = -1; return; }
        if (hipFuncSetAttribute((const void*)hybrid_fwd, hipFuncAttributeMaxDynamicSharedMemorySize, LDS_BYTES) != hipSuccess) { fprintf(stderr, "kernel_launch: hipFuncSetAttribute failed\n"); grid = -1; return; }
        if (hipOccupancyMaxActiveBlocksPerMultiprocessor(&per_cu, (const void*)hybrid_fwd, NTHR, LDS_BYTES) != hipSuccess || per_cu < 1) { fprintf(stderr, "kernel_launch: occupancy query says %d blocks per CU\n", per_cu); (void)hipGetLastError(); grid = -1; return; }
        grid = cus;
    }
    if (grid < 0) return;
    if (hipMemsetAsync((char*)d_ws + WS_CTL, 0, 65536, stream) != hipSuccess) { fprintf(stderr, "kernel_launch: memset of the barrier words failed\n"); return; }
    Params p{};
    const float** pp = (const float**)&p;
    for (int i = 0; i < 17; ++i) pp[i] = (const float*)d_in[i];
    p.out = (float*)d_out; p.ws = (unsigned char*)d_ws;
#if N_LAUNCH_SPLIT
    for (int ph = 0; ph < 17; ++ph) {
        p.ph_lo = ph; p.ph_hi = ph + 1; void* args[] = {&p};
        hipError_t e = hipLaunchCooperativeKernel((const void*)hybrid_fwd, dim3(grid), dim3(NTHR), args, LDS_BYTES, stream);
        if (e != hipSuccess) { fprintf(stderr, "cooperative launch failed: %s\n", hipGetErrorString(e)); break; }
    }
#else
    p.ph_lo = 0; p.ph_hi = 17; void* args[] = {&p};
    hipError_t e = hipLaunchCooperativeKernel((const void*)hybrid_fwd, dim3(grid), dim3(NTHR), args, LDS_BYTES, stream);
    if (e != hipSuccess) fprintf(stderr, "cooperative launch failed: %s (grid %d)\n", hipGetErrorString(e), grid);
#endif
}
```

```cpp
#include <hip/hip_runtime.h>
#include <hip/hip_cooperative_groups.h>
#include <cstdio>
#include <cstdint>
namespace cg = cooperative_groups;
namespace pg8 {
#define PG8_LAS __attribute__((address_space(3)))
typedef unsigned short bf16_t;
typedef short bf16x8 __attribute__((ext_vector_type(8)));
typedef float f32x4 __attribute__((ext_vector_type(4)));
typedef unsigned u32x4 __attribute__((ext_vector_type(4)));
constexpr int BM = 256, BK = 64, HALF = 128, HTB = HALF * BK * 2  , STAGE_BYTES = 8 * HTB, NXCD = 8, WGM = 8;

__host__ __device__ __forceinline__ int lds_byte(int r, int c) { const int st = (r >> 4) * 2 + (c >> 5), rr = r & 15, cc = c & 31, ob = rr * 64 + cc * 2; return st * 1024 + (ob ^ (((ob >> 9) & 1) << 5)); }
__host__ __device__ __forceinline__ void stage_rc(int b, int& R, int& C) { const int st = b / 1024, sb = b % 1024, swz = sb ^ (((sb >> 9) & 1) << 5); R = (st >> 1) * 16 + swz / 64; C = (st & 1) * 32 + (swz % 64) / 2; }
__host__ __device__ __forceinline__ int perm32(int rho) { const int n = rho >> 4, i = rho & 15; return 8 * (i >> 2) + 4 * n + (i & 3); }

struct Unit { int pm, pn; };
struct Gemm { const bf16_t* A; const bf16_t* Bt; int M, N, K; };

struct StaticOrder {
    int nM, nN, nwg, G, c;
    __host__ __device__ void init(int M, int N, int G_, int c_) { nM = M / BM; nN = N / BM; nwg = nM * nN; G = G_; c = c_; }
    __host__ __device__ bool next(int i, Unit& u) const {
        const long L = (long)i * G + c; if (L >= nwg) return false;
        int wgid = (int)L; { const int q = nwg / NXCD, r = nwg % NXCD, xcd = wgid % NXCD, off = wgid / NXCD; wgid = (xcd < r ? xcd * (q + 1) : r * (q + 1) + (xcd - r) * q) + off; }
        const int nig = WGM * nN, gid = wgid / nig, fm = gid * WGM, gsz = (nM - fm) < WGM ? (nM - fm) : WGM;
        u.pm = fm + ((wgid % nig) % gsz); u.pn = (wgid % nig) / gsz; return true;
    }
    __device__ __forceinline__ void a_ready(const Unit&) const {}
    __device__ __forceinline__ void done(const Unit&) const {}
};
__device__ __forceinline__ unsigned cvt_pk_bf16(float lo, float hi) { unsigned r; asm volatile("v_cvt_pk_bf16_f32 %0, %1, %2" : "=v"(r) : "v"(lo), "v"(hi)); return r; }
typedef float f32x2 __attribute__((ext_vector_type(2)));
template <class Epi, class Sched, bool ALIGN_EPI = false, bool SP2 = false>
__device__ __forceinline__ void gemm_phase(PG8_LAS unsigned char* lds, const Gemm g, const Sched& S, const Epi& E) {
    int tid_l = threadIdx.x; asm volatile("" : "+v"(tid_l)); const int tid = tid_l, wid = __builtin_amdgcn_readfirstlane(tid >> 6), lane = tid & 63, wr = wid >> 2, wc = wid & 3, fr = lane & 15, fq = lane >> 4;
    const int K = g.K, nt = K / BK;
    unsigned voffA[2], voffB[2];
#pragma unroll
    for (int i = 0; i < 2; ++i) { int R, C; stage_rc(tid * 16 + i * 8192, R, C); const int Rb = Epi::PERM ? ((R & ~31) + perm32(R & 31)) : R;
        voffA[i] = (unsigned)(R * K + C) * 2u; voffB[i] = (unsigned)(Rb * K + C) * 2u; }
    const size_t kstep = (size_t)(BK * 2);
    const size_t hstep = (size_t)HALF * K * 2;
    const size_t tstep = 2 * hstep;
    const unsigned ldsw = (unsigned)wid * 1024u;
    const int aoff = lds_byte(wr * 64 + fr, fq * 8), boff = lds_byte(wc * 32 + fr, fq * 8);
#define PG8_SA(b, h) (((b) * 2 + (h)) * HTB)
#define PG8_SB(b, h) ((4 + (b) * 2 + (h)) * HTB)
#define PG8_STAGE(bufoff, gbase, voff) do { _Pragma("unroll") for (int _i = 0; _i < 2; ++_i) \
        __builtin_amdgcn_global_load_lds((const unsigned*)((const char*)(gbase) + (voff)[_i]), (PG8_LAS unsigned*)(lds + (bufoff) + ldsw + _i * 8192), 16, 0, 0); } while (0)
#define PG8_LDA(dst, b, h) do { _Pragma("unroll") for (int m = 0; m < 4; ++m) _Pragma("unroll") for (int k = 0; k < 2; ++k) dst[m][k] = *(const PG8_LAS bf16x8*)(lds + PG8_SA(b, h) + aoff + m * 2048 + k * 1024); } while (0)
#define PG8_LDB(dst, b, h) do { _Pragma("unroll") for (int n = 0; n < 2; ++n) _Pragma("unroll") for (int k = 0; k < 2; ++k) dst[n][k] = *(const PG8_LAS bf16x8*)(lds + PG8_SB(b, h) + boff + n * 2048 + k * 1024); } while (0)
#define PG8_MMA(ai, bj, At, Bt) do { __builtin_amdgcn_s_setprio(1); _Pragma("unroll") for (int m = 0; m < 4; ++m) _Pragma("unroll") for (int n = 0; n < 2; ++n) _Pragma("unroll") for (int k = 0; k < 2; ++k) \
        acc[ai][bj][m][n] = __builtin_amdgcn_mfma_f32_16x16x32_bf16(Bt[n][k], At[m][k], acc[ai][bj][m][n], 0, 0, 0); __builtin_amdgcn_s_setprio(0); } while (0)
#define PG8_WAIT_V(n) asm volatile("s_waitcnt vmcnt(" #n ")" ::: "memory")
#define PG8_WAIT_L(n) asm volatile("s_waitcnt lgkmcnt(" #n ")" ::: "memory")
#define PG8_BAR __builtin_amdgcn_s_barrier()
#define PG8_SCHED __builtin_amdgcn_sched_barrier(0)
    Unit cur, nxt; int ui = 0;
    if (!S.next(0, cur)) return;
    f32x4 acc[2][2][4][2];
#pragma unroll
    for (int a = 0; a < 2; ++a)
#pragma unroll
        for (int b = 0; b < 2; ++b)
#pragma unroll
            for (int m = 0; m < 4; ++m)
#pragma unroll
                for (int n = 0; n < 2; ++n) acc[a][b][m][n] = (f32x4){0.f, 0.f, 0.f, 0.f};
    bf16x8 At[4][2], B0[2][2], B1[2][2];
    const char* cA = (const char*)g.A + (size_t)cur.pm * tstep; const char* cB = (const char*)g.Bt + (size_t)cur.pn * tstep;
    S.a_ready(cur);
    if constexpr (SP2) {
        PG8_STAGE(PG8_SB(0, 0), cB, voffB); PG8_STAGE(PG8_SB(0, 1), cB + hstep, voffB); PG8_STAGE(PG8_SA(0, 0), cA, voffA); PG8_STAGE(PG8_SA(0, 1), cA + hstep, voffA);
        if (wr == 1) PG8_BAR;
        PG8_WAIT_V(2); PG8_BAR;
        PG8_STAGE(PG8_SB(1, 0), cB + kstep, voffB); PG8_STAGE(PG8_SA(1, 0), cA + kstep, voffA); PG8_STAGE(PG8_SB(1, 1), cB + hstep + kstep, voffB);
        PG8_WAIT_V(6); PG8_BAR;
    } else {
        PG8_STAGE(PG8_SB(0, 0), cB, voffB); PG8_STAGE(PG8_SA(0, 0), cA, voffA); PG8_STAGE(PG8_SB(0, 1), cB + hstep, voffB); PG8_STAGE(PG8_SA(0, 1), cA + hstep, voffA);
        if (wr == 1) PG8_BAR;
        PG8_WAIT_V(4); PG8_BAR;
        PG8_STAGE(PG8_SB(1, 0), cB + kstep, voffB); PG8_STAGE(PG8_SA(1, 0), cA + kstep, voffA); PG8_STAGE(PG8_SB(1, 1), cB + hstep + kstep, voffB);
        PG8_WAIT_V(6); PG8_BAR;
    }
    for (;;) {
        const bool has_next = S.next(ui + 1, nxt);
        const char* nA = has_next ? (const char*)g.A + (size_t)nxt.pm * tstep : cA; const char* nB = has_next ? (const char*)g.Bt + (size_t)nxt.pn * tstep : cB;
        for (int t = 0; t < nt; t += 2) {
            const bool last = (t == nt - 2);
            const char* a1 = cA + (size_t)(t + 1) * kstep;
            const char* a2 = last ? nA : cA + (size_t)(t + 2) * kstep; const char* b2 = last ? nB : cB + (size_t)(t + 2) * kstep;
            const char* a3 = a2 + kstep; const char* b3 = b2 + kstep;
            if (last && has_next) S.a_ready(nxt);
            if constexpr (SP2) {
            PG8_LDB(B0, 0, 0); PG8_LDB(B1, 0, 1); PG8_SCHED; PG8_LDA(At, 0, 0); PG8_STAGE(PG8_SA(1, 1), a1 + hstep, voffA);
            PG8_WAIT_V(8); PG8_WAIT_L(0); PG8_BAR; PG8_MMA(0, 0, At, B0); PG8_MMA(0, 1, At, B1); PG8_BAR; PG8_SCHED;
            PG8_LDA(At, 0, 1); PG8_STAGE(PG8_SB(0, 0), b2, voffB); PG8_STAGE(PG8_SB(0, 1), b2 + hstep, voffB); PG8_STAGE(PG8_SA(0, 0), a2, voffA);
            PG8_WAIT_V(8); PG8_WAIT_L(0); PG8_BAR; PG8_MMA(1, 0, At, B0); PG8_MMA(1, 1, At, B1); PG8_BAR; PG8_SCHED;
            PG8_LDB(B0, 1, 0); PG8_LDB(B1, 1, 1); PG8_SCHED; PG8_LDA(At, 1, 0); PG8_STAGE(PG8_SA(0, 1), a2 + hstep, voffA);
            PG8_WAIT_V(8); PG8_WAIT_L(0); PG8_BAR; PG8_MMA(0, 0, At, B0); PG8_MMA(0, 1, At, B1); PG8_BAR; PG8_SCHED;
            PG8_LDA(At, 1, 1); PG8_STAGE(PG8_SB(1, 0), b3, voffB); PG8_STAGE(PG8_SB(1, 1), b3 + hstep, voffB); PG8_STAGE(PG8_SA(1, 0), a3, voffA);
            PG8_WAIT_V(8); PG8_WAIT_L(0); PG8_BAR; PG8_MMA(1, 0, At, B0); PG8_MMA(1, 1, At, B1); PG8_BAR; PG8_SCHED;
            } else {
            PG8_LDB(B0, 0, 0); PG8_SCHED; PG8_LDA(At, 0, 0); PG8_STAGE(PG8_SA(1, 1), a1 + hstep, voffA);
            PG8_WAIT_L(8); PG8_BAR; PG8_WAIT_L(0); PG8_MMA(0, 0, At, B0); PG8_BAR; PG8_SCHED;
            PG8_LDB(B1, 0, 1); PG8_STAGE(PG8_SB(0, 0), b2, voffB);
            PG8_BAR; PG8_WAIT_L(0); PG8_MMA(0, 1, At, B1); PG8_BAR;
            PG8_LDA(At, 0, 1); PG8_STAGE(PG8_SA(0, 0), a2, voffA);
            PG8_BAR; PG8_WAIT_L(0); PG8_MMA(1, 0, At, B0); PG8_BAR; PG8_SCHED;
            PG8_STAGE(PG8_SB(0, 1), b2 + hstep, voffB);
            PG8_WAIT_V(6); PG8_BAR; PG8_MMA(1, 1, At, B1); PG8_BAR;
            PG8_LDB(B0, 1, 0); PG8_SCHED; PG8_LDA(At, 1, 0); PG8_STAGE(PG8_SA(0, 1), a2 + hstep, voffA);
            PG8_WAIT_L(8); PG8_BAR; PG8_WAIT_L(0); PG8_MMA(0, 0, At, B0); PG8_BAR; PG8_SCHED;
            PG8_LDB(B1, 1, 1); PG8_STAGE(PG8_SB(1, 0), b3, voffB);
            PG8_BAR; PG8_WAIT_L(0); PG8_MMA(0, 1, At, B1); PG8_BAR;
            PG8_LDA(At, 1, 1); PG8_STAGE(PG8_SA(1, 0), a3, voffA);
            PG8_BAR; PG8_WAIT_L(0); PG8_MMA(1, 0, At, B0); PG8_BAR; PG8_SCHED;
            PG8_STAGE(PG8_SB(1, 1), b3 + hstep, voffB);
            PG8_WAIT_V(6); PG8_BAR; PG8_MMA(1, 1, At, B1); PG8_BAR;
            }
        }
        if constexpr (ALIGN_EPI) { if (wr == 0) PG8_BAR; }
        if constexpr (!Epi::AFTER_DRAIN) { E(acc, cur, wr, wc, fr, fq); S.done(cur); }
        if (!has_next) break;
#pragma unroll
        for (int a = 0; a < 2; ++a)
#pragma unroll
            for (int b = 0; b < 2; ++b)
#pragma unroll
                for (int m = 0; m < 4; ++m)
#pragma unroll
                    for (int n = 0; n < 2; ++n) acc[a][b][m][n] = (f32x4){0.f, 0.f, 0.f, 0.f};
        cur = nxt; cA = nA; cB = nB; ++ui;
        if constexpr (ALIGN_EPI) { if (wr == 1) PG8_BAR; }
    }
    PG8_WAIT_V(0);
    if constexpr (!ALIGN_EPI) { if (wr == 0) PG8_BAR; }
    PG8_BAR;
    if constexpr (Epi::AFTER_DRAIN) { E.fused(acc, cur, wr, wc, fr, fq, lds, wid, lane); S.done(cur); }
#undef PG8_SA
#undef PG8_SB
#undef PG8_STAGE
#undef PG8_LDA
#undef PG8_LDB
#undef PG8_MMA
#undef PG8_WAIT_V
#undef PG8_WAIT_L
#undef PG8_BAR
#undef PG8_SCHED
}
}

#ifndef MIX_STAGE
#define MIX_STAGE 3
#endif
using pg8::bf16_t; using pg8::bf16x8; using pg8::f32x4; using pg8::u32x4; using pg8::f32x2;
#define LAS __attribute__((address_space(3)))
typedef float f32x16 __attribute__((ext_vector_type(16)));
typedef unsigned u32x2 __attribute__((ext_vector_type(2)));
typedef __bf16 bf16x2_t __attribute__((ext_vector_type(2)));

constexpr int NB = 2, S = 16384, T = NB * S, DM = 1024, NIN = 2816, INW = 2824, FF = 4096;
constexpr int C_MQ = 0, C_MK = 384, C_MV = 768, C_SQ = 1152, C_SK = 1536, C_SV = 1664, C_XQK = 1792, C_XV = 2304, C_XO = 2560;
constexpr float EPS = 1e-6f;
constexpr float LOG2E = 1.4426950408889634f;
constexpr float QSCALE = 0.125f * LOG2E;
constexpr int NTHR = 512;

constexpr size_t MiB = 1ull << 20;
constexpr size_t WS_WIN = 1 * MiB, WIN_L = (size_t)NIN * DM * 2;
constexpr size_t WS_WOUT = 12 * MiB, WOUT_L = (size_t)DM * DM * 2;
constexpr size_t WS_WUP = 16 * MiB, WUP_L = (size_t)FF * DM * 2;
constexpr size_t WS_WDN = 32 * MiB, WDN_L = (size_t)DM * FF * 2;
constexpr size_t WS_WG = 48 * MiB;
constexpr size_t WS_COS = 49 * MiB, WS_SIN = 51 * MiB;
constexpr size_t WS_SSQ = 53 * MiB;
constexpr size_t WS_GATES = 55 * MiB;
constexpr size_t WS_KMH = 56 * MiB, WS_KML = 56 * MiB + 262144;
constexpr size_t WS_SEL = 57 * MiB;
constexpr size_t WS_MISC = 58 * MiB;
constexpr size_t WS_PML = 59 * MiB;
constexpr size_t WS_XB = 64 * MiB;
constexpr size_t WS_DC = 64 * MiB;
constexpr size_t WS_CST = 97 * MiB;
constexpr size_t WS_LQK = 128 * MiB;
constexpr size_t WS_YCAT = 160 * MiB;
constexpr size_t WS_PROJ = 224 * MiB;
constexpr size_t WS_PARTO = 400 * MiB;
constexpr size_t WS_H = 224 * MiB;
constexpr size_t WS_END = 480 * MiB;
static_assert(WS_WIN + 2 * WIN_L <= WS_WOUT && WS_DC + (size_t)2048 * 4160 * 4 <= WS_CST && WS_CST + (size_t)2049 * 4160 * 2 <= WS_LQK, "ws map");
static_assert(WS_PROJ + (size_t)T * NIN * 2 <= WS_PARTO && WS_PARTO + (size_t)12 * S * 3 * 64 * 2 <= WS_END && WS_H + (size_t)T * FF * 2 <= WS_END, "ws map 2");

constexpr int LDS_BYTES = 147456, BAR_LDS_OFF = 131072 + 64;
constexpr size_t WS_CTL = 0;

struct Params {
    const float* x; const float* ln1; const float* w_in; const float* conv_w; const float* conv_b; const float* igate_b; const float* fgate_b;
    const float* mlstm_norm; const float* moba_q_norm; const float* moba_k_norm; const float* swa_q_norm; const float* swa_k_norm; const float* swa_sinks;
    const float* w_out; const float* ln2; const float* w_up; const float* w_down;
    float* out; unsigned char* ws; int ph_lo, ph_hi;
};

__device__ __forceinline__ float wave_sum(float v) {
#pragma unroll
    for (int o = 1; o < 64; o <<= 1) v += __shfl_xor(v, o);
    return v;
}
__device__ __forceinline__ float wave_max(float v) {
#pragma unroll
    for (int o = 1; o < 64; o <<= 1) v = fmaxf(v, __shfl_xor(v, o));
    return v;
}
__device__ __forceinline__ unsigned pk2(float lo, float hi) { f32x2 v = {lo, hi}; bf16x2_t b = __builtin_convertvector(v, bf16x2_t); return __builtin_bit_cast(unsigned, b); }
__device__ __forceinline__ float bflo(unsigned w) { return __uint_as_float(w << 16); }
__device__ __forceinline__ float bfhi(unsigned w) { return __uint_as_float(w & 0xffff0000u); }
__device__ __forceinline__ void unpack8(const u32x4 w, float (&v)[8]) {
    v[0] = bflo(w.x); v[1] = bfhi(w.x); v[2] = bflo(w.y); v[3] = bfhi(w.y); v[4] = bflo(w.z); v[5] = bfhi(w.z); v[6] = bflo(w.w); v[7] = bfhi(w.w);
}
__device__ __forceinline__ u32x4 pack8(const float (&v)[8]) { u32x4 w; w.x = pk2(v[0], v[1]); w.y = pk2(v[2], v[3]); w.z = pk2(v[4], v[5]); w.w = pk2(v[6], v[7]); return w; }
#define LDS_WAIT() asm volatile("s_waitcnt lgkmcnt(0)" ::: "memory")
__device__ __forceinline__ float exp2_fast(float v) { return __builtin_amdgcn_exp2f(v); }

__device__ __forceinline__ float row_rstd(const float* ssq, int row, int fq) {
    const f32x4 p = *(const f32x4*)(ssq + (size_t)row * 16 + 4 * fq);
    float s = (p[0] + p[1]) + (p[2] + p[3]); s += __shfl_xor(s, 16); s += __shfl_xor(s, 32);
    return rsqrtf(s * (1.0f / 1024.0f) + EPS);
}
template <int ACT  > struct EpiScaled {
    static constexpr bool PERM = true, AFTER_DRAIN = false;
    bf16_t* O; int ldc; const float* ssq;
    __device__ __forceinline__ void operator()(const f32x4 (&acc)[2][2][4][2], const pg8::Unit& u, int wr, int wc, int fr, int fq) const {
        const int row0 = u.pm * pg8::BM + wr * 64 + fr, col0 = u.pn * pg8::BM + wc * 32 + 8 * fq;
        f32x4 sp[2][4];
#pragma unroll
        for (int ai = 0; ai < 2; ++ai)
#pragma unroll
            for (int m = 0; m < 4; ++m) sp[ai][m] = *(const f32x4*)(ssq + (size_t)(row0 + ai * pg8::HALF + m * 16) * 16 + 4 * fq);
#pragma unroll
        for (int ai = 0; ai < 2; ++ai)
#pragma unroll
            for (int m = 0; m < 4; ++m) {
                const int row = row0 + ai * pg8::HALF + m * 16;
                float s_ = (sp[ai][m][0] + sp[ai][m][1]) + (sp[ai][m][2] + sp[ai][m][3]); s_ += __shfl_xor(s_, 16); s_ += __shfl_xor(s_, 32);
                const float rs = rsqrtf(s_ * (1.0f / 1024.0f) + EPS);
                bf16_t* rowp = O + (size_t)row * ldc + col0;
#pragma unroll
                for (int bj = 0; bj < 2; ++bj) {
                    f32x4 v0 = acc[ai][bj][m][0] * rs, v1 = acc[ai][bj][m][1] * rs;
                    if (ACT == 1) {
#pragma unroll
                        for (int i = 0; i < 4; ++i) { const float a = fmaxf(v0[i], 0.f), b = fmaxf(v1[i], 0.f); v0[i] = a * a; v1[i] = b * b; }
                    }
                    u32x4 w; w.x = pk2(v0[0], v0[1]); w.y = pk2(v0[2], v0[3]); w.z = pk2(v1[0], v1[1]); w.w = pk2(v1[2], v1[3]);
                    *(u32x4*)(rowp + bj * pg8::HALF) = w;
                }
            }
    }
};
struct EpiRes {
    static constexpr bool PERM = true, AFTER_DRAIN = false;
    const float* res; float* out; bf16_t* xb; float* ssq;
    __device__ __forceinline__ void operator()(const f32x4 (&acc)[2][2][4][2], const pg8::Unit& u, int wr, int wc, int fr, int fq) const {
        const int row0 = u.pm * pg8::BM + wr * 64 + fr, col0 = u.pn * pg8::BM + wc * 32 + 8 * fq;
#pragma unroll
        for (int ai = 0; ai < 2; ++ai) {
            f32x4 rv[4][2][2];
#pragma unroll
            for (int m = 0; m < 4; ++m)
#pragma unroll
                for (int bj = 0; bj < 2; ++bj) { const size_t o_ = (size_t)(row0 + ai * pg8::HALF + m * 16) * DM + col0 + bj * pg8::HALF; rv[m][bj][0] = *(const f32x4*)(res + o_); rv[m][bj][1] = *(const f32x4*)(res + o_ + 4); }
#pragma unroll
            for (int m = 0; m < 4; ++m) {
                const int row = row0 + ai * pg8::HALF + m * 16;
                const size_t off = (size_t)row * DM + col0;
                float part = 0.f;
#pragma unroll
                for (int bj = 0; bj < 2; ++bj) {
                    const f32x4 r0 = rv[m][bj][0], r1 = rv[m][bj][1];
                    const f32x4 v0 = acc[ai][bj][m][0] + r0, v1 = acc[ai][bj][m][1] + r1;
                    *(f32x4*)(out + off + bj * pg8::HALF) = v0; *(f32x4*)(out + off + bj * pg8::HALF + 4) = v1;
                    if (xb) { u32x4 w; w.x = pk2(v0[0], v0[1]); w.y = pk2(v0[2], v0[3]); w.z = pk2(v1[0], v1[1]); w.w = pk2(v1[2], v1[3]); *(u32x4*)(xb + off + bj * pg8::HALF) = w; }
                    part += (v0[0] * v0[0] + v0[1] * v0[1]) + (v0[2] * v0[2] + v0[3] * v0[3]) + (v1[0] * v1[0] + v1[1] * v1[1]) + (v1[2] * v1[2] + v1[3] * v1[3]);
                }
                part += __shfl_xor(part, 16); part += __shfl_xor(part, 32);
                if (ssq && fq == 0) ssq[(size_t)row * 16 + u.pn * 4 + wc] = part;
            }
        }
    }
};
template <class Epi> __device__ __forceinline__ void run_gemm(LAS unsigned char* lds, const bf16_t* A, const bf16_t* Bt, int M, int N, int K, const Epi& E, int bid) {
    pg8::Gemm g{A, Bt, M, N, K}; pg8::StaticOrder so; so.init(M, N, (int)gridDim.x, bid);
    pg8::gemm_phase<Epi, pg8::StaticOrder, true, true>(lds, g, so, E);
}

__device__ __forceinline__ void transpose_item(const float* W, int K, int ld, int nblk, const float* scale, bf16_t* WT, LAS float* scr, int item, int lane) {
    const int kb = item / nblk, nb = item % nblk, k0 = 64 * kb, n0 = 32 * nb;
    float tv[32];
#pragma unroll
    for (int i = 0; i < 32; ++i) { const int kk = 2 * i + (lane >> 5); tv[i] = W[(size_t)(k0 + kk) * ld + n0 + (lane & 31)]; }
    if (scale) {
#pragma unroll
        for (int i = 0; i < 32; ++i) tv[i] *= scale[k0 + 2 * i + (lane >> 5)];
    }
#pragma unroll
    for (int i = 0; i < 32; ++i) scr[(2 * i + (lane >> 5)) * 33 + (lane & 31)] = tv[i];
    LDS_WAIT();
    const int c = lane & 7;
#pragma unroll
    for (int j = 0; j < 4; ++j) {
        const int n = (lane >> 3) + 8 * j; const LAS float* s = scr + (8 * c) * 33 + n;
        u32x4 o; o.x = pk2(s[0 * 33], s[1 * 33]); o.y = pk2(s[2 * 33], s[3 * 33]); o.z = pk2(s[4 * 33], s[5 * 33]); o.w = pk2(s[6 * 33], s[7 * 33]);
        *(u32x4*)(WT + (size_t)(n0 + n) * K + k0 + 8 * c) = o;
    }
    LDS_WAIT();
}
__device__ __forceinline__ void rope_entry(int pos, int i, float& cs, float& sn) {
    const double R = 0.74989420933245582730;
    double inv = 1.0; { double b = R; int e = i; while (e) { if (e & 1) inv *= b; b *= b; e >>= 1; } }
    const double ang = (double)pos * inv;
    const double n = __builtin_rint(ang * 0.63661977236758134308);
    double y = __builtin_fma(-n, 1.57079632679489655800, ang); y = __builtin_fma(-n, 6.12323399573676603587e-17, y);
    const double y2 = y * y;
    double sp = -1.0 / 1307674368000.0; sp = sp * y2 + 1.0 / 6227020800.0; sp = sp * y2 - 1.0 / 39916800.0; sp = sp * y2 + 1.0 / 362880.0; sp = sp * y2 - 1.0 / 5040.0;
    sp = sp * y2 + 1.0 / 120.0; sp = sp * y2 - 1.0 / 6.0; sp = sp * y2 + 1.0; const double sy = sp * y;
    double cp = 1.0 / 20922789888000.0; cp = cp * y2 - 1.0 / 87178291200.0; cp = cp * y2 + 1.0 / 479001600.0; cp = cp * y2 - 1.0 / 3628800.0; cp = cp * y2 + 1.0 / 40320.0;
    cp = cp * y2 - 1.0 / 720.0; cp = cp * y2 + 1.0 / 24.0; cp = cp * y2 - 0.5; const double cy = cp * y2 + 1.0;
    const int q = (int)((long long)n & 3);
    const double s_ = (q == 0) ? sy : (q == 1) ? cy : (q == 2) ? -sy : -cy;
    const double c_ = (q == 0) ? cy : (q == 1) ? -sy : (q == 2) ? -cy : sy;
    cs = (float)c_; sn = (float)s_;
}
__device__ __forceinline__ void prologue(const Params& p, LAS unsigned char* lds, int tid, int wave, int lane) {
    unsigned char* ws = p.ws;
    const int G = (int)gridDim.x, gw = (int)blockIdx.x * 8 + wave, NGW = G * 8;
    LAS float* scr = (LAS float*)(lds + wave * 8704);
    constexpr int I_IN = 16 * 88, I_OUT = 16 * 32, I_UP = 16 * 128, I_DN = 64 * 32, I_L = I_IN + I_OUT + I_UP + I_DN;
    for (int it = gw; it < 2 * I_L; it += NGW) {
        const int l = it / I_L; int r = it % I_L;
        if (r < I_IN) { transpose_item(p.w_in + (size_t)l * DM * INW, DM, INW, 88, p.ln1 + l * DM, (bf16_t*)(ws + WS_WIN + l * WIN_L), scr, r, lane); continue; } r -= I_IN;
        if (r < I_OUT) { transpose_item(p.w_out + (size_t)l * DM * DM, DM, DM, 32, nullptr, (bf16_t*)(ws + WS_WOUT + l * WOUT_L), scr, r, lane); continue; } r -= I_OUT;
        if (r < I_UP) { transpose_item(p.w_up + (size_t)l * DM * FF, DM, FF, 128, p.ln2 + l * DM, (bf16_t*)(ws + WS_WUP + l * WUP_L), scr, r, lane); continue; } r -= I_UP;
        transpose_item(p.w_down + (size_t)l * FF * DM, FF, DM, 32, nullptr, (bf16_t*)(ws + WS_WDN + l * WDN_L), scr, r, lane);
    }
    { float* WG = (float*)(ws + WS_WG);
      for (int e = (int)blockIdx.x * NTHR + tid; e < 2 * 8 * DM; e += G * NTHR) { const int l = e >> 13, c = (e >> 10) & 7, k = e & 1023; WG[e] = p.ln1[l * DM + k] * p.w_in[((size_t)l * DM + k) * INW + NIN + c]; } }
    { float* COS = (float*)(ws + WS_COS); float* SIN = (float*)(ws + WS_SIN);
      for (int e = (int)blockIdx.x * NTHR + tid; e < S * 32; e += G * NTHR) { float c, s; rope_entry(e >> 5, e & 31, c, s); COS[e] = c; SIN[e] = s; } }
    { bf16_t* XB = (bf16_t*)(ws + WS_XB); float* SSQ = (float*)(ws + WS_SSQ);
      for (int m0 = gw * 4; m0 < T; m0 += NGW * 4) {
          f32x4 v[4][4];
#pragma unroll
          for (int rr = 0; rr < 4; ++rr) { const f32x4* xr = (const f32x4*)(p.x + (size_t)(m0 + rr) * DM) + lane;
#pragma unroll
              for (int j = 0; j < 4; ++j) v[rr][j] = xr[64 * j]; }
#pragma unroll
          for (int rr = 0; rr < 4; ++rr) {
              float s = 0.f;
#pragma unroll
              for (int j = 0; j < 4; ++j) s += (v[rr][j][0] * v[rr][j][0] + v[rr][j][1] * v[rr][j][1]) + (v[rr][j][2] * v[rr][j][2] + v[rr][j][3] * v[rr][j][3]);
              s = wave_sum(s);
              u32x2* o8 = (u32x2*)(XB + (size_t)(m0 + rr) * DM) + lane;
#pragma unroll
              for (int j = 0; j < 4; ++j) { u32x2 w; w.x = pk2(v[rr][j][0], v[rr][j][1]); w.y = pk2(v[rr][j][2], v[rr][j][3]); o8[64 * j] = w; }
              if (lane < 16) SSQ[(size_t)(m0 + rr) * 16 + lane] = (lane == 0) ? s : 0.f;
          }
      } }
}

__device__ __forceinline__ void prep_unit(const Params& p, int layer, int u, LAS unsigned char* lds, int tid, int wave, int lane) {
    unsigned char* ws = p.ws;
    const int blk = u / 30, job = u % 30;
    const int row0 = blk * 256, b = blk >> 6, pos0 = (blk & 63) * 256;
    bf16_t* PROJ = (bf16_t*)(ws + WS_PROJ);
    const int c = lane & 7, tl = lane >> 3;
    if (job < 20) {
        int col; const float* gw; float scale; bool iskm = false; int kh = 0;
        if (job < 6) { col = C_MQ + 64 * job; gw = p.moba_q_norm + layer * 64; scale = QSCALE; }
        else if (job < 12) { kh = job - 6; col = C_MK + 64 * kh; gw = p.moba_k_norm + layer * 64; scale = 1.f; iskm = true; }
        else if (job < 18) { col = C_SQ + 64 * (job - 12); gw = p.swa_q_norm + layer * 64; scale = QSCALE; }
        else { col = C_SK + 64 * (job - 18); gw = p.swa_k_norm + layer * 64; scale = 1.f; }
        float gv[8]; { const f32x4 g0 = *(const f32x4*)(gw + 8 * c), g1 = *(const f32x4*)(gw + 8 * c + 4); gv[0] = g0[0]; gv[1] = g0[1]; gv[2] = g0[2]; gv[3] = g0[3]; gv[4] = g1[0]; gv[5] = g1[1]; gv[6] = g1[2]; gv[7] = g1[3]; }
        float ks[8];
#pragma unroll
        for (int e = 0; e < 8; ++e) ks[e] = 0.f;
        const float* COS = (const float*)(ws + WS_COS); const float* SIN = (const float*)(ws + WS_SIN);
        u32x4 win[4]; f32x4 cc0[4], cc1[4], sc0[4], sc1[4];
#pragma unroll
        for (int it = 0; it < 4; ++it) {
            const int tt = 32 * wave + 8 * it + tl, pos = pos0 + tt;
            win[it] = *(const u32x4*)(PROJ + (size_t)(row0 + tt) * NIN + col + 8 * c);
            cc0[it] = *(const f32x4*)(COS + (size_t)pos * 32 + 8 * (c & 3)); cc1[it] = *(const f32x4*)(COS + (size_t)pos * 32 + 8 * (c & 3) + 4);
            sc0[it] = *(const f32x4*)(SIN + (size_t)pos * 32 + 8 * (c & 3)); sc1[it] = *(const f32x4*)(SIN + (size_t)pos * 32 + 8 * (c & 3) + 4);
        }
#pragma unroll
        for (int it = 0; it < 4; ++it) {
            const int tt = 32 * wave + 8 * it + tl;
            bf16_t* ptr = PROJ + (size_t)(row0 + tt) * NIN + col + 8 * c;
            const u32x4 w = win[it]; float v[8]; unpack8(w, v);
            float ss = 0.f;
#pragma unroll
            for (int e = 0; e < 8; ++e) ss += v[e] * v[e];
            ss += __shfl_xor(ss, 1); ss += __shfl_xor(ss, 2); ss += __shfl_xor(ss, 4);
            const float rs = rsqrtf(ss * (1.0f / 64.0f) + EPS);
            const f32x4 c0 = cc0[it], c1 = cc1[it], s0 = sc0[it], s1 = sc1[it];
            float o[8];
#pragma unroll
            for (int e = 0; e < 8; ++e) {
                const float val = v[e] * rs * gv[e]; const float pr = __shfl_xor(val, 4);
                const float cs = (e < 4) ? c0[e & 3] : c1[e & 3], sn = (e < 4) ? s0[e & 3] : s1[e & 3];
                o[e] = (c < 4) ? (val * cs - pr * sn) : (val * cs + pr * sn);
                ks[e] += o[e];
                o[e] *= scale;
            }
            *(u32x4*)ptr = pack8(o);
        }
        if (iskm) {
#pragma unroll
            for (int e = 0; e < 8; ++e) { ks[e] += __shfl_xor(ks[e], 8); ks[e] += __shfl_xor(ks[e], 16); ks[e] += __shfl_xor(ks[e], 32); }
            LAS float* red = (LAS float*)lds;
            if (tl == 0) {
#pragma unroll
                for (int e = 0; e < 8; ++e) red[wave * 64 + 8 * c + e] = ks[e];
            }
            __syncthreads();
            if (tid < 64) {
                float s = 0.f;
#pragma unroll
                for (int w8 = 0; w8 < 8; ++w8) s += red[w8 * 64 + tid];
                const float mean = s * (1.0f / 256.0f); const unsigned hb = pk2(mean, 0.f) & 0xffffu; const unsigned lb = pk2(mean - bflo(hb), 0.f) & 0xffffu;
                const size_t ki = ((size_t)((b * 6 + kh) * 64 + (blk & 63))) * 64 + tid;
                ((bf16_t*)(ws + WS_KMH))[ki] = (bf16_t)hb; ((bf16_t*)(ws + WS_KML))[ki] = (bf16_t)lb;
            }
            __syncthreads();
        }
    } else if (job < 28) {
        const int cj = job - 20, col = C_XQK + 64 * cj; const float osc = (cj >= 4) ? 0.125f : 1.f;
        bf16_t* LQK = (bf16_t*)(ws + WS_LQK);
        float cw[4][8], cb[8];
#pragma unroll
        for (int jj = 0; jj < 4; ++jj) { const float* wp = p.conv_w + ((size_t)layer * 4 + jj) * 512 + 64 * cj + 8 * c; const f32x4 a = *(const f32x4*)wp, bq = *(const f32x4*)(wp + 4);
            cw[jj][0] = a[0]; cw[jj][1] = a[1]; cw[jj][2] = a[2]; cw[jj][3] = a[3]; cw[jj][4] = bq[0]; cw[jj][5] = bq[1]; cw[jj][6] = bq[2]; cw[jj][7] = bq[3]; }
        { const float* bp = p.conv_b + (size_t)layer * 512 + 64 * cj + 8 * c; const f32x4 a = *(const f32x4*)bp, bq = *(const f32x4*)(bp + 4);
          cb[0] = a[0]; cb[1] = a[1]; cb[2] = a[2]; cb[3] = a[3]; cb[4] = bq[0]; cb[5] = bq[1]; cb[6] = bq[2]; cb[7] = bq[3]; }
        u32x4 xin[4][4];
#pragma unroll
        for (int it = 0; it < 4; ++it) {
            const int tt = 32 * wave + 8 * it + tl, pos = pos0 + tt; const size_t row = (size_t)row0 + tt;
#pragma unroll
            for (int jj = 0; jj < 4; ++jj) { const u32x4 z = {0u, 0u, 0u, 0u}; xin[it][jj] = (pos - 3 + jj >= 0) ? *(const u32x4*)(PROJ + (row - 3 + jj) * NIN + col + 8 * c) : z; }
        }
#pragma unroll
        for (int it = 0; it < 4; ++it) {
            const int tt = 32 * wave + 8 * it + tl; const size_t row = (size_t)row0 + tt;
            float acc[8];
#pragma unroll
            for (int e = 0; e < 8; ++e) acc[e] = cb[e];
#pragma unroll
            for (int jj = 0; jj < 4; ++jj) {
                float v[8]; unpack8(xin[it][jj], v);
#pragma unroll
                for (int e = 0; e < 8; ++e) acc[e] += cw[jj][e] * v[e];
            }
            float o[8];
#pragma unroll
            for (int e = 0; e < 8; ++e) { const float y = acc[e]; o[e] = y / (1.f + __expf(-y)) * osc; }
            *(u32x4*)(LQK + row * 512 + 64 * cj + 8 * c) = pack8(o);
        }
    } else {
        const int gh = job - 28;
        const float* WG = (const float*)(ws + WS_WG) + (size_t)layer * 8 * DM + (size_t)gh * 4 * DM;
        const bf16_t* XB = (const bf16_t*)(ws + WS_XB); const float* SSQ = (const float*)(ws + WS_SSQ); float* GT = (float*)(ws + WS_GATES);
        float wg[4][16];
#pragma unroll
        for (int cc = 0; cc < 4; ++cc)
#pragma unroll
            for (int hf = 0; hf < 2; ++hf) { const float* wp = WG + cc * DM + 512 * hf + 8 * lane; const f32x4 a = *(const f32x4*)wp, bq = *(const f32x4*)(wp + 4);
                wg[cc][8 * hf + 0] = a[0]; wg[cc][8 * hf + 1] = a[1]; wg[cc][8 * hf + 2] = a[2]; wg[cc][8 * hf + 3] = a[3]; wg[cc][8 * hf + 4] = bq[0]; wg[cc][8 * hf + 5] = bq[1]; wg[cc][8 * hf + 6] = bq[2]; wg[cc][8 * hf + 7] = bq[3]; }
        float bias = 0.f; if (lane < 4) bias = (gh == 0) ? p.igate_b[layer * 4 + lane] : p.fgate_b[layer * 4 + lane];
#pragma unroll 1
        for (int rb = 0; rb < 32; rb += 8) {
          u32x4 xa0[8], xa1[8]; float spv[8];
#pragma unroll
          for (int r8 = 0; r8 < 8; ++r8) { const size_t row = (size_t)row0 + 32 * wave + rb + r8; xa0[r8] = *(const u32x4*)(XB + row * DM + 8 * lane); xa1[r8] = *(const u32x4*)(XB + row * DM + 512 + 8 * lane); spv[r8] = SSQ[row * 16 + (lane & 15)]; }
#pragma unroll
          for (int r8 = 0; r8 < 8; ++r8) {
            const size_t row = (size_t)row0 + 32 * wave + rb + r8;
            const u32x4 a0 = xa0[r8], a1 = xa1[r8];
            float xv[16]; { float t0[8], t1[8]; unpack8(a0, t0); unpack8(a1, t1);
#pragma unroll
                for (int e = 0; e < 8; ++e) { xv[e] = t0[e]; xv[8 + e] = t1[e]; } }
            float d[4];
#pragma unroll
            for (int cc = 0; cc < 4; ++cc) { float s = 0.f;
#pragma unroll
                for (int k = 0; k < 16; ++k) s += xv[k] * wg[cc][k];
                d[cc] = wave_sum(s); }
            float sp = spv[r8]; sp += __shfl_xor(sp, 1); sp += __shfl_xor(sp, 2); sp += __shfl_xor(sp, 4); sp += __shfl_xor(sp, 8);
            const float rs = rsqrtf(sp * (1.0f / 1024.0f) + EPS);
            float dv = d[0]; dv = (lane == 1) ? d[1] : dv; dv = (lane == 2) ? d[2] : dv; dv = (lane == 3) ? d[3] : dv;
            if (lane < 4) GT[row * 8 + 4 * gh + lane] = dv * rs + bias;
          }
        }
    }
}

#define RLX_AGENT __ATOMIC_RELAXED, __HIP_MEMORY_SCOPE_AGENT
#define XB_TMO      128
#define XB_XCNT(j)  (256  + 64 * (j))
#define XB_XSUB(j)  (1280 + 64 * (j))
#define XB_XGEN(j)  (2304 + 64 * (j))
#define XB_TOP      3328
#define XB_TOPGEN   3392
#define XCD_BAR_WORDS 3456
#define XB_SPIN_CAP (1u << 18)

__device__ __forceinline__ unsigned xb_ld(unsigned* p)              { return __hip_atomic_load(p, __ATOMIC_RELAXED, __HIP_MEMORY_SCOPE_AGENT); }
__device__ __forceinline__ unsigned xb_add(unsigned* p, unsigned v) { return __hip_atomic_fetch_add(p, v, __ATOMIC_RELAXED, __HIP_MEMORY_SCOPE_AGENT); }
__device__ __forceinline__ unsigned xb_xcc_id() { return (unsigned)__builtin_amdgcn_s_getreg((3 << 11) | 20) & 0xFu; }
#define XB_SPIN(cond, bar) do { unsigned _sp = 0; while (cond) { __builtin_amdgcn_s_sleep(1); \
    if ((++_sp & 255u) == 0u) { if (xb_ld(&(bar)[XB_TMO])) break; if (_sp > XB_SPIN_CAP) { atomicAdd(&(bar)[XB_TMO], 1u); break; } } } } while (0)

struct XcdBarrier {
    unsigned* bar; unsigned x;
    volatile LAS unsigned* st;
};

__device__ __forceinline__ XcdBarrier xcd_barrier_post(unsigned* bar, volatile LAS unsigned* st) {
    XcdBarrier b; b.bar = bar; b.x = xb_xcc_id(); b.st = st;
    if (threadIdx.x == 0) (void)xb_add(&bar[XB_XCNT(b.x)], 1u);
    return b;
}
__device__ __forceinline__ void xcd_barrier_complete(unsigned* bar, unsigned x, unsigned& nloc, unsigned& nx) {
    const unsigned G = gridDim.x * gridDim.y * gridDim.z;
    unsigned sum, cnt, mine, sp = 0u;
    for (;;) {
        sum = 0u; cnt = 0u; mine = 0u;
#pragma unroll
        for (unsigned j = 0; j < 16; ++j) { const unsigned c = xb_ld(&bar[XB_XCNT(j)]); sum += c; cnt += (c > 0u) ? 1u : 0u; mine = (j == x) ? c : mine; }
        if (sum == G) break;
        __builtin_amdgcn_s_sleep(1);
        if ((++sp & 255u) == 0u) { if (xb_ld(&bar[XB_TMO])) break; if (sp > XB_SPIN_CAP) { atomicAdd(&bar[XB_TMO], 1u); break; } }
    }
    nloc = mine > 0u ? mine : 1u; nx = cnt > 0u ? cnt : 1u;
}

__device__ __forceinline__ void xcd_barrier(const XcdBarrier& b) {
    asm volatile("s_waitcnt vmcnt(0)" ::: "memory");
    __syncthreads();
    if (threadIdx.x == 0) {
        unsigned* bar = b.bar;
        __builtin_amdgcn_s_waitcnt(0);
        unsigned nloc = b.st[0], nx = b.st[1];
        if (nloc == 0u) { xcd_barrier_complete(bar, b.x, nloc, nx); b.st[0] = nloc; b.st[1] = nx; }
        const unsigned old = xb_add(&bar[XB_XSUB(b.x)], 1u);
        const unsigned gen = old / nloc;
        if (old + 1u == (gen + 1u) * nloc) {
            __builtin_amdgcn_fence(__ATOMIC_RELEASE, "agent");
            asm volatile("s_waitcnt vmcnt(0)" ::: "memory");
            const unsigned og = xb_add(&bar[XB_TOP], 1u);
            const unsigned tg = og / nx;
            if (og + 1u == (tg + 1u) * nx) xb_add(&bar[XB_TOPGEN], 1u);
            else XB_SPIN(xb_ld(&bar[XB_TOPGEN]) == tg, bar);
            __builtin_amdgcn_fence(__ATOMIC_ACQUIRE, "agent");
            xb_add(&bar[XB_XGEN(b.x)], 1u);
            asm volatile("s_waitcnt vmcnt(0)" ::: "memory");
        } else {
            XB_SPIN(xb_ld(&bar[XB_XGEN(b.x)]) == gen, bar);
            __builtin_amdgcn_fence(__ATOMIC_ACQUIRE, "agent");
            asm volatile("s_waitcnt vmcnt(0)" ::: "memory");
        }
    }
    __syncthreads();
}

constexpr int KP = 72, VP = 260;
constexpr int AT_KS = 0, AT_VT = 256 * KP * 2, AT_LIST = AT_VT + 64 * VP * 2, AT_CNT = AT_LIST + 16384;
__device__ __forceinline__ void stage_kv256(LAS unsigned char* lds, const bf16_t* kb, const bf16_t* vb, long row0, long rowmin, int tid) {
#pragma unroll
    for (int i = 0; i < 4; ++i) {
        const int chunk = i * NTHR + tid, row = chunk >> 3, c8 = chunk & 7;
        long gr = row0 + row; gr = gr < rowmin ? rowmin : gr;
        const u32x4 kv = *(const u32x4*)(kb + gr * NIN + 8 * c8);
        const u32x4 vv = *(const u32x4*)(vb + gr * NIN + 8 * c8);
        *(LAS u32x4*)(lds + AT_KS + (row * KP + 8 * c8) * 2) = kv;
        LAS bf16_t* vt = (LAS bf16_t*)(lds + AT_VT) + (8 * c8) * VP + row;
        vt[0 * VP] = (bf16_t)(vv.x & 0xffffu); vt[1 * VP] = (bf16_t)(vv.x >> 16); vt[2 * VP] = (bf16_t)(vv.y & 0xffffu); vt[3 * VP] = (bf16_t)(vv.y >> 16);
        vt[4 * VP] = (bf16_t)(vv.z & 0xffffu); vt[5 * VP] = (bf16_t)(vv.z >> 16); vt[6 * VP] = (bf16_t)(vv.w & 0xffffu); vt[7 * VP] = (bf16_t)(vv.w >> 16);
    }
}
__device__ __forceinline__ void attn_tile(const LAS unsigned char* lds, const bf16x8 (&qf)[4], int kmin, int kmax, int r32, int hi, f32x16 (&o)[2], float& mrow, float& lrow) {
    const LAS unsigned char* kbase = lds + AT_KS + (r32 * KP + 8 * hi) * 2;
    const LAS unsigned char* vbase = lds + AT_VT + (r32 * VP + 4 * hi) * 2;
    const int klo = kmin - 4 * hi, khi = kmax - 4 * hi;
#pragma unroll
    for (int dt = 0; dt < 2; ++dt)
#pragma unroll
        for (int r = 0; r < 16; ++r) o[dt][r] = 0.f;
    float m = -INFINITY, l = 0.f;
#pragma unroll 1
    for (int kt = 0; kt < 8; ++kt) {
        f32x16 s;
#pragma unroll
        for (int r = 0; r < 16; ++r) s[r] = 0.f;
#pragma unroll
        for (int d0 = 0; d0 < 4; ++d0) {
            const bf16x8 kf = *(const LAS bf16x8*)(kbase + (32 * kt * KP + 16 * d0) * 2);
            s = __builtin_amdgcn_mfma_f32_32x32x16_bf16(kf, qf[d0], s, 0, 0, 0);
        }
        float tmx = -INFINITY;
#pragma unroll
        for (int r = 0; r < 16; ++r) {
            const int kv = 32 * kt + (r & 3) + 8 * (r >> 2);
            const float v = (kv >= klo && kv <= khi) ? s[r] : -INFINITY;
            s[r] = v; tmx = fmaxf(tmx, v);
        }
        tmx = fmaxf(tmx, __shfl_xor(tmx, 32));
        const float mn = fmaxf(m, tmx), mu = (mn == -INFINITY) ? 0.f : mn;
        const float sc = exp2_fast(m - mu);
        float sum = 0.f;
#pragma unroll
        for (int r = 0; r < 16; ++r) { const float pv = exp2_fast(s[r] - mu); s[r] = pv; sum += pv; }
        sum += __shfl_xor(sum, 32);
        l = l * sc + sum; m = mn;
#pragma unroll
        for (int dt = 0; dt < 2; ++dt)
#pragma unroll
            for (int r = 0; r < 16; ++r) o[dt][r] *= sc;
#pragma unroll
        for (int j = 0; j < 2; ++j) {
            u32x4 pw; pw.x = pk2(s[8 * j + 0], s[8 * j + 1]); pw.y = pk2(s[8 * j + 2], s[8 * j + 3]); pw.z = pk2(s[8 * j + 4], s[8 * j + 5]); pw.w = pk2(s[8 * j + 6], s[8 * j + 7]);
            const bf16x8 pb = __builtin_bit_cast(bf16x8, pw);
#pragma unroll
            for (int dt = 0; dt < 2; ++dt) {
                const LAS unsigned char* vp = vbase + (32 * dt * VP + 32 * kt + 16 * j) * 2;
                const u32x2 lo = *(const LAS u32x2*)vp, hi2 = *(const LAS u32x2*)(vp + 16);
                u32x4 vw; vw.x = lo.x; vw.y = lo.y; vw.z = hi2.x; vw.w = hi2.y;
                o[dt] = __builtin_amdgcn_mfma_f32_32x32x16_bf16(__builtin_bit_cast(bf16x8, vw), pb, o[dt], 0, 0, 0);
            }
        }
    }
    mrow = m; lrow = l;
}
__device__ __forceinline__ void store_orow_bf16(bf16_t* dst, const f32x16 (&o)[2], float sc, int hi) {
#pragma unroll
    for (int dt = 0; dt < 2; ++dt)
#pragma unroll
        for (int g = 0; g < 4; ++g) { u32x2 w; w.x = pk2(o[dt][4 * g] * sc, o[dt][4 * g + 1] * sc); w.y = pk2(o[dt][4 * g + 2] * sc, o[dt][4 * g + 3] * sc); *(u32x2*)(dst + 32 * dt + 8 * g + 4 * hi) = w; }
}
__device__ __forceinline__ void load_qf(bf16x8 (&qf)[4], const bf16_t* qrow, int hi) {
#pragma unroll
    for (int d0 = 0; d0 < 4; ++d0) qf[d0] = *(const bf16x8*)(qrow + 16 * d0 + 8 * hi);
}

__device__ __forceinline__ void swa_unit(const Params& p, int layer, int u, LAS unsigned char* lds, int tid, int wave, int lane) {
    const int kh = u & 1, n = (u >> 1) & 127, b = u >> 8;
    const bf16_t* PROJ = (const bf16_t*)(p.ws + WS_PROJ); bf16_t* YC = (bf16_t*)(p.ws + WS_YCAT);
    const long rowb = (long)b * S;
    stage_kv256(lds, PROJ + C_SK + 64 * kh, PROJ + C_SV + 64 * kh, rowb + 128 * (n - 1), rowb, tid);
    __syncthreads();
    const int r32 = lane & 31, hi = lane >> 5;
    for (int tl = wave; tl < 12; tl += 8) {
        const int qh = 3 * kh + (tl >> 2), rt = tl & 3, qi = 32 * rt + r32; const long row = rowb + 128 * n + qi;
        bf16x8 qf[4]; load_qf(qf, PROJ + row * NIN + C_SQ + 64 * qh, hi);
        int kmin = qi + 1; if (n == 0 && kmin < 128) kmin = 128;
        f32x16 o[2]; float m, l; attn_tile(lds, qf, kmin, qi + 128, r32, hi, o, m, l);
        l += exp2_fast(p.swa_sinks[layer * 6 + qh] * LOG2E - m);
        store_orow_bf16(YC + row * DM + 640 + 64 * qh, o, 1.0f / l, hi);
    }
    __syncthreads();
}

#define TOP3_INSERT(g, ju) do { if ((g) > v0) { v2 = v1; i2 = i1; v1 = v0; i1 = i0; v0 = (g); i0 = (ju); } else if ((g) > v1) { v2 = v1; i2 = i1; v1 = (g); i1 = (ju); } else if ((g) > v2) { v2 = (g); i2 = (ju); } } while (0)
__device__ __forceinline__ void sel_wave_unit(const Params& p, int wu, int lane) {
    const int bh = wu >> 8, i = wu & 255, b = bh / 6, h = bh % 6, t0 = i * 64, blk = t0 >> 8;
    unsigned* SEL = (unsigned*)(p.ws + WS_SEL) + (size_t)bh * S + t0;
    if (blk == 0) { SEL[lane] = 0xFFFFFFu; return; }
    const int r32 = lane & 31, hi = lane >> 5;
    const bf16_t* KH = (const bf16_t*)(p.ws + WS_KMH) + (size_t)bh * 4096; const bf16_t* KL = (const bf16_t*)(p.ws + WS_KML) + (size_t)bh * 4096;
    const bf16_t* PROJ = (const bf16_t*)(p.ws + WS_PROJ);
    const int njt = (blk > 32) ? 2 : 1;
#pragma unroll 1
    for (int qt = 0; qt < 2; ++qt) {
        bf16x8 qf[4]; load_qf(qf, PROJ + ((size_t)b * S + t0 + 32 * qt + r32) * NIN + C_MQ + 64 * h, hi);
        float v0 = -INFINITY, v1 = -INFINITY, v2 = -INFINITY; unsigned i0 = 255u, i1 = 255u, i2 = 255u;
#pragma unroll 1
        for (int jt = 0; jt < njt; ++jt) {
            f32x16 acc;
#pragma unroll
            for (int r = 0; r < 16; ++r) acc[r] = 0.f;
#pragma unroll
            for (int d0 = 0; d0 < 4; ++d0) {
                const bf16x8 ah = *(const bf16x8*)(KH + (32 * jt + r32) * 64 + 16 * d0 + 8 * hi), al = *(const bf16x8*)(KL + (32 * jt + r32) * 64 + 16 * d0 + 8 * hi);
                acc = __builtin_amdgcn_mfma_f32_32x32x16_bf16(ah, qf[d0], acc, 0, 0, 0);
                acc = __builtin_amdgcn_mfma_f32_32x32x16_bf16(al, qf[d0], acc, 0, 0, 0);
            }
#pragma unroll
            for (int r = 0; r < 16; ++r) { const int j = 32 * jt + (r & 3) + 8 * (r >> 2) + 4 * hi; const float g = (j < blk) ? acc[r] : -INFINITY; const unsigned ju = (unsigned)j; TOP3_INSERT(g, ju); }
        }
        const float p0 = __shfl_xor(v0, 32), p1 = __shfl_xor(v1, 32), p2 = __shfl_xor(v2, 32);
        const unsigned q0 = (unsigned)__shfl_xor((int)i0, 32), q1 = (unsigned)__shfl_xor((int)i1, 32), q2 = (unsigned)__shfl_xor((int)i2, 32);
        TOP3_INSERT(p0, q0); TOP3_INSERT(p1, q1); TOP3_INSERT(p2, q2);
        if (hi == 0) SEL[32 * qt + r32] = i0 | (i1 << 8) | (i2 << 16);
    }
}
__device__ __forceinline__ void moba_sel_unit(const Params& p, int v, LAS unsigned char* lds, int tid, int wave, int lane) {
    const int bh = v % 12, w = v / 12, b = bh / 6, h = bh % 6;
    int j = 0, c = w; for (;;) { const int nc = (63 - j + 15) >> 4; if (c < nc) break; c -= nc; ++j; }
    const int tstart = 256 * (j + 1) + 4096 * c;
    const bf16_t* PROJ = (const bf16_t*)(p.ws + WS_PROJ);
    u32x4 kreg[4], vreg[4];
    { const bf16_t* kb = PROJ + C_MK + 64 * h; const bf16_t* vb = PROJ + C_MV + 64 * h; const long row0 = (long)b * S + 256 * j;
#pragma unroll
      for (int i = 0; i < 4; ++i) { const int chunk = i * NTHR + tid, row = chunk >> 3, c8 = chunk & 7; kreg[i] = *(const u32x4*)(kb + (row0 + row) * NIN + 8 * c8); vreg[i] = *(const u32x4*)(vb + (row0 + row) * NIN + 8 * c8); } }
    LAS unsigned* list = (LAS unsigned*)(lds + AT_LIST); LAS unsigned* cnt = (LAS unsigned*)(lds + AT_CNT);
    if (tid == 0) *cnt = 0u;
    __syncthreads();
    const unsigned* SEL = (const unsigned*)(p.ws + WS_SEL) + (size_t)bh * S;
    unsigned selv[8];
#pragma unroll
    for (int i = 0; i < 8; ++i) { const int t = tstart + i * NTHR + tid; selv[i] = (t < S) ? SEL[t] : 0xFFFFFFu; }
#pragma unroll
    for (int i = 0; i < 8; ++i) {
        const unsigned sel = selv[i]; int rk = -1;
        if ((sel & 0xffu) == (unsigned)j) rk = 0; else if (((sel >> 8) & 0xffu) == (unsigned)j) rk = 1; else if (((sel >> 16) & 0xffu) == (unsigned)j) rk = 2;
        if (rk >= 0) { const unsigned pos = __hip_atomic_fetch_add(cnt, 1u, __ATOMIC_RELAXED, __HIP_MEMORY_SCOPE_WORKGROUP); list[pos] = (unsigned)(i * NTHR + tid) | ((unsigned)rk << 16); }
    }
#pragma unroll
    for (int i = 0; i < 4; ++i) {
        const int chunk = i * NTHR + tid, row = chunk >> 3, c8 = chunk & 7;
        *(LAS u32x4*)(lds + AT_KS + (row * KP + 8 * c8) * 2) = kreg[i];
        LAS bf16_t* vt = (LAS bf16_t*)(lds + AT_VT) + (8 * c8) * VP + row; const u32x4 vv = vreg[i];
        vt[0 * VP] = (bf16_t)(vv.x & 0xffffu); vt[1 * VP] = (bf16_t)(vv.x >> 16); vt[2 * VP] = (bf16_t)(vv.y & 0xffffu); vt[3 * VP] = (bf16_t)(vv.y >> 16);
        vt[4 * VP] = (bf16_t)(vv.z & 0xffffu); vt[5 * VP] = (bf16_t)(vv.z >> 16); vt[6 * VP] = (bf16_t)(vv.w & 0xffffu); vt[7 * VP] = (bf16_t)(vv.w >> 16);
    }
    __syncthreads();
    const int n = (int)*cnt;
    {
        const int r32 = lane & 31, hi = lane >> 5, ntl = (n + 31) >> 5;
        float* PML = (float*)(p.ws + WS_PML); bf16_t* PO = (bf16_t*)(p.ws + WS_PARTO);
        for (int tl = wave; tl < ntl; tl += 8) {
            const int idx = 32 * tl + r32; const bool valid = idx < n;
            const unsigned e = list[valid ? idx : 0]; const int t = tstart + (int)(e & 0xffffu), rk = (int)(e >> 16);
            const long row = (long)b * S + t;
            bf16x8 qf[4]; load_qf(qf, PROJ + row * NIN + C_MQ + 64 * h, hi);
            f32x16 o[2]; float m, l; attn_tile(lds, qf, 0, 255, r32, hi, o, m, l);
            if (valid) {
                const size_t base = ((size_t)bh * S + t) * 3 + rk;
                if (hi == 0) { PML[base * 2] = m; PML[base * 2 + 1] = l; }
                store_orow_bf16(PO + base * 64, o, 1.0f, hi);
            }
        }
    }
    __syncthreads();
}
__device__ __forceinline__ void moba_own_unit(const Params& p, int u, LAS unsigned char* lds, int tid, int wave, int lane) {
    const int bh = u % 12, blk = u / 12, b = bh / 6, h = bh % 6;
    const bf16_t* PROJ = (const bf16_t*)(p.ws + WS_PROJ); bf16_t* YC = (bf16_t*)(p.ws + WS_YCAT);
    stage_kv256(lds, PROJ + C_MK + 64 * h, PROJ + C_MV + 64 * h, (long)b * S + 256 * blk, 0, tid);
    __syncthreads();
    const int r32 = lane & 31, hi = lane >> 5, qi = 32 * wave + r32, t = 256 * blk + qi; const long row = (long)b * S + t;
    bf16x8 qf[4]; load_qf(qf, PROJ + row * NIN + C_MQ + 64 * h, hi);
    f32x16 o[2]; float m, l; attn_tile(lds, qf, 0, qi, r32, hi, o, m, l);
    const int nv = blk < 3 ? blk : 3;
    const float* PML = (const float*)(p.ws + WS_PML); const bf16_t* PO = (const bf16_t*)(p.ws + WS_PARTO);
    const size_t base = ((size_t)bh * S + t) * 3;
    float mr[3], lr[3]; float M = m;
#pragma unroll
    for (int r = 0; r < 3; ++r) { mr[r] = -INFINITY; lr[r] = 0.f; if (r < nv) { const f32x2 ml = *(const f32x2*)(PML + (base + r) * 2); mr[r] = ml[0]; lr[r] = ml[1]; M = fmaxf(M, mr[r]); } }
    const float w0 = exp2_fast(m - M); float L = l * w0;
#pragma unroll
    for (int dt = 0; dt < 2; ++dt)
#pragma unroll
        for (int r = 0; r < 16; ++r) o[dt][r] *= w0;
#pragma unroll
    for (int r = 0; r < 3; ++r) {
        if (r < nv) {
            const float wr_ = exp2_fast(mr[r] - M); L += wr_ * lr[r];
            const bf16_t* src = PO + (base + r) * 64;
#pragma unroll
            for (int dt = 0; dt < 2; ++dt)
#pragma unroll
                for (int g = 0; g < 4; ++g) { const u32x2 wv = *(const u32x2*)(src + 32 * dt + 8 * g + 4 * hi);
                    o[dt][4 * g] += wr_ * bflo(wv.x); o[dt][4 * g + 1] += wr_ * bfhi(wv.x); o[dt][4 * g + 2] += wr_ * bflo(wv.y); o[dt][4 * g + 3] += wr_ * bfhi(wv.y); }
        }
    }
    store_orow_bf16(YC + row * DM + 64 * h, o, 1.0f / L, hi);
    __syncthreads();
}

__device__ __forceinline__ float log_sigmoid(float f) { return fminf(f, 0.f) - log1pf(__expf(-fabsf(f))); }
__device__ __forceinline__ float wave_incl_scan(float v, int lane) {
#pragma unroll
    for (int o = 1; o < 64; o <<= 1) { const float t = __shfl_up(v, o); if (lane >= o) v += t; }
    return v;
}
constexpr int MP = 72;
constexpr int M1_KT = 0, M1_VT = 64 * MP * 2, M1_W = M1_VT + 96 * MP * 2, M1_SUB = M1_W + 256;
__device__ __forceinline__ void m1_quad(const Params& p, int quad, LAS unsigned char* lds, int tid, int wave, int lane) {
    const int sub = wave >> 1, wp = wave & 1, unit = quad * 4 + sub, bh = unit >> 8, c = unit & 255, b = bh >> 2, h = bh & 3;
    const long row0 = (long)b * S + 64 * c;
    LAS unsigned char* L = lds + sub * M1_SUB;
    LAS float* wv = (LAS float*)(L + M1_W);
    const float* GT = (const float*)(p.ws + WS_GATES);
    if (wp == 0) {
        const float ig = GT[(row0 + lane) * 8 + h], fg = GT[(row0 + lane) * 8 + 4 + h];
        const float bs = wave_incl_scan(log_sigmoid(fg), lane);
        const float a = __shfl(bs, 63), g = a - bs + ig, mg = wave_max(g);
        wv[lane] = __expf(g - mg);
        if (lane == 0) { float* MISC = (float*)(p.ws + WS_MISC); MISC[unit] = a; MISC[2048 + unit] = mg; }
    }
    __syncthreads();
    const bf16_t* LQK = (const bf16_t*)(p.ws + WS_LQK); const bf16_t* PROJ = (const bf16_t*)(p.ws + WS_PROJ);
    const int tp = wp * 64 + lane;
#pragma unroll
    for (int i = 0; i < 4; ++i) {
        const int chunk = i * 128 + tp, s = chunk >> 3, c8 = chunk & 7;
        const u32x4 kw = *(const u32x4*)(LQK + (row0 + s) * 512 + 256 + 64 * h + 8 * c8);
        const u32x4 vw = *(const u32x4*)(PROJ + (row0 + s) * NIN + C_XV + 64 * h + 8 * c8);
        float kf[8]; unpack8(kw, kf); const float ws_ = wv[s];
        LAS bf16_t* kt = (LAS bf16_t*)(L + M1_KT) + (8 * c8) * MP + s;
#pragma unroll
        for (int e = 0; e < 8; e += 2) { const unsigned pw = pk2(kf[e] * ws_, kf[e + 1] * ws_); kt[e * MP] = (bf16_t)(pw & 0xffffu); kt[(e + 1) * MP] = (bf16_t)(pw >> 16); }
        LAS bf16_t* vt = (LAS bf16_t*)(L + M1_VT) + (8 * c8) * MP + s;
        vt[0 * MP] = (bf16_t)(vw.x & 0xffffu); vt[1 * MP] = (bf16_t)(vw.x >> 16); vt[2 * MP] = (bf16_t)(vw.y & 0xffffu); vt[3 * MP] = (bf16_t)(vw.y >> 16);
        vt[4 * MP] = (bf16_t)(vw.z & 0xffffu); vt[5 * MP] = (bf16_t)(vw.z >> 16); vt[6 * MP] = (bf16_t)(vw.w & 0xffffu); vt[7 * MP] = (bf16_t)(vw.w >> 16);
    }
#pragma unroll
    for (int i = 0; i < 16; ++i) { const int e = i * 128 + tp, rr = e >> 6, ss = e & 63; ((LAS bf16_t*)(L + M1_VT))[(64 + rr) * MP + ss] = (rr == 0) ? (bf16_t)0x3F80u : (bf16_t)0u; }
    __syncthreads();
    const int r32 = lane & 31, hi = lane >> 5;
    f32x16 acc[3];
#pragma unroll
    for (int et = 0; et < 3; ++et)
#pragma unroll
        for (int r = 0; r < 16; ++r) acc[et][r] = 0.f;
#pragma unroll
    for (int ks = 0; ks < 4; ++ks) {
        const bf16x8 bfr = *(const LAS bf16x8*)(L + M1_KT + ((32 * wp + r32) * MP + 16 * ks + 8 * hi) * 2);
#pragma unroll
        for (int et = 0; et < 3; ++et) {
            const bf16x8 afr = *(const LAS bf16x8*)(L + M1_VT + ((32 * et + r32) * MP + 16 * ks + 8 * hi) * 2);
            acc[et] = __builtin_amdgcn_mfma_f32_32x32x16_bf16(afr, bfr, acc[et], 0, 0, 0);
        }
    }
    float* DC = (float*)(p.ws + WS_DC) + (size_t)unit * 4160;
    const int d = 32 * wp + r32;
#pragma unroll
    for (int et = 0; et < 2; ++et)
#pragma unroll
        for (int r = 0; r < 16; ++r) { const int e = 32 * et + (r & 3) + 8 * (r >> 2) + 4 * hi; DC[e * 64 + d] = acc[et][r]; }
    if (hi == 0) DC[64 * 64 + d] = acc[2][0];
    __syncthreads();
}
__device__ __forceinline__ void scan_unit(const Params& p, int su, LAS unsigned char* lds, int tid) {
    const int e0 = su * NTHR, bh0 = e0 / 4160;
    const float* MISC = (const float*)(p.ws + WS_MISC); float* MS = (float*)(p.ws + WS_MISC) + 4096;
    const float* __restrict__ DC = (const float*)(p.ws + WS_DC); bf16_t* __restrict__ CST = (bf16_t*)(p.ws + WS_CST);
    LAS float* la = (LAS float*)lds; LAS float* lmg = la + 512; LAS float* ldec = la + 1024; LAS float* lsc = la + 1536;
    { const int which = tid >> 8, c = tid & 255, bh = bh0 + which;
      la[tid] = (bh < 8) ? MISC[bh * 256 + c] : 0.f; lmg[tid] = (bh < 8) ? MISC[2048 + bh * 256 + c] : 0.f; }
    __syncthreads();
    if (tid < 2) {
        const int bh = bh0 + tid; const bool own = (bh < 8) && (bh * 4160 >= e0) && (bh * 4160 < e0 + NTHR);
        float m = 0.f;
        for (int c = 0; c < 256; ++c) {
            if (own) MS[bh * 256 + c] = m;
            const float a = la[tid * 256 + c], mg = lmg[tid * 256 + c], mn = fmaxf(a + m, mg);
            ldec[tid * 256 + c] = __expf(a + m - mn); lsc[tid * 256 + c] = __expf(mg - mn); m = mn;
        }
    }
    __syncthreads();
    const int e = e0 + tid, bh = e / 4160, idx = e - bh * 4160, which = bh - bh0;
    const float* __restrict__ dcp = DC + (size_t)bh * 256 * 4160 + idx; bf16_t* __restrict__ csp = CST + (size_t)bh * 256 * 4160 + idx;
    float C = 0.f;
#pragma unroll 1
    for (int c0 = 0; c0 < 256; c0 += 32) {
        float dcv[32];
#pragma unroll
        for (int k = 0; k < 32; ++k) dcv[k] = dcp[(size_t)(c0 + k) * 4160];
#pragma unroll
        for (int k = 0; k < 32; ++k) {
            csp[(size_t)(c0 + k) * 4160] = (bf16_t)(pk2(C, 0.f) & 0xffffu);
            C = ldec[which * 256 + c0 + k] * C + lsc[which * 256 + c0 + k] * dcv[k];
        }
    }
    __syncthreads();
}
constexpr int M3_K = 0, M3_VT = 64 * MP * 2, M3_CS = 2 * 64 * MP * 2, M3_BS = M3_CS + 256, M3_SUB = M3_BS + 256;
__device__ __forceinline__ void m3_quad(const Params& p, int layer, int quad, LAS unsigned char* lds, int tid, int wave, int lane) {
    const int sub = wave >> 1, wp = wave & 1, unit = quad * 4 + sub, bh = unit >> 8, c = unit & 255, b = bh >> 2, h = bh & 3;
    const long row0 = (long)b * S + 64 * c;
    LAS unsigned char* L = lds + sub * M3_SUB;
    LAS float* cs = (LAS float*)(L + M3_CS); LAS float* bsv = (LAS float*)(L + M3_BS);
    const float* GT = (const float*)(p.ws + WS_GATES);
    if (wp == 0) {
        const float ig = GT[(row0 + lane) * 8 + h], fg = GT[(row0 + lane) * 8 + 4 + h];
        const float bs = wave_incl_scan(log_sigmoid(fg), lane);
        cs[lane] = ig - bs; bsv[lane] = bs;
    }
    const bf16_t* LQK = (const bf16_t*)(p.ws + WS_LQK); const bf16_t* PROJ = (const bf16_t*)(p.ws + WS_PROJ);
    const int tp = wp * 64 + lane;
#pragma unroll
    for (int i = 0; i < 4; ++i) {
        const int chunk = i * 128 + tp, s = chunk >> 3, c8 = chunk & 7;
        const u32x4 kw = *(const u32x4*)(LQK + (row0 + s) * 512 + 256 + 64 * h + 8 * c8);
        const u32x4 vw = *(const u32x4*)(PROJ + (row0 + s) * NIN + C_XV + 64 * h + 8 * c8);
        *(LAS u32x4*)(L + M3_K + (s * MP + 8 * c8) * 2) = kw;
        LAS bf16_t* vt = (LAS bf16_t*)(L + M3_VT) + (8 * c8) * MP + s;
        vt[0 * MP] = (bf16_t)(vw.x & 0xffffu); vt[1 * MP] = (bf16_t)(vw.x >> 16); vt[2 * MP] = (bf16_t)(vw.y & 0xffffu); vt[3 * MP] = (bf16_t)(vw.y >> 16);
        vt[4 * MP] = (bf16_t)(vw.z & 0xffffu); vt[5 * MP] = (bf16_t)(vw.z >> 16); vt[6 * MP] = (bf16_t)(vw.w & 0xffffu); vt[7 * MP] = (bf16_t)(vw.w >> 16);
    }
    __syncthreads();
    const int r32 = lane & 31, hi = lane >> 5, t = 32 * wp + r32; const long row = row0 + t;
    bf16x8 qf[4]; load_qf(qf, LQK + row * 512 + 64 * h, hi);
    f32x16 sT[2];
#pragma unroll
    for (int st = 0; st < 2; ++st) {
        f32x16 a;
#pragma unroll
        for (int r = 0; r < 16; ++r) a[r] = 0.f;
#pragma unroll
        for (int d0 = 0; d0 < 4; ++d0) {
            const bf16x8 kf = *(const LAS bf16x8*)(L + M3_K + ((32 * st + r32) * MP + 16 * d0 + 8 * hi) * 2);
            a = __builtin_amdgcn_mfma_f32_32x32x16_bf16(kf, qf[d0], a, 0, 0, 0);
        }
        sT[st] = a;
    }
    const float b_t = bsv[t], m_c = ((const float*)(p.ws + WS_MISC))[4096 + unit], inter = b_t + m_c;
    f32x16 dm[2]; float mx = inter;
#pragma unroll
    for (int st = 0; st < 2; ++st)
#pragma unroll
        for (int g = 0; g < 4; ++g) {
            const f32x4 c4 = *(const LAS f32x4*)(cs + 32 * st + 8 * g + 4 * hi);
#pragma unroll
            for (int e2 = 0; e2 < 4; ++e2) { const int s = 32 * st + 8 * g + 4 * hi + e2; const float dv = (s <= t) ? (b_t + c4[e2]) : -INFINITY; dm[st][4 * g + e2] = dv; mx = fmaxf(mx, dv); }
        }
    mx = fmaxf(mx, __shfl_xor(mx, 32));
    const float w_inter = __expf(inter - mx);
    float den = 0.f;
#pragma unroll
    for (int st = 0; st < 2; ++st)
#pragma unroll
        for (int r = 0; r < 16; ++r) { const float qk = sT[st][r] * __expf(dm[st][r] - mx); sT[st][r] = qk; den += qk; }
    den += __shfl_xor(den, 32);
    f32x16 acc[3];
    const bf16_t* CST = (const bf16_t*)(p.ws + WS_CST) + (size_t)unit * 4160;
#pragma unroll
    for (int et = 0; et < 3; ++et) {
        f32x16 a;
#pragma unroll
        for (int r = 0; r < 16; ++r) a[r] = 0.f;
#pragma unroll
        for (int d0 = 0; d0 < 4; ++d0) {
            const bf16x8 cf = *(const bf16x8*)(CST + (32 * et + r32) * 64 + 16 * d0 + 8 * hi);
            a = __builtin_amdgcn_mfma_f32_32x32x16_bf16(cf, qf[d0], a, 0, 0, 0);
        }
        acc[et] = a;
    }
    const float qn = __shfl(acc[2][0], r32);
#pragma unroll
    for (int et = 0; et < 2; ++et)
#pragma unroll
        for (int r = 0; r < 16; ++r) acc[et][r] *= w_inter;
#pragma unroll
    for (int st = 0; st < 2; ++st)
#pragma unroll
        for (int j = 0; j < 2; ++j) {
            u32x4 pw; pw.x = pk2(sT[st][8 * j + 0], sT[st][8 * j + 1]); pw.y = pk2(sT[st][8 * j + 2], sT[st][8 * j + 3]); pw.z = pk2(sT[st][8 * j + 4], sT[st][8 * j + 5]); pw.w = pk2(sT[st][8 * j + 6], sT[st][8 * j + 7]);
            const bf16x8 pb = __builtin_bit_cast(bf16x8, pw);
#pragma unroll
            for (int et = 0; et < 2; ++et) {
                const LAS unsigned char* vp = L + M3_VT + ((32 * et + r32) * MP + 32 * st + 16 * j + 4 * hi) * 2;
                const u32x2 lo = *(const LAS u32x2*)vp, hi2 = *(const LAS u32x2*)(vp + 16);
                u32x4 vw; vw.x = lo.x; vw.y = lo.y; vw.z = hi2.x; vw.w = hi2.y;
                acc[et] = __builtin_amdgcn_mfma_f32_32x32x16_bf16(__builtin_bit_cast(bf16x8, vw), pb, acc[et], 0, 0, 0);
            }
        }
    const float dtot = w_inter * qn + den, inv = 1.0f / fmaxf(fabsf(dtot), __expf(-mx));
    float ss = 0.f;
#pragma unroll
    for (int et = 0; et < 2; ++et)
#pragma unroll
        for (int g = 0; g < 4; ++g) {
            const u32x2 xw = *(const u32x2*)(PROJ + row * NIN + C_XO + 64 * h + 32 * et + 8 * g + 4 * hi);
            const float xo[4] = {bflo(xw.x), bfhi(xw.x), bflo(xw.y), bfhi(xw.y)};
#pragma unroll
            for (int e2 = 0; e2 < 4; ++e2) { const float hv = acc[et][4 * g + e2] * inv / (1.f + __expf(-xo[e2])); acc[et][4 * g + e2] = hv; ss += hv * hv; }
        }
    ss += __shfl_xor(ss, 32);
    const float rs = rsqrtf(ss * (1.0f / 64.0f) + EPS);
    const float* nw = p.mlstm_norm + (size_t)layer * 256 + 64 * h;
    bf16_t* dst = (bf16_t*)(p.ws + WS_YCAT) + row * DM + 384 + 64 * h;
#pragma unroll
    for (int et = 0; et < 2; ++et)
#pragma unroll
        for (int g = 0; g < 4; ++g) {
            const f32x4 nv = *(const f32x4*)(nw + 32 * et + 8 * g + 4 * hi);
            u32x2 w; w.x = pk2(acc[et][4 * g] * rs * nv[0], acc[et][4 * g + 1] * rs * nv[1]); w.y = pk2(acc[et][4 * g + 2] * rs * nv[2], acc[et][4 * g + 3] * rs * nv[3]);
            *(u32x2*)(dst + 32 * et + 8 * g + 4 * hi) = w;
        }
    __syncthreads();
}

#ifndef REPEAT_MASK
#define REPEAT_MASK 0
#endif
__global__ void __launch_bounds__(NTHR, 2) hybrid_fwd(Params p0) {
    extern __shared__ __attribute__((aligned(16))) unsigned char lds_raw[];
    LAS unsigned char* lds = (LAS unsigned char*)lds_raw;
    cg::grid_group grid = cg::this_grid();
    const int lo = p0.ph_lo, hi = p0.ph_hi;
    if (threadIdx.x < 16) ((LAS unsigned*)(lds + BAR_LDS_OFF))[threadIdx.x] = 0u;
    __syncthreads();
    XcdBarrier xbar; xbar.bar = (unsigned*)(p0.ws + WS_CTL) + 4096; xbar.x = 0; xbar.st = nullptr;
    if (hi - lo > 1) xbar = xcd_barrier_post((unsigned*)(p0.ws + WS_CTL) + 4096, (volatile LAS unsigned*)(lds + BAR_LDS_OFF));
#define IN(k) (lo <= (k) && (k) < hi)
#define SEAM(k) do { if (IN(k) && IN((k) + 1)) { if ((k) == 0) grid.sync(); else xcd_barrier(xbar); } } while (0)
#define PHASE_VARS() int tid = threadIdx.x; asm volatile("" : "+v"(tid)); const int lane = tid & 63, wave = __builtin_amdgcn_readfirstlane(tid >> 6); \
    int bid = (int)blockIdx.x; asm volatile("" : "+s"(bid)); const int G = (int)gridDim.x; Params p = p0; { unsigned char* w_ = p0.ws; asm volatile("" : "+s"(w_)); p.ws = w_; } unsigned char* ws = p.ws; (void)ws; (void)lane; (void)wave; (void)bid; (void)G
    for (int rep_ = 0; rep_ < ((REPEAT_MASK & 1) ? 2 : 1); ++rep_) { if (rep_) xcd_barrier(xbar);
        if (IN(0)) { PHASE_VARS(); prologue(p, lds, tid, wave, lane); }
    }
        SEAM(0);
#pragma unroll 1
    for (int layer = 0; layer < 2; ++layer) {
        const int P = 1 + 8 * layer;
        for (int rep_ = 0; rep_ < ((REPEAT_MASK & 2) ? 2 : 1); ++rep_) { if (rep_) xcd_barrier(xbar);
        if (IN(P)) { PHASE_VARS(); EpiScaled<0> E{(bf16_t*)(ws + WS_PROJ), NIN, (const float*)(ws + WS_SSQ)}; run_gemm(lds, (const bf16_t*)(ws + WS_XB), (const bf16_t*)(ws + WS_WIN + layer * WIN_L), T, NIN, DM, E, bid); }
        }
        SEAM(P);
        if (IN(P + 1)) { PHASE_VARS();
            for (int u = bid; u < 128 * 30; u += G) prep_unit(p, layer, u, lds, tid, wave, lane);
#if MIX_STAGE < 3
            { u32x4* y4 = (u32x4*)(ws + WS_YCAT); const u32x4 z = {0u, 0u, 0u, 0u}; for (size_t e = (size_t)bid * NTHR + tid; e < (size_t)T * DM / 8; e += (size_t)G * NTHR) y4[e] = z; }
#endif
        }
        SEAM(P + 1);
        for (int rep_ = 0; rep_ < ((REPEAT_MASK & 4) ? 2 : 1); ++rep_) { if (rep_) xcd_barrier(xbar);
        if (IN(P + 2)) { PHASE_VARS();
#if MIX_STAGE >= 1
            for (int q = bid; q < 512; q += G) m1_quad(p, q, lds, tid, wave, lane);
#endif
#if MIX_STAGE >= 3
            for (int wu = bid * 8 + wave; wu < 3072; wu += G * 8) sel_wave_unit(p, wu, lane);
#endif
        }
        }
        SEAM(P + 2);
        for (int rep_ = 0; rep_ < ((REPEAT_MASK & 8) ? 2 : 1); ++rep_) { if (rep_) xcd_barrier(xbar);
        if (IN(P + 3)) { PHASE_VARS();
            for (int u = bid; u < 65 + 512 + 1872; u += G) {
                if (u < 65) {
#if MIX_STAGE >= 1
                    scan_unit(p, u, lds, tid);
#endif
                } else if (u < 577) {
#if MIX_STAGE >= 2
                    swa_unit(p, layer, u - 65, lds, tid, wave, lane);
#endif
                } else {
#if MIX_STAGE >= 3
                    moba_sel_unit(p, u - 577, lds, tid, wave, lane);
#endif
                }
            }
        }
        }
        SEAM(P + 3);
        for (int rep_ = 0; rep_ < ((REPEAT_MASK & 16) ? 2 : 1); ++rep_) { if (rep_) xcd_barrier(xbar);
        if (IN(P + 4)) { PHASE_VARS();
            for (int u = bid; u < 768 + 512; u += G) {
                if (u < 768) {
#if MIX_STAGE >= 3
                    moba_own_unit(p, u, lds, tid, wave, lane);
#endif
                } else {
#if MIX_STAGE >= 1
                    m3_quad(p, layer, u - 768, lds, tid, wave, lane);
#endif
                }
            }
        }
        }
        SEAM(P + 4);
        if (IN(P + 5)) { PHASE_VARS(); EpiRes E{layer == 0 ? p.x : (const float*)p.out, p.out, (bf16_t*)(ws + WS_XB), (float*)(ws + WS_SSQ)}; run_gemm(lds, (const bf16_t*)(ws + WS_YCAT), (const bf16_t*)(ws + WS_WOUT + layer * WOUT_L), T, DM, DM, E, bid); }
        SEAM(P + 5);
        for (int rep_ = 0; rep_ < ((REPEAT_MASK & 32) ? 2 : 1); ++rep_) { if (rep_) xcd_barrier(xbar);
        if (IN(P + 6)) { PHASE_VARS(); EpiScaled<1> E{(bf16_t*)(ws + WS_H), FF, (const float*)(ws + WS_SSQ)}; run_gemm(lds, (const bf16_t*)(ws + WS_XB), (const bf16_t*)(ws + WS_WUP + layer * WUP_L), T, FF, DM, E, bid); }
        }
        SEAM(P + 6);
        if (IN(P + 7)) { PHASE_VARS(); EpiRes E{(const float*)p.out, p.out, layer == 0 ? (bf16_t*)(ws + WS_XB) : nullptr, layer == 0 ? (float*)(ws + WS_SSQ) : nullptr}; run_gemm(lds, (const bf16_t*)(ws + WS_H), (const bf16_t*)(ws + WS_WDN + layer * WDN_L), T, DM, FF, E, bid); }
        SEAM(P + 7);
    }
#undef IN
#undef SEAM
}

#ifndef N_LAUNCH_SPLIT
#define N_LAUNCH_SPLIT 0
#endif
extern "C" void kernel_launch(void* const* d_in, const int* in_sizes, int n_in, void* d_out, int out_size, void* d_ws, size_t ws_size, hipStream_t stream) {
    static int grid = 0;
    if (grid == 0) {
        if (n_in != 17 || in_sizes[0] != T * DM || out_size != T * DM || ws_size < WS_END) { fprintf(stderr, "kernel_launch: unexpected shapes (n_in %d, in0 %d, out %d, ws %zu); nothing launched\n", n_in, n_in > 0 ? in_sizes[0] : -1, out_size, ws_size); grid = -1; return; }
        int dev = 0, cus = 0, per_cu = 0;
        if (hipGetDevice(&dev) != hipSuccess || hipDeviceGetAttribute(&cus, hipDeviceAttributeMultiprocessorCount, dev) != hipSuccess) { grid = -1; return; }
        if (hipFuncSetAttribute((const void*)hybrid_fwd, hipFuncAttributeMaxDynamicSharedMemorySize, LDS_BYTES) != hipSuccess) { fprintf(stderr, "kernel_launch: hipFuncSetAttribute failed\n"); grid = -1; return; }
        if (hipOccupancyMaxActiveBlocksPerMultiprocessor(&per_cu, (const void*)hybrid_fwd, NTHR, LDS_BYTES) != hipSuccess || per_cu < 1) { fprintf(stderr, "kernel_launch: occupancy query says %d blocks per CU\n", per_cu); (void)hipGetLastError(); grid = -1; return; }
        grid = cus;
    }
    if (grid < 0) return;
    if (hipMemsetAsync((char*)d_ws + WS_CTL, 0, 65536, stream) != hipSuccess) { fprintf(stderr, "kernel_launch: memset of the barrier words failed\n"); return; }
    Params p{};
    const float** pp = (const float**)&p;
    for (int i = 0; i < 17; ++i) pp[i] = (const float*)d_in[i];
    p.out = (float*)d_out; p.ws = (unsigned char*)d_ws;
#if N_LAUNCH_SPLIT
    for (int ph = 0; ph < 17; ++ph) {
        p.ph_lo = ph; p.ph_hi = ph + 1; void* args[] = {&p};
        hipError_t e = hipLaunchCooperativeKernel((const void*)hybrid_fwd, dim3(grid), dim3(NTHR), args, LDS_BYTES, stream);
        if (e != hipSuccess) { fprintf(stderr, "cooperative launch failed: %s\n", hipGetErrorString(e)); break; }
    }
#else
    p.ph_lo = 0; p.ph_hi = 17; void* args[] = {&p};
    hipError_t e = hipLaunchCooperativeKernel((const void*)hybrid_fwd, dim3(grid), dim3(NTHR), args, LDS_BYTES, stream);
    if (e != hipSuccess) fprintf(stderr, "cooperative launch failed: %s (grid %d)\n", hipGetErrorString(e), grid);
#endif
}
```

```cpp
#include <hip/hip_runtime.h>
#include <hip/hip_cooperative_groups.h>
#include <cstdio>
#include <cstdint>
namespace cg = cooperative_groups;
namespace pg8 {
#define PG8_LAS __attribute__((address_space(3)))
typedef unsigned short bf16_t;
typedef short bf16x8 __attribute__((ext_vector_type(8)));
typedef float f32x4 __attribute__((ext_vector_type(4)));
typedef unsigned u32x4 __attribute__((ext_vector_type(4)));
constexpr int BM = 256, BK = 64, HALF = 128, HTB = HALF * BK * 2  , STAGE_BYTES = 8 * HTB, NXCD = 8, WGM = 8;

__host__ __device__ __forceinline__ int lds_byte(int r, int c) { const int st = (r >> 4) * 2 + (c >> 5), rr = r & 15, cc = c & 31, ob = rr * 64 + cc * 2; return st * 1024 + (ob ^ (((ob >> 9) & 1) << 5)); }
__host__ __device__ __forceinline__ void stage_rc(int b, int& R, int& C) { const int st = b / 1024, sb = b % 1024, swz = sb ^ (((sb >> 9) & 1) << 5); R = (st >> 1) * 16 + swz / 64; C = (st & 1) * 32 + (swz % 64) / 2; }
__host__ __device__ __forceinline__ int perm32(int rho) { const int n = rho >> 4, i = rho & 15; return 8 * (i >> 2) + 4 * n + (i & 3); }

struct Unit { int pm, pn; };
struct Gemm { const bf16_t* A; const bf16_t* Bt; int M, N, K; };

struct StaticOrder {
    int nM, nN, nwg, G, c;
    __host__ __device__ void init(int M, int N, int G_, int c_) { nM = M / BM; nN = N / BM; nwg = nM * nN; G = G_; c = c_; }
    __host__ __device__ bool next(int i, Unit& u) const {
        const long L = (long)i * G + c; if (L >= nwg) return false;
        int wgid = (int)L; { const int q = nwg / NXCD, r = nwg % NXCD, xcd = wgid % NXCD, off = wgid / NXCD; wgid = (xcd < r ? xcd * (q + 1) : r * (q + 1) + (xcd - r) * q) + off; }
        const int nig = WGM * nN, gid = wgid / nig, fm = gid * WGM, gsz = (nM - fm) < WGM ? (nM - fm) : WGM;
        u.pm = fm + ((wgid % nig) % gsz); u.pn = (wgid % nig) / gsz; return true;
    }
    __device__ __forceinline__ void a_ready(const Unit&) const {}
    __device__ __forceinline__ void done(const Unit&) const {}
};
__device__ __forceinline__ unsigned cvt_pk_bf16(float lo, float hi) { unsigned r; asm volatile("v_cvt_pk_bf16_f32 %0, %1, %2" : "=v"(r) : "v"(lo), "v"(hi)); return r; }
typedef float f32x2 __attribute__((ext_vector_type(2)));
template <class Epi, class Sched, bool ALIGN_EPI = false, bool SP2 = false>
__device__ __forceinline__ void gemm_phase(PG8_LAS unsigned char* lds, const Gemm g, const Sched& S, const Epi& E, const int tid_in  ) {
    const int tid = tid_in, wid = __builtin_amdgcn_readfirstlane(tid >> 6), lane = tid & 63, wr = wid >> 2, wc = wid & 3, fr = lane & 15, fq = lane >> 4;
    const int K = g.K, nt = K / BK;
    unsigned voffA[2], voffB[2];
#pragma unroll
    for (int i = 0; i < 2; ++i) { int R, C; stage_rc(tid * 16 + i * 8192, R, C); const int Rb = Epi::PERM ? ((R & ~31) + perm32(R & 31)) : R;
        voffA[i] = (unsigned)(R * K + C) * 2u; voffB[i] = (unsigned)(Rb * K + C) * 2u; }
    const size_t kstep = (size_t)(BK * 2);
    const size_t hstep = (size_t)HALF * K * 2;
    const size_t tstep = 2 * hstep;
    const unsigned ldsw = (unsigned)wid * 1024u;
    const int aoff = lds_byte(wr * 64 + fr, fq * 8), boff = lds_byte(wc * 32 + fr, fq * 8);
#define PG8_SA(b, h) (((b) * 2 + (h)) * HTB)
#define PG8_SB(b, h) ((4 + (b) * 2 + (h)) * HTB)
#define PG8_STAGE(bufoff, gbase, voff) do { _Pragma("unroll") for (int _i = 0; _i < 2; ++_i) \
        __builtin_amdgcn_global_load_lds((const unsigned*)((const char*)(gbase) + (voff)[_i]), (PG8_LAS unsigned*)(lds + (bufoff) + ldsw + _i * 8192), 16, 0, 0); } while (0)
#define PG8_LDA(dst, b, h) do { _Pragma("unroll") for (int m = 0; m < 4; ++m) _Pragma("unroll") for (int k = 0; k < 2; ++k) dst[m][k] = *(const PG8_LAS bf16x8*)(lds + PG8_SA(b, h) + aoff + m * 2048 + k * 1024); } while (0)
#define PG8_LDB(dst, b, h) do { _Pragma("unroll") for (int n = 0; n < 2; ++n) _Pragma("unroll") for (int k = 0; k < 2; ++k) dst[n][k] = *(const PG8_LAS bf16x8*)(lds + PG8_SB(b, h) + boff + n * 2048 + k * 1024); } while (0)
#define PG8_MMA(ai, bj, At, Bt) do { __builtin_amdgcn_s_setprio(1); _Pragma("unroll") for (int m = 0; m < 4; ++m) _Pragma("unroll") for (int n = 0; n < 2; ++n) _Pragma("unroll") for (int k = 0; k < 2; ++k) \
        acc[ai][bj][m][n] = __builtin_amdgcn_mfma_f32_16x16x32_bf16(Bt[n][k], At[m][k], acc[ai][bj][m][n], 0, 0, 0); __builtin_amdgcn_s_setprio(0); } while (0)
#define PG8_WAIT_V(n) asm volatile("s_waitcnt vmcnt(" #n ")" ::: "memory")
#define PG8_WAIT_L(n) asm volatile("s_waitcnt lgkmcnt(" #n ")" ::: "memory")
#define PG8_BAR __builtin_amdgcn_s_barrier()
#define PG8_SCHED __builtin_amdgcn_sched_barrier(0)
    Unit cur, nxt; int ui = 0;
    if (!S.next(0, cur)) return;
    f32x4 acc[2][2][4][2];
#pragma unroll
    for (int a = 0; a < 2; ++a)
#pragma unroll
        for (int b = 0; b < 2; ++b)
#pragma unroll
            for (int m = 0; m < 4; ++m)
#pragma unroll
                for (int n = 0; n < 2; ++n) acc[a][b][m][n] = (f32x4){0.f, 0.f, 0.f, 0.f};
    bf16x8 At[4][2], B0[2][2], B1[2][2];
    const char* cA = (const char*)g.A + (size_t)cur.pm * tstep; const char* cB = (const char*)g.Bt + (size_t)cur.pn * tstep;
    S.a_ready(cur);
    if constexpr (SP2) {
        PG8_STAGE(PG8_SB(0, 0), cB, voffB); PG8_STAGE(PG8_SB(0, 1), cB + hstep, voffB); PG8_STAGE(PG8_SA(0, 0), cA, voffA); PG8_STAGE(PG8_SA(0, 1), cA + hstep, voffA);
        if (wr == 1) PG8_BAR;
        PG8_WAIT_V(2); PG8_BAR;
        PG8_STAGE(PG8_SB(1, 0), cB + kstep, voffB); PG8_STAGE(PG8_SA(1, 0), cA + kstep, voffA); PG8_STAGE(PG8_SB(1, 1), cB + hstep + kstep, voffB);
        PG8_WAIT_V(6); PG8_BAR;
    } else {
        PG8_STAGE(PG8_SB(0, 0), cB, voffB); PG8_STAGE(PG8_SA(0, 0), cA, voffA); PG8_STAGE(PG8_SB(0, 1), cB + hstep, voffB); PG8_STAGE(PG8_SA(0, 1), cA + hstep, voffA);
        if (wr == 1) PG8_BAR;
        PG8_WAIT_V(4); PG8_BAR;
        PG8_STAGE(PG8_SB(1, 0), cB + kstep, voffB); PG8_STAGE(PG8_SA(1, 0), cA + kstep, voffA); PG8_STAGE(PG8_SB(1, 1), cB + hstep + kstep, voffB);
        PG8_WAIT_V(6); PG8_BAR;
    }
    for (;;) {
        const bool has_next = S.next(ui + 1, nxt);
        const char* nA = has_next ? (const char*)g.A + (size_t)nxt.pm * tstep : cA; const char* nB = has_next ? (const char*)g.Bt + (size_t)nxt.pn * tstep : cB;
        for (int t = 0; t < nt; t += 2) {
            const bool last = (t == nt - 2);
            const char* a1 = cA + (size_t)(t + 1) * kstep;
            const char* a2 = last ? nA : cA + (size_t)(t + 2) * kstep; const char* b2 = last ? nB : cB + (size_t)(t + 2) * kstep;
            const char* a3 = a2 + kstep; const char* b3 = b2 + kstep;
            if (last && has_next) S.a_ready(nxt);
            if constexpr (SP2) {
            PG8_LDB(B0, 0, 0); PG8_LDB(B1, 0, 1); PG8_SCHED; PG8_LDA(At, 0, 0); PG8_STAGE(PG8_SA(1, 1), a1 + hstep, voffA);
            PG8_WAIT_V(8); PG8_WAIT_L(0); PG8_BAR; PG8_MMA(0, 0, At, B0); PG8_MMA(0, 1, At, B1); PG8_BAR; PG8_SCHED;
            PG8_LDA(At, 0, 1); PG8_STAGE(PG8_SB(0, 0), b2, voffB); PG8_STAGE(PG8_SB(0, 1), b2 + hstep, voffB); PG8_STAGE(PG8_SA(0, 0), a2, voffA);
            PG8_WAIT_V(8); PG8_WAIT_L(0); PG8_BAR; PG8_MMA(1, 0, At, B0); PG8_MMA(1, 1, At, B1); PG8_BAR; PG8_SCHED;
            PG8_LDB(B0, 1, 0); PG8_LDB(B1, 1, 1); PG8_SCHED; PG8_LDA(At, 1, 0); PG8_STAGE(PG8_SA(0, 1), a2 + hstep, voffA);
            PG8_WAIT_V(8); PG8_WAIT_L(0); PG8_BAR; PG8_MMA(0, 0, At, B0); PG8_MMA(0, 1, At, B1); PG8_BAR; PG8_SCHED;
            PG8_LDA(At, 1, 1); PG8_STAGE(PG8_SB(1, 0), b3, voffB); PG8_STAGE(PG8_SB(1, 1), b3 + hstep, voffB); PG8_STAGE(PG8_SA(1, 0), a3, voffA);
            PG8_WAIT_V(8); PG8_WAIT_L(0); PG8_BAR; PG8_MMA(1, 0, At, B0); PG8_MMA(1, 1, At, B1); PG8_BAR; PG8_SCHED;
            } else {
            PG8_LDB(B0, 0, 0); PG8_SCHED; PG8_LDA(At, 0, 0); PG8_STAGE(PG8_SA(1, 1), a1 + hstep, voffA);
            PG8_WAIT_L(8); PG8_BAR; PG8_WAIT_L(0); PG8_MMA(0, 0, At, B0); PG8_BAR; PG8_SCHED;
            PG8_LDB(B1, 0, 1); PG8_STAGE(PG8_SB(0, 0), b2, voffB);
            PG8_BAR; PG8_WAIT_L(0); PG8_MMA(0, 1, At, B1); PG8_BAR;
            PG8_LDA(At, 0, 1); PG8_STAGE(PG8_SA(0, 0), a2, voffA);
            PG8_BAR; PG8_WAIT_L(0); PG8_MMA(1, 0, At, B0); PG8_BAR; PG8_SCHED;
            PG8_STAGE(PG8_SB(0, 1), b2 + hstep, voffB);
            PG8_WAIT_V(6); PG8_BAR; PG8_MMA(1, 1, At, B1); PG8_BAR;
            PG8_LDB(B0, 1, 0); PG8_SCHED; PG8_LDA(At, 1, 0); PG8_STAGE(PG8_SA(0, 1), a2 + hstep, voffA);
            PG8_WAIT_L(8); PG8_BAR; PG8_WAIT_L(0); PG8_MMA(0, 0, At, B0); PG8_BAR; PG8_SCHED;
            PG8_LDB(B1, 1, 1); PG8_STAGE(PG8_SB(1, 0), b3, voffB);
            PG8_BAR; PG8_WAIT_L(0); PG8_MMA(0, 1, At, B1); PG8_BAR;
            PG8_LDA(At, 1, 1); PG8_STAGE(PG8_SA(1, 0), a3, voffA);
            PG8_BAR; PG8_WAIT_L(0); PG8_MMA(1, 0, At, B0); PG8_BAR; PG8_SCHED;
            PG8_STAGE(PG8_SB(1, 1), b3 + hstep, voffB);
            PG8_WAIT_V(6); PG8_BAR; PG8_MMA(1, 1, At, B1); PG8_BAR;
            }
        }
        if constexpr (ALIGN_EPI) { if (wr == 0) PG8_BAR; }
        if constexpr (!Epi::AFTER_DRAIN) { E(acc, cur, wr, wc, fr, fq); S.done(cur); }
        if (!has_next) break;
#pragma unroll
        for (int a = 0; a < 2; ++a)
#pragma unroll
            for (int b = 0; b < 2; ++b)
#pragma unroll
                for (int m = 0; m < 4; ++m)
#pragma unroll
                    for (int n = 0; n < 2; ++n) acc[a][b][m][n] = (f32x4){0.f, 0.f, 0.f, 0.f};
        cur = nxt; cA = nA; cB = nB; ++ui;
        if constexpr (ALIGN_EPI) { if (wr == 1) PG8_BAR; }
    }
    PG8_WAIT_V(0);
    if constexpr (!ALIGN_EPI) { if (wr == 0) PG8_BAR; }
    PG8_BAR;
    if constexpr (Epi::AFTER_DRAIN) { E.fused(acc, cur, wr, wc, fr, fq, lds, wid, lane); S.done(cur); }
#undef PG8_SA
#undef PG8_SB
#undef PG8_STAGE
#undef PG8_LDA
#undef PG8_LDB
#undef PG8_MMA
#undef PG8_WAIT_V
#undef PG8_WAIT_L
#undef PG8_BAR
#undef PG8_SCHED
}
}

#ifndef MIX_STAGE
#define MIX_STAGE 3
#endif
using pg8::bf16_t; using pg8::bf16x8; using pg8::f32x4; using pg8::u32x4; using pg8::f32x2;
#define LAS __attribute__((address_space(3)))
typedef float f32x16 __attribute__((ext_vector_type(16)));
typedef unsigned u32x2 __attribute__((ext_vector_type(2)));
typedef __bf16 bf16x2_t __attribute__((ext_vector_type(2)));

constexpr int NB = 2, S = 16384, T = NB * S, DM = 1024, NIN = 2816, INW = 2824, FF = 4096;
constexpr int C_MQ = 0, C_MK = 384, C_MV = 768, C_SQ = 1152, C_SK = 1536, C_SV = 1664, C_XQK = 1792, C_XV = 2304, C_XO = 2560;
constexpr float EPS = 1e-6f;
constexpr float LOG2E = 1.4426950408889634f;
constexpr float QSCALE = 0.125f * LOG2E;
constexpr int NTHR = 512;

constexpr size_t MiB = 1ull << 20;
constexpr size_t WS_WIN = 1 * MiB, WIN_L = (size_t)NIN * DM * 2;
constexpr size_t WS_WOUT = 12 * MiB, WOUT_L = (size_t)DM * DM * 2;
constexpr size_t WS_WUP = 16 * MiB, WUP_L = (size_t)FF * DM * 2;
constexpr size_t WS_WDN = 32 * MiB, WDN_L = (size_t)DM * FF * 2;
constexpr size_t WS_WG = 48 * MiB;
constexpr size_t WS_COS = 49 * MiB, WS_SIN = 51 * MiB;
constexpr size_t WS_SSQ = 53 * MiB;
constexpr size_t WS_GATES = 55 * MiB;
constexpr size_t WS_KMH = 56 * MiB, WS_KML = 56 * MiB + 262144;
constexpr size_t WS_SEL = 57 * MiB;
constexpr size_t WS_MISC = 58 * MiB;
constexpr size_t WS_PML = 59 * MiB;
constexpr size_t WS_XB = 64 * MiB;
constexpr size_t OUT_DC = 0;
constexpr size_t OUT_CST = 40 * MiB;
constexpr size_t WS_LQK = 128 * MiB;
constexpr size_t WS_YCAT = 160 * MiB;
constexpr size_t WS_PROJ = 224 * MiB;
constexpr size_t WS_PARTO = 400 * MiB;
constexpr size_t WS_H = 224 * MiB;
constexpr size_t WS_END = 480 * MiB;
static_assert(WS_WIN + 2 * WIN_L <= WS_WOUT && OUT_DC + (size_t)2048 * 4160 * 4 <= OUT_CST && OUT_CST + (size_t)2049 * 4160 * 2 <= (size_t)T * DM * 4, "ws / d_out map");
static_assert(WS_PROJ + (size_t)T * NIN * 2 <= WS_PARTO && WS_PARTO + (size_t)12 * S * 3 * 64 * 2 <= WS_END && WS_H + (size_t)T * FF * 2 <= WS_END, "ws map 2");

constexpr int LDS_BYTES = 147456 + 256, BAR_LDS_OFF = 147456 + 64;
constexpr size_t WS_CTL = 0;

struct Params {
    const float* x; const float* ln1; const float* w_in; const float* conv_w; const float* conv_b; const float* igate_b; const float* fgate_b;
    const float* mlstm_norm; const float* moba_q_norm; const float* moba_k_norm; const float* swa_q_norm; const float* swa_k_norm; const float* swa_sinks;
    const float* w_out; const float* ln2; const float* w_up; const float* w_down;
    float* out; unsigned char* ws; int ph_lo, ph_hi;
};

__device__ __forceinline__ int lane_nocse() { int l; asm volatile("v_mbcnt_lo_u32_b32 %0, -1, 0\n\tv_mbcnt_hi_u32_b32 %0, -1, %0" : "=v"(l)); return l; }
__device__ __forceinline__ float shx(float v, int m, int lane) { return __builtin_bit_cast(float, __builtin_amdgcn_ds_bpermute((lane ^ m) << 2, __builtin_bit_cast(int, v))); }
__device__ __forceinline__ int shx(int v, int m, int lane) { return __builtin_amdgcn_ds_bpermute((lane ^ m) << 2, v); }
__device__ __forceinline__ float shidx(float v, int src) { return __builtin_bit_cast(float, __builtin_amdgcn_ds_bpermute(src << 2, __builtin_bit_cast(int, v))); }
__device__ __forceinline__ float shup(float v, int o, int lane) { return __builtin_bit_cast(float, __builtin_amdgcn_ds_bpermute((lane >= o ? lane - o : lane) << 2, __builtin_bit_cast(int, v))); }

__device__ __forceinline__ float wave_sum(float v, int lane) {
#pragma unroll
    for (int o = 1; o < 64; o <<= 1) v += shx(v, o, lane);
    return v;
}
__device__ __forceinline__ float wave_max(float v, int lane) {
#pragma unroll
    for (int o = 1; o < 64; o <<= 1) v = fmaxf(v, shx(v, o, lane));
    return v;
}
__device__ __forceinline__ unsigned pk2(float lo, float hi) { f32x2 v = {lo, hi}; bf16x2_t b = __builtin_convertvector(v, bf16x2_t); return __builtin_bit_cast(unsigned, b); }
__device__ __forceinline__ float bflo(unsigned w) { return __uint_as_float(w << 16); }
__device__ __forceinline__ float bfhi(unsigned w) { return __uint_as_float(w & 0xffff0000u); }
__device__ __forceinline__ void unpack8(const u32x4 w, float (&v)[8]) {
    v[0] = bflo(w.x); v[1] = bfhi(w.x); v[2] = bflo(w.y); v[3] = bfhi(w.y); v[4] = bflo(w.z); v[5] = bfhi(w.z); v[6] = bflo(w.w); v[7] = bfhi(w.w);
}
__device__ __forceinline__ u32x4 pack8(const float (&v)[8]) { u32x4 w; w.x = pk2(v[0], v[1]); w.y = pk2(v[2], v[3]); w.z = pk2(v[4], v[5]); w.w = pk2(v[6], v[7]); return w; }
#define LDS_WAIT() asm volatile("s_waitcnt lgkmcnt(0)" ::: "memory")
typedef unsigned u32x2s __attribute__((ext_vector_type(2)));
__device__ __forceinline__ float max_x32(float v) { const auto rr = __builtin_amdgcn_permlane32_swap(__float_as_uint(v), __float_as_uint(v), false, false); return fmaxf(__uint_as_float(rr[0]), __uint_as_float(rr[1])); }
__device__ __forceinline__ float sum_x32(float v) { const auto rr = __builtin_amdgcn_permlane32_swap(__float_as_uint(v), __float_as_uint(v), false, false); return __uint_as_float(rr[0]) + __uint_as_float(rr[1]); }
__device__ __forceinline__ float exp2_fast(float v) { return __builtin_amdgcn_exp2f(v); }

template <int ACT  > struct EpiScaled {
    static constexpr bool PERM = true, AFTER_DRAIN = false;
    bf16_t* O; int ldc; const float* ssq;
    __device__ __forceinline__ void operator()(const f32x4 (&acc)[2][2][4][2], const pg8::Unit& u, int wr, int wc, int fr, int fq) const {
        const int row0 = u.pm * pg8::BM + wr * 64 + fr, col0 = u.pn * pg8::BM + wc * 32 + 8 * fq;
        f32x4 sp[2][4];
#pragma unroll
        for (int ai = 0; ai < 2; ++ai)
#pragma unroll
            for (int m = 0; m < 4; ++m) sp[ai][m] = *(const f32x4*)(ssq + (size_t)(row0 + ai * pg8::HALF + m * 16) * 16 + 4 * fq);
#pragma unroll
        for (int ai = 0; ai < 2; ++ai)
#pragma unroll
            for (int m = 0; m < 4; ++m) {
                const int row = row0 + ai * pg8::HALF + m * 16;
                float s_ = (sp[ai][m][0] + sp[ai][m][1]) + (sp[ai][m][2] + sp[ai][m][3]); s_ += shx(s_, 16, fr + 16 * fq); s_ = sum_x32(s_);
                const float rs = rsqrtf(s_ * (1.0f / 1024.0f) + EPS);
                bf16_t* rowp = O + (size_t)row * ldc + col0;
#pragma unroll
                for (int bj = 0; bj < 2; ++bj) {
                    f32x4 v0 = acc[ai][bj][m][0] * rs, v1 = acc[ai][bj][m][1] * rs;
                    if (ACT == 1) {
#pragma unroll
                        for (int i = 0; i < 4; ++i) { const float a = fmaxf(v0[i], 0.f), b = fmaxf(v1[i], 0.f); v0[i] = a * a; v1[i] = b * b; }
                    }
                    u32x4 w; w.x = pk2(v0[0], v0[1]); w.y = pk2(v0[2], v0[3]); w.z = pk2(v1[0], v1[1]); w.w = pk2(v1[2], v1[3]);
                    *(u32x4*)(rowp + bj * pg8::HALF) = w;
                }
            }
    }
};
struct EpiRes {
    static constexpr bool PERM = true, AFTER_DRAIN = false;
    const float* resf; const bf16_t* resb; float* outf; bf16_t* xb; float* ssq;
    __device__ __forceinline__ void operator()(const f32x4 (&acc)[2][2][4][2], const pg8::Unit& u, int wr, int wc, int fr, int fq) const {
        const int row0 = u.pm * pg8::BM + wr * 64 + fr, col0 = u.pn * pg8::BM + wc * 32 + 8 * fq;
#pragma unroll
        for (int ai = 0; ai < 2; ++ai) {
            f32x4 rv[4][2][2];
            if (resf) {
#pragma unroll
                for (int m = 0; m < 4; ++m)
#pragma unroll
                    for (int bj = 0; bj < 2; ++bj) { const size_t o_ = (size_t)(row0 + ai * pg8::HALF + m * 16) * DM + col0 + bj * pg8::HALF; rv[m][bj][0] = *(const f32x4*)(resf + o_); rv[m][bj][1] = *(const f32x4*)(resf + o_ + 4); }
            } else {
                u32x4 rb[4][2];
#pragma unroll
                for (int m = 0; m < 4; ++m)
#pragma unroll
                    for (int bj = 0; bj < 2; ++bj) rb[m][bj] = *(const u32x4*)(resb + (size_t)(row0 + ai * pg8::HALF + m * 16) * DM + col0 + bj * pg8::HALF);
#pragma unroll
                for (int m = 0; m < 4; ++m)
#pragma unroll
                    for (int bj = 0; bj < 2; ++bj) { const u32x4 w = rb[m][bj]; rv[m][bj][0] = (f32x4){bflo(w.x), bfhi(w.x), bflo(w.y), bfhi(w.y)}; rv[m][bj][1] = (f32x4){bflo(w.z), bfhi(w.z), bflo(w.w), bfhi(w.w)}; }
            }
#pragma unroll
            for (int m = 0; m < 4; ++m) {
                const int row = row0 + ai * pg8::HALF + m * 16;
                const size_t off = (size_t)row * DM + col0;
                float part = 0.f;
#pragma unroll
                for (int bj = 0; bj < 2; ++bj) {
                    const f32x4 v0 = acc[ai][bj][m][0] + rv[m][bj][0], v1 = acc[ai][bj][m][1] + rv[m][bj][1];
                    if (outf) { *(f32x4*)(outf + off + bj * pg8::HALF) = v0; *(f32x4*)(outf + off + bj * pg8::HALF + 4) = v1; }
                    if (xb) { u32x4 w; w.x = pk2(v0[0], v0[1]); w.y = pk2(v0[2], v0[3]); w.z = pk2(v1[0], v1[1]); w.w = pk2(v1[2], v1[3]); *(u32x4*)(xb + off + bj * pg8::HALF) = w; }
                    part += (v0[0] * v0[0] + v0[1] * v0[1]) + (v0[2] * v0[2] + v0[3] * v0[3]) + (v1[0] * v1[0] + v1[1] * v1[1]) + (v1[2] * v1[2] + v1[3] * v1[3]);
                }
                part += shx(part, 16, fr + 16 * fq); part = sum_x32(part);
                if (ssq && fq == 0) ssq[(size_t)row * 16 + u.pn * 4 + wc] = part;
            }
        }
    }
};
template <class Epi> __device__ __forceinline__ void run_gemm(LAS unsigned char* lds, const bf16_t* A, const bf16_t* Bt, int M, int N, int K, const Epi& E, int bid, int tid) {
    pg8::Gemm g{A, Bt, M, N, K}; pg8::StaticOrder so; so.init(M, N, (int)gridDim.x, bid);
    pg8::gemm_phase<Epi, pg8::StaticOrder, true, true>(lds, g, so, E, tid);
}

__device__ __forceinline__ void transpose_item(const float* W, int K, int ld, int nblk, const float* scale, bf16_t* WT, LAS float* scr, int item, int lane) {
    const int kb = item / nblk, nb = item % nblk, k0 = 64 * kb, n0 = 32 * nb;
    float tv[32];
#pragma unroll
    for (int i = 0; i < 32; ++i) { const int kk = 2 * i + (lane >> 5); tv[i] = W[(size_t)(k0 + kk) * ld + n0 + (lane & 31)]; }
    if (scale) {
#pragma unroll
        for (int i = 0; i < 32; ++i) tv[i] *= scale[k0 + 2 * i + (lane >> 5)];
    }
#pragma unroll
    for (int i = 0; i < 32; ++i) scr[(2 * i + (lane >> 5)) * 33 + (lane & 31)] = tv[i];
    LDS_WAIT();
    const int c = lane & 7;
#pragma unroll
    for (int j = 0; j < 4; ++j) {
        const int n = (lane >> 3) + 8 * j; const LAS float* s = scr + (8 * c) * 33 + n;
        u32x4 o; o.x = pk2(s[0 * 33], s[1 * 33]); o.y = pk2(s[2 * 33], s[3 * 33]); o.z = pk2(s[4 * 33], s[5 * 33]); o.w = pk2(s[6 * 33], s[7 * 33]);
        *(u32x4*)(WT + (size_t)(n0 + n) * K + k0 + 8 * c) = o;
    }
    LDS_WAIT();
}
__device__ __forceinline__ void rope_entry(int pos, int i, float& cs, float& sn) {
    const double R = 0.74989420933245582730;
    double inv = 1.0; { double b = R; int e = i; while (e) { if (e & 1) inv *= b; b *= b; e >>= 1; } }
    const double ang = (double)pos * inv;
    const double n = __builtin_rint(ang * 0.63661977236758134308);
    double y = __builtin_fma(-n, 1.57079632679489655800, ang); y = __builtin_fma(-n, 6.12323399573676603587e-17, y);
    const double y2 = y * y;
    double sp = -1.0 / 1307674368000.0; sp = sp * y2 + 1.0 / 6227020800.0; sp = sp * y2 - 1.0 / 39916800.0; sp = sp * y2 + 1.0 / 362880.0; sp = sp * y2 - 1.0 / 5040.0;
    sp = sp * y2 + 1.0 / 120.0; sp = sp * y2 - 1.0 / 6.0; sp = sp * y2 + 1.0; const double sy = sp * y;
    double cp = 1.0 / 20922789888000.0; cp = cp * y2 - 1.0 / 87178291200.0; cp = cp * y2 + 1.0 / 479001600.0; cp = cp * y2 - 1.0 / 3628800.0; cp = cp * y2 + 1.0 / 40320.0;
    cp = cp * y2 - 1.0 / 720.0; cp = cp * y2 + 1.0 / 24.0; cp = cp * y2 - 0.5; const double cy = cp * y2 + 1.0;
    const int q = (int)((long long)n & 3);
    const double s_ = (q == 0) ? sy : (q == 1) ? cy : (q == 2) ? -sy : -cy;
    const double c_ = (q == 0) ? cy : (q == 1) ? -sy : (q == 2) ? -cy : sy;
    cs = (float)c_; sn = (float)s_;
}
__device__ __forceinline__ void prologue(const Params& p, LAS unsigned char* lds, int tid, int wave, int lane) {
    unsigned char* ws = p.ws;
    const int G = (int)gridDim.x, gw = (int)blockIdx.x * 8 + wave, NGW = G * 8;
    LAS float* scr = (LAS float*)(lds + wave * 8704);
    for (int it = gw; it < 16 * 88; it += NGW) transpose_item(p.w_in, DM, INW, 88, p.ln1, (bf16_t*)(ws + WS_WIN), scr, it, lane);
    constexpr int I_IN = 16 * 88, I_OUT = 16 * 32, I_UP = 16 * 128, I_DN = 64 * 32, I_L = I_IN + I_OUT + I_UP + I_DN;
    for (int it = gw; it < 0; it += NGW) {
        const int l = it / I_L; int r = it % I_L;
        if (r < I_IN) { transpose_item(p.w_in + (size_t)l * DM * INW, DM, INW, 88, p.ln1 + l * DM, (bf16_t*)(ws + WS_WIN + l * WIN_L), scr, r, lane); continue; } r -= I_IN;
        if (r < I_OUT) { transpose_item(p.w_out + (size_t)l * DM * DM, DM, DM, 32, nullptr, (bf16_t*)(ws + WS_WOUT + l * WOUT_L), scr, r, lane); continue; } r -= I_OUT;
        if (r < I_UP) { transpose_item(p.w_up + (size_t)l * DM * FF, DM, FF, 128, p.ln2 + l * DM, (bf16_t*)(ws + WS_WUP + l * WUP_L), scr, r, lane); continue; } r -= I_UP;
        transpose_item(p.w_down + (size_t)l * FF * DM, FF, DM, 32, nullptr, (bf16_t*)(ws + WS_WDN + l * WDN_L), scr, r, lane);
    }
    { float* WG = (float*)(ws + WS_WG);
      bf16_t* WGH = (bf16_t*)(ws + WS_WG + 131072); bf16_t* WGL = (bf16_t*)(ws + WS_WG + 196608);
      for (int e = (int)blockIdx.x * NTHR + tid; e < 2 * 8 * DM; e += G * NTHR) { const int l = e >> 13, c = (e >> 10) & 7, k = e & 1023; const float wv_ = p.ln1[l * DM + k] * p.w_in[((size_t)l * DM + k) * INW + NIN + c];
          WG[e] = wv_; const unsigned hb = pk2(wv_, 0.f) & 0xffffu; WGH[e] = (bf16_t)hb; WGL[e] = (bf16_t)(pk2(wv_ - bflo(hb), 0.f) & 0xffffu); } }
    if (blockIdx.x == 0 && tid < 4) {
        const int l = tid >> 1, ty = tid & 1; const float* gq = (ty ? p.swa_q_norm : p.moba_q_norm) + l * 64; const float* gk = (ty ? p.swa_k_norm : p.moba_k_norm) + l * 64;
        float mq = 0.f, mk = 0.f; for (int d = 0; d < 64; ++d) { mq = fmaxf(mq, fabsf(gq[d])); mk = fmaxf(mk, fabsf(gk[d])); }
        ((float*)(ws + WS_MISC))[6144 + tid] = fminf(QSCALE * 64.f * mq * mk * 1.01f, 60.f);
    }
    { float* COS = (float*)(ws + WS_COS); float* SIN = (float*)(ws + WS_SIN);
      for (int e = (int)blockIdx.x * NTHR + tid; e < S * 32; e += G * NTHR) { float c, s; rope_entry(e >> 5, e & 31, c, s); COS[e] = c; SIN[e] = s; } }
    { bf16_t* XB = (bf16_t*)(ws + WS_XB); float* SSQ = (float*)(ws + WS_SSQ);
      for (int m0 = gw * 4; m0 < T; m0 += NGW * 4) {
          f32x4 v[4][4];
#pragma unroll
          for (int rr = 0; rr < 4; ++rr) { const f32x4* xr = (const f32x4*)(p.x + (size_t)(m0 + rr) * DM) + lane;
#pragma unroll
              for (int j = 0; j < 4; ++j) v[rr][j] = xr[64 * j]; }
#pragma unroll
          for (int rr = 0; rr < 4; ++rr) {
              float s = 0.f;
#pragma unroll
              for (int j = 0; j < 4; ++j) s += (v[rr][j][0] * v[rr][j][0] + v[rr][j][1] * v[rr][j][1]) + (v[rr][j][2] * v[rr][j][2] + v[rr][j][3] * v[rr][j][3]);
              s = wave_sum(s, lane);
              u32x2* o8 = (u32x2*)(XB + (size_t)(m0 + rr) * DM) + lane;
#pragma unroll
              for (int j = 0; j < 4; ++j) { u32x2 w; w.x = pk2(v[rr][j][0], v[rr][j][1]); w.y = pk2(v[rr][j][2], v[rr][j][3]); o8[64 * j] = w; }
              if (lane < 16) SSQ[(size_t)(m0 + rr) * 16 + lane] = (lane == 0) ? s : 0.f;
          }
      } }
}

__device__ __forceinline__ void convert_deferred_weights(const Params& p, LAS unsigned char* lds, int first, int stride, int wave, int lane) {
    unsigned char* ws = p.ws;
    LAS float* scr = (LAS float*)(lds + wave * 8704);
    constexpr int I_IN = 16 * 88, I_OUT = 16 * 32, I_UP = 16 * 128, I_DN = 64 * 32, I_L0 = I_OUT + I_UP + I_DN, I_ALL = I_L0 + I_IN + I_OUT + I_UP + I_DN;
    for (int it = first; it < I_ALL; it += stride) {
        int r = it, l = 0;
        if (r >= I_L0) { r -= I_L0; l = 1;
            if (r < I_IN) { transpose_item(p.w_in + (size_t)DM * INW, DM, INW, 88, p.ln1 + DM, (bf16_t*)(ws + WS_WIN + WIN_L), scr, r, lane); continue; } r -= I_IN; }
        if (r < I_OUT) { transpose_item(p.w_out + (size_t)l * DM * DM, DM, DM, 32, nullptr, (bf16_t*)(ws + WS_WOUT + l * WOUT_L), scr, r, lane); continue; } r -= I_OUT;
        if (r < I_UP) { transpose_item(p.w_up + (size_t)l * DM * FF, DM, FF, 128, p.ln2 + l * DM, (bf16_t*)(ws + WS_WUP + l * WUP_L), scr, r, lane); continue; } r -= I_UP;
        transpose_item(p.w_down + (size_t)l * FF * DM, FF, DM, 32, nullptr, (bf16_t*)(ws + WS_WDN + l * WDN_L), scr, r, lane);
    }
}

__device__ __forceinline__ void gates_unit(const Params& p, int layer, int blk, int wave, int lane) {
    const int r32 = lane & 31, hi = lane >> 5; const size_t row = (size_t)blk * 256 + 32 * wave + r32;
    const bf16_t* XB = (const bf16_t*)(p.ws + WS_XB) + row * DM;
    const bf16_t* WGH = (const bf16_t*)(p.ws + WS_WG + 131072) + (size_t)layer * 8 * DM + (size_t)(r32 & 7) * DM;
    const bf16_t* WGL = (const bf16_t*)(p.ws + WS_WG + 196608) + (size_t)layer * 8 * DM + (size_t)(r32 & 7) * DM;
    const bool wrow = r32 < 8;
    f32x16 acc;
#pragma unroll
    for (int r = 0; r < 16; ++r) acc[r] = 0.f;
#pragma unroll 1
    for (int k0 = 0; k0 < 64; k0 += 4) {
        bf16x8 xb[4], ah[4], al[4];
#pragma unroll
        for (int ks = 0; ks < 4; ++ks) {
            xb[ks] = *(const bf16x8*)(XB + 16 * (k0 + ks) + 8 * hi);
            const bf16x8 z = {0, 0, 0, 0, 0, 0, 0, 0};
            ah[ks] = wrow ? *(const bf16x8*)(WGH + 16 * (k0 + ks) + 8 * hi) : z; al[ks] = wrow ? *(const bf16x8*)(WGL + 16 * (k0 + ks) + 8 * hi) : z;
        }
#pragma unroll
        for (int ks = 0; ks < 4; ++ks) { acc = __builtin_amdgcn_mfma_f32_32x32x16_bf16(ah[ks], xb[ks], acc, 0, 0, 0); acc = __builtin_amdgcn_mfma_f32_32x32x16_bf16(al[ks], xb[ks], acc, 0, 0, 0); }
    }
    const float* SSQ = (const float*)(p.ws + WS_SSQ) + row * 16;
    float sp = 0.f;
#pragma unroll
    for (int q4 = 0; q4 < 4; ++q4) { const f32x4 t4 = *(const f32x4*)(SSQ + 4 * q4); sp += (t4[0] + t4[1]) + (t4[2] + t4[3]); }
    const float rs = rsqrtf(sp * (1.0f / 1024.0f) + EPS);
    const float* bp = (hi == 0) ? (p.igate_b + layer * 4) : (p.fgate_b + layer * 4);
    f32x4 o; o[0] = acc[0] * rs + bp[0]; o[1] = acc[1] * rs + bp[1]; o[2] = acc[2] * rs + bp[2]; o[3] = acc[3] * rs + bp[3];
    *(f32x4*)((float*)(p.ws + WS_GATES) + row * 8 + 4 * hi) = o;
}

__device__ __forceinline__ void prep_unit(const Params& p, int layer, int u, LAS unsigned char* lds, int tid, int wave, int lane) {
    unsigned char* ws = p.ws;
    const int blk = u / 22, j22 = u % 22, job = j22 < 12 ? j22 : j22 + 6;
    const int row0 = blk * 256, b = blk >> 6, pos0 = (blk & 63) * 256;
    bf16_t* PROJ = (bf16_t*)(ws + WS_PROJ);
    const int c = lane & 7, tl = lane >> 3;
    if (job < 20) {
        int col; const float* gw; float scale; bool iskm = false; int kh = 0;
        if (job < 6) { col = C_MQ + 64 * job; gw = p.moba_q_norm + layer * 64; scale = QSCALE; }
        else if (job < 12) { kh = job - 6; col = C_MK + 64 * kh; gw = p.moba_k_norm + layer * 64; scale = 1.f; iskm = true; }
        else if (job < 18) { col = C_SQ + 64 * (job - 12); gw = p.swa_q_norm + layer * 64; scale = QSCALE; }
        else { col = C_SK + 64 * (job - 18); gw = p.swa_k_norm + layer * 64; scale = 1.f; }
        float gv[8]; { const f32x4 g0 = *(const f32x4*)(gw + 8 * c), g1 = *(const f32x4*)(gw + 8 * c + 4); gv[0] = g0[0]; gv[1] = g0[1]; gv[2] = g0[2]; gv[3] = g0[3]; gv[4] = g1[0]; gv[5] = g1[1]; gv[6] = g1[2]; gv[7] = g1[3]; }
        float ks[8];
#pragma unroll
        for (int e = 0; e < 8; ++e) ks[e] = 0.f;
        const float* COS = (const float*)(ws + WS_COS); const float* SIN = (const float*)(ws + WS_SIN);
        u32x4 win[4]; f32x4 cc0[4], cc1[4], sc0[4], sc1[4];
#pragma unroll
        for (int it = 0; it < 4; ++it) {
            const int tt = 32 * wave + 8 * it + tl, pos = pos0 + tt;
            win[it] = *(const u32x4*)(PROJ + (size_t)(row0 + tt) * NIN + col + 8 * c);
            cc0[it] = *(const f32x4*)(COS + (size_t)pos * 32 + 8 * (c & 3)); cc1[it] = *(const f32x4*)(COS + (size_t)pos * 32 + 8 * (c & 3) + 4);
            sc0[it] = *(const f32x4*)(SIN + (size_t)pos * 32 + 8 * (c & 3)); sc1[it] = *(const f32x4*)(SIN + (size_t)pos * 32 + 8 * (c & 3) + 4);
        }
#pragma unroll
        for (int it = 0; it < 4; ++it) {
            const int tt = 32 * wave + 8 * it + tl;
            bf16_t* ptr = PROJ + (size_t)(row0 + tt) * NIN + col + 8 * c;
            const u32x4 w = win[it]; float v[8]; unpack8(w, v);
            float ss = 0.f;
#pragma unroll
            for (int e = 0; e < 8; ++e) ss += v[e] * v[e];
            ss += shx(ss, 1, lane); ss += shx(ss, 2, lane); ss += shx(ss, 4, lane);
            const float rs = rsqrtf(ss * (1.0f / 64.0f) + EPS);
            const f32x4 c0 = cc0[it], c1 = cc1[it], s0 = sc0[it], s1 = sc1[it];
            float o[8];
#pragma unroll
            for (int e = 0; e < 8; ++e) {
                const float val = v[e] * rs * gv[e]; const float pr = shx(val, 4, lane);
                const float cs = (e < 4) ? c0[e & 3] : c1[e & 3], sn = (e < 4) ? s0[e & 3] : s1[e & 3];
                o[e] = (c < 4) ? (val * cs - pr * sn) : (val * cs + pr * sn);
                ks[e] += o[e];
                o[e] *= scale;
            }
            *(u32x4*)ptr = pack8(o);
        }
        if (iskm) {
#pragma unroll
            for (int e = 0; e < 8; ++e) { ks[e] += shx(ks[e], 8, lane); ks[e] += shx(ks[e], 16, lane); ks[e] = sum_x32(ks[e]); }
            LAS float* red = (LAS float*)lds;
            if (tl == 0) {
#pragma unroll
                for (int e = 0; e < 8; ++e) red[wave * 64 + 8 * c + e] = ks[e];
            }
            __syncthreads();
            if (tid < 64) {
                float s = 0.f;
#pragma unroll
                for (int w8 = 0; w8 < 8; ++w8) s += red[w8 * 64 + tid];
                const float mean = s * (1.0f / 256.0f); const unsigned hb = pk2(mean, 0.f) & 0xffffu; const unsigned lb = pk2(mean - bflo(hb), 0.f) & 0xffffu;
                const size_t ki = ((size_t)((b * 6 + kh) * 64 + (blk & 63))) * 64 + tid;
                ((bf16_t*)(ws + WS_KMH))[ki] = (bf16_t)hb; ((bf16_t*)(ws + WS_KML))[ki] = (bf16_t)lb;
            }
            __syncthreads();
        }
    } else if (job < 28) {
        const int cj = job - 20, col = C_XQK + 64 * cj; const float osc = (cj >= 4) ? 0.125f : 1.f;
        bf16_t* LQK = (bf16_t*)(ws + WS_LQK);
        float cw[4][8], cb[8];
#pragma unroll
        for (int jj = 0; jj < 4; ++jj) { const float* wp = p.conv_w + ((size_t)layer * 4 + jj) * 512 + 64 * cj + 8 * c; const f32x4 a = *(const f32x4*)wp, bq = *(const f32x4*)(wp + 4);
            cw[jj][0] = a[0]; cw[jj][1] = a[1]; cw[jj][2] = a[2]; cw[jj][3] = a[3]; cw[jj][4] = bq[0]; cw[jj][5] = bq[1]; cw[jj][6] = bq[2]; cw[jj][7] = bq[3]; }
        { const float* bp = p.conv_b + (size_t)layer * 512 + 64 * cj + 8 * c; const f32x4 a = *(const f32x4*)bp, bq = *(const f32x4*)(bp + 4);
          cb[0] = a[0]; cb[1] = a[1]; cb[2] = a[2]; cb[3] = a[3]; cb[4] = bq[0]; cb[5] = bq[1]; cb[6] = bq[2]; cb[7] = bq[3]; }
        u32x4 xin[4][4];
#pragma unroll
        for (int it = 0; it < 4; ++it) {
            const int tt = 32 * wave + 8 * it + tl, pos = pos0 + tt; const size_t row = (size_t)row0 + tt;
#pragma unroll
            for (int jj = 0; jj < 4; ++jj) { const u32x4 z = {0u, 0u, 0u, 0u}; xin[it][jj] = (pos - 3 + jj >= 0) ? *(const u32x4*)(PROJ + (row - 3 + jj) * NIN + col + 8 * c) : z; }
        }
#pragma unroll
        for (int it = 0; it < 4; ++it) {
            const int tt = 32 * wave + 8 * it + tl; const size_t row = (size_t)row0 + tt;
            float acc[8];
#pragma unroll
            for (int e = 0; e < 8; ++e) acc[e] = cb[e];
#pragma unroll
            for (int jj = 0; jj < 4; ++jj) {
                float v[8]; unpack8(xin[it][jj], v);
#pragma unroll
                for (int e = 0; e < 8; ++e) acc[e] += cw[jj][e] * v[e];
            }
            float o[8];
#pragma unroll
            for (int e = 0; e < 8; ++e) { const float y = acc[e]; o[e] = y / (1.f + __expf(-y)) * osc; }
            *(u32x4*)(LQK + row * 512 + 64 * cj + 8 * c) = pack8(o);
        }
    }
}

#define RLX_AGENT __ATOMIC_RELAXED, __HIP_MEMORY_SCOPE_AGENT
#define XB_TMO      128
#define XB_XCNT(j)  (256  + 64 * (j))
#define XB_XSUB(j)  (1280 + 64 * (j))
#define XB_XGEN(j)  (2304 + 64 * (j))
#define XB_TOP      3328
#define XB_TOPGEN   3392
#define XCD_BAR_WORDS 3456
#define XB_SPIN_CAP (1u << 18)

__device__ __forceinline__ unsigned xb_ld(unsigned* p)              { return __hip_atomic_load(p, __ATOMIC_RELAXED, __HIP_MEMORY_SCOPE_AGENT); }
__device__ __forceinline__ unsigned xb_add(unsigned* p, unsigned v) { return __hip_atomic_fetch_add(p, v, __ATOMIC_RELAXED, __HIP_MEMORY_SCOPE_AGENT); }
__device__ __forceinline__ unsigned xb_xcc_id() { return (unsigned)__builtin_amdgcn_s_getreg((3 << 11) | 20) & 0xFu; }
#define XB_SPIN(cond, bar) do { unsigned _sp = 0; while (cond) { __builtin_amdgcn_s_sleep(1); \
    if ((++_sp & 255u) == 0u) { if (xb_ld(&(bar)[XB_TMO])) break; if (_sp > XB_SPIN_CAP) { atomicAdd(&(bar)[XB_TMO], 1u); break; } } } } while (0)

struct XcdBarrier {
    bool t0; unsigned* bar; unsigned x;
    volatile LAS unsigned* st;
};

struct XcdBarrier; __device__ __forceinline__ bool xb_is_t0(const XcdBarrier& b);
__device__ __forceinline__ XcdBarrier xcd_barrier_post(unsigned* bar, volatile LAS unsigned* st, bool t0  ) {
    XcdBarrier b; b.bar = bar; b.x = xb_xcc_id(); b.st = st;
    b.t0 = t0; if (xb_is_t0(b)) (void)xb_add(&bar[XB_XCNT(b.x)], 1u);
    return b;
}
__device__ __forceinline__ void xcd_barrier_complete(unsigned* bar, unsigned x, unsigned& nloc, unsigned& nx) {
    const unsigned G = gridDim.x * gridDim.y * gridDim.z;
    unsigned sum, cnt, mine, sp = 0u;
    for (;;) {
        sum = 0u; cnt = 0u; mine = 0u;
#pragma unroll
        for (unsigned j = 0; j < 16; ++j) { const unsigned c = xb_ld(&bar[XB_XCNT(j)]); sum += c; cnt += (c > 0u) ? 1u : 0u; }
        if (sum == G) break;
        __builtin_amdgcn_s_sleep(1);
        if ((++sp & 255u) == 0u) { if (xb_ld(&bar[XB_TMO])) break; if (sp > XB_SPIN_CAP) { atomicAdd(&bar[XB_TMO], 1u); break; } }
    }
    mine = xb_ld(&bar[XB_XCNT(x)]);
    nloc = mine > 0u ? mine : 1u; nx = cnt > 0u ? cnt : 1u;
}

__device__ __forceinline__ bool xb_is_t0(const XcdBarrier& b) { int l_; asm volatile("v_mbcnt_lo_u32_b32 %0, -1, 0\n\tv_mbcnt_hi_u32_b32 %0, -1, %0" : "=v"(l_)); return b.t0 && l_ == 0; }
__device__ __forceinline__ void xcd_barrier(const XcdBarrier& b) {
    asm volatile("s_waitcnt vmcnt(0)" ::: "memory");
    __syncthreads();
    if (xb_is_t0(b)) {
        unsigned* bar = b.bar;
        __builtin_amdgcn_s_waitcnt(0);
        unsigned nloc = b.st[0], nx = b.st[1];
        if (nloc == 0u) { xcd_barrier_complete(bar, b.x, nloc, nx); b.st[0] = nloc; b.st[1] = nx; }
        const unsigned old = xb_add(&bar[XB_XSUB(b.x)], 1u);
        const unsigned gen = old / nloc;
        if (old + 1u == (gen + 1u) * nloc) {
            __builtin_amdgcn_fence(__ATOMIC_RELEASE, "agent");
            asm volatile("s_waitcnt vmcnt(0)" ::: "memory");
            const unsigned og = xb_add(&bar[XB_TOP], 1u);
            const unsigned tg = og / nx;
            if (og + 1u == (tg + 1u) * nx) xb_add(&bar[XB_TOPGEN], 1u);
            else XB_SPIN(xb_ld(&bar[XB_TOPGEN]) == tg, bar);
            __builtin_amdgcn_fence(__ATOMIC_ACQUIRE, "agent");
            xb_add(&bar[XB_XGEN(b.x)], 1u);
            asm volatile("s_waitcnt vmcnt(0)" ::: "memory");
        } else {
            XB_SPIN(xb_ld(&bar[XB_XGEN(b.x)]) == gen, bar);
            __builtin_amdgcn_fence(__ATOMIC_ACQUIRE, "agent");
            asm volatile("s_waitcnt vmcnt(0)" ::: "memory");
        }
    }
    __syncthreads();
}
#ifndef REPEAT_MASK
#define REPEAT_MASK 0
#endif

constexpr int KP = 72, VP = 260;
constexpr int AT_KS = 0, AT_VT = 256 * KP * 2, AT_LIST = AT_VT + 64 * VP * 2, AT_CNT = AT_LIST + 32768;
__device__ __forceinline__ void stage_kv256(LAS unsigned char* lds, const bf16_t* kb, const bf16_t* vb, long row0, long rowmin, int tid) {
#pragma unroll
    for (int i = 0; i < 4; ++i) {
        const int chunk = i * NTHR + tid, row = chunk >> 3, c8 = chunk & 7;
        long gr = row0 + row; gr = gr < rowmin ? rowmin : gr;
        const u32x4 kv = *(const u32x4*)(kb + gr * NIN + 8 * c8);
        const u32x4 vv = *(const u32x4*)(vb + gr * NIN + 8 * c8);
        *(LAS u32x4*)(lds + AT_KS + (row * KP + 8 * c8) * 2) = kv;
        LAS bf16_t* vt = (LAS bf16_t*)(lds + AT_VT) + (8 * c8) * VP + row;
        vt[0 * VP] = (bf16_t)(vv.x & 0xffffu); vt[1 * VP] = (bf16_t)(vv.x >> 16); vt[2 * VP] = (bf16_t)(vv.y & 0xffffu); vt[3 * VP] = (bf16_t)(vv.y >> 16);
        vt[4 * VP] = (bf16_t)(vv.z & 0xffffu); vt[5 * VP] = (bf16_t)(vv.z >> 16); vt[6 * VP] = (bf16_t)(vv.w & 0xffffu); vt[7 * VP] = (bf16_t)(vv.w >> 16);
    }
}
struct KVRegs { u32x4 k[4], v[4]; };
__device__ __forceinline__ void kv_load(KVRegs& r, const bf16_t* kb, const bf16_t* vb, long row0, long rowmin, int tid) {
#pragma unroll
    for (int i = 0; i < 4; ++i) {
        const int chunk = i * NTHR + tid, row = chunk >> 3, c8 = chunk & 7;
        long gr = row0 + row; gr = gr < rowmin ? rowmin : gr;
        r.k[i] = *(const u32x4*)(kb + gr * NIN + 8 * c8); r.v[i] = *(const u32x4*)(vb + gr * NIN + 8 * c8);
    }
}
__device__ __forceinline__ void kv_store(LAS unsigned char* lds, const KVRegs& r, int tid) {
#pragma unroll
    for (int i = 0; i < 4; ++i) {
        const int chunk = i * NTHR + tid, row = chunk >> 3, c8 = chunk & 7;
        *(LAS u32x4*)(lds + AT_KS + (row * KP + 8 * c8) * 2) = r.k[i];
        LAS bf16_t* vt = (LAS bf16_t*)(lds + AT_VT) + (8 * c8) * VP + row; const u32x4 vv = r.v[i];
        vt[0 * VP] = (bf16_t)(vv.x & 0xffffu); vt[1 * VP] = (bf16_t)(vv.x >> 16); vt[2 * VP] = (bf16_t)(vv.y & 0xffffu); vt[3 * VP] = (bf16_t)(vv.y >> 16);
        vt[4 * VP] = (bf16_t)(vv.z & 0xffffu); vt[5 * VP] = (bf16_t)(vv.z >> 16); vt[6 * VP] = (bf16_t)(vv.w & 0xffffu); vt[7 * VP] = (bf16_t)(vv.w >> 16);
    }
}
__device__ __forceinline__ void attn_iter(const LAS unsigned char* kbase, const LAS unsigned char* vbase, const bf16x8 (&qf)[4], const bf16x8 (&kc)[4], bf16x8 (&kn)[4], int kt, int ktn, bool masked, int klo, unsigned kspan,
                                          const f32x16& negMv, f32x16 (&o)[2], float& l) {
    u32x2 vfl[2][2], vfh[2][2];
#pragma unroll
    for (int j = 0; j < 2; ++j)
#pragma unroll
        for (int dt = 0; dt < 2; ++dt) { const LAS unsigned char* vp = vbase + (32 * dt * VP + 32 * kt + 16 * j) * 2; vfl[j][dt] = *(const LAS u32x2*)vp; vfh[j][dt] = *(const LAS u32x2*)(vp + 16); }
#pragma unroll
    for (int d0 = 0; d0 < 4; ++d0) kn[d0] = *(const LAS bf16x8*)(kbase + (32 * ktn * KP + 16 * d0) * 2);
    f32x16 s = __builtin_amdgcn_mfma_f32_32x32x16_bf16(kc[0], qf[0], negMv, 0, 0, 0);
#pragma unroll
    for (int d0 = 1; d0 < 4; ++d0) s = __builtin_amdgcn_mfma_f32_32x32x16_bf16(kc[d0], qf[d0], s, 0, 0, 0);
    if (masked) {
#pragma unroll
        for (int r = 0; r < 16; ++r) { const int kv = 32 * kt + (r & 3) + 8 * (r >> 2); s[r] = ((unsigned)(kv - klo) <= kspan) ? s[r] : -INFINITY; }
    }
    float sum = 0.f;
#pragma unroll
    for (int r = 0; r < 16; ++r) { const float pv = exp2_fast(s[r]); s[r] = pv; sum += pv; }
    l += sum;
#pragma unroll
    for (int j = 0; j < 2; ++j) {
        u32x4 pw; pw.x = pk2(s[8 * j + 0], s[8 * j + 1]); pw.y = pk2(s[8 * j + 2], s[8 * j + 3]); pw.z = pk2(s[8 * j + 4], s[8 * j + 5]); pw.w = pk2(s[8 * j + 6], s[8 * j + 7]);
        const bf16x8 pb = __builtin_bit_cast(bf16x8, pw);
#pragma unroll
        for (int dt = 0; dt < 2; ++dt) {
            u32x4 vw; vw.x = vfl[j][dt].x; vw.y = vfl[j][dt].y; vw.z = vfh[j][dt].x; vw.w = vfh[j][dt].y;
            o[dt] = __builtin_amdgcn_mfma_f32_32x32x16_bf16(__builtin_bit_cast(bf16x8, vw), pb, o[dt], 0, 0, 0);
        }
    }
}
__device__ __forceinline__ void attn_tile(const LAS unsigned char* lds, const bf16x8 (&qf)[4], int kmin, int kmax, int kt_lo, int kt_hi, int mlo_kt, int mhi_kt, float negM, int r32, int hi, f32x16 (&o)[2], float& lrow) {
    const LAS unsigned char* kbase = lds + AT_KS + (r32 * KP + 8 * hi) * 2;
    const LAS unsigned char* vbase = lds + AT_VT + (r32 * VP + 4 * hi) * 2;
    const int klo = kmin - 4 * hi; const unsigned kspan = (unsigned)(kmax - kmin);
    f32x16 negMv;
#pragma unroll
    for (int r = 0; r < 16; ++r) negMv[r] = negM;
#pragma unroll
    for (int dt = 0; dt < 2; ++dt)
#pragma unroll
        for (int r = 0; r < 16; ++r) o[dt][r] = 0.f;
    float l = 0.f;
    bf16x8 ka[4], kb[4];
#pragma unroll
    for (int d0 = 0; d0 < 4; ++d0) ka[d0] = *(const LAS bf16x8*)(kbase + (32 * kt_lo * KP + 16 * d0) * 2);
#pragma unroll 1
    for (int kt = kt_lo; kt <= kt_hi; kt += 2) {
        attn_iter(kbase, vbase, qf, ka, kb, kt, (kt < kt_hi) ? kt + 1 : kt, (kt <= mlo_kt || kt >= mhi_kt), klo, kspan, negMv, o, l);
        if (kt + 1 > kt_hi) break;
        attn_iter(kbase, vbase, qf, kb, ka, kt + 1, (kt + 1 < kt_hi) ? kt + 2 : kt + 1, (kt + 1 <= mlo_kt || kt + 1 >= mhi_kt), klo, kspan, negMv, o, l);
    }
    lrow = sum_x32(l);
}
__device__ __forceinline__ float softmax_ref(const Params& p, int layer, int type  ) { return ((const float*)(p.ws + WS_MISC))[6144 + layer * 2 + type]; }
__device__ __forceinline__ void store_orow_bf16(bf16_t* dst, const f32x16 (&o)[2], float sc, int hi) {
#pragma unroll
    for (int dt = 0; dt < 2; ++dt)
#pragma unroll
        for (int g = 0; g < 4; ++g) { u32x2 w; w.x = pk2(o[dt][4 * g] * sc, o[dt][4 * g + 1] * sc); w.y = pk2(o[dt][4 * g + 2] * sc, o[dt][4 * g + 3] * sc); *(u32x2*)(dst + 32 * dt + 8 * g + 4 * hi) = w; }
}
__device__ __forceinline__ void load_qf(bf16x8 (&qf)[4], const bf16_t* qrow, int hi) {
#pragma unroll
    for (int d0 = 0; d0 < 4; ++d0) qf[d0] = *(const bf16x8*)(qrow + 16 * d0 + 8 * hi);
}

__device__ __forceinline__ void qnorm_rope(bf16x8 (&qf)[4], int pos, const float* gq, const float* COS, const float* SIN, int hi) {
    float v[4][8];
#pragma unroll
    for (int d0 = 0; d0 < 4; ++d0) unpack8(__builtin_bit_cast(u32x4, qf[d0]), v[d0]);
    float ss = 0.f;
#pragma unroll
    for (int d0 = 0; d0 < 4; ++d0)
#pragma unroll
        for (int e = 0; e < 8; ++e) ss += v[d0][e] * v[d0][e];
    const float rs = rsqrtf(sum_x32(ss) * (1.0f / 64.0f) + EPS);
#pragma unroll
    for (int d0 = 0; d0 < 4; ++d0) { const f32x4 g0 = *(const f32x4*)(gq + 16 * d0 + 8 * hi), g1 = *(const f32x4*)(gq + 16 * d0 + 8 * hi + 4);
#pragma unroll
        for (int e = 0; e < 8; ++e) v[d0][e] *= rs * ((e < 4) ? g0[e & 3] : g1[e & 3]); }
#pragma unroll
    for (int d0 = 0; d0 < 2; ++d0) {
        const f32x4 c0 = *(const f32x4*)(COS + (size_t)pos * 32 + 16 * d0 + 8 * hi), c1 = *(const f32x4*)(COS + (size_t)pos * 32 + 16 * d0 + 8 * hi + 4);
        const f32x4 s0 = *(const f32x4*)(SIN + (size_t)pos * 32 + 16 * d0 + 8 * hi), s1 = *(const f32x4*)(SIN + (size_t)pos * 32 + 16 * d0 + 8 * hi + 4);
#pragma unroll
        for (int e = 0; e < 8; ++e) {
            const float cs = (e < 4) ? c0[e & 3] : c1[e & 3], sn = (e < 4) ? s0[e & 3] : s1[e & 3];
            const float x1 = v[d0][e], x2 = v[d0 + 2][e];
            v[d0][e] = (x1 * cs - x2 * sn) * QSCALE; v[d0 + 2][e] = (x2 * cs + x1 * sn) * QSCALE;
        }
    }
#pragma unroll
    for (int d0 = 0; d0 < 4; ++d0) qf[d0] = __builtin_bit_cast(bf16x8, pack8(v[d0]));
}
__device__ __forceinline__ void swa_loop(const Params& p, int layer, int first, int end, LAS unsigned char* lds, int tid, int wave, int lane) {
    const bf16_t* PROJ = (const bf16_t*)(p.ws + WS_PROJ); bf16_t* YC = (bf16_t*)(p.ws + WS_YCAT);
    const int r32 = lane & 31, hi = lane >> 5; const float negM = -softmax_ref(p, layer, 1);
    int u = first; bool have = u < end;
    while (have) {
        const int kh = (u >> 7) & 1, n = u & 127, b = u >> 8; const long rowb = (long)b * S;
        __syncthreads();
        { KVRegs kv; kv_load(kv, PROJ + C_SK + 64 * kh, PROJ + C_SV + 64 * kh, rowb + 128 * (n - 1), rowb, tid); kv_store(lds, kv, tid); }
        bf16x8 qfa[4], qfb[4];
        { const int qh = 3 * kh + (wave >> 2), rt = wave & 3; load_qf(qfa, PROJ + (rowb + 128 * n + 32 * rt + r32) * NIN + C_SQ + 64 * qh, hi); }
        { const int tl = (wave < 4) ? wave + 8 : wave; const int qh = 3 * kh + (tl >> 2), rt = tl & 3; load_qf(qfb, PROJ + (rowb + 128 * n + 32 * rt + r32) * NIN + C_SQ + 64 * qh, hi); }
        { const float* gq = p.swa_q_norm + layer * 64; const float* COS = (const float*)(p.ws + WS_COS); const float* SIN = (const float*)(p.ws + WS_SIN);
          qnorm_rope(qfa, 128 * n + 32 * (wave & 3) + r32, gq, COS, SIN, hi);
          asm volatile("" : "+v"(qfa[0]), "+v"(qfa[1]), "+v"(qfa[2]), "+v"(qfa[3]) :: "memory");
          qnorm_rope(qfb, 128 * n + 32 * (wave & 3) + r32, gq, COS, SIN, hi);
          asm volatile("" : "+v"(qfb[0]), "+v"(qfb[1]), "+v"(qfb[2]), "+v"(qfb[3]) :: "memory"); }
        __syncthreads();
        const int un = u + 1; const bool hn = un < end;
#pragma unroll
        for (int rep = 0; rep < 2; ++rep) {
            const int tl = wave + 8 * rep;
            if (tl < 12) {
                const int qh = 3 * kh + (tl >> 2), rt = tl & 3, qi = 32 * rt + r32; const long row = rowb + 128 * n + qi;
                int kmin = qi + 1; if (n == 0 && kmin < 128) kmin = 128;
                const int ktl = (n == 0 && rt < 4) ? 4 : rt;
                f32x16 o[2]; float l;
                if (rep == 0) attn_tile(lds, qfa, kmin, qi + 128, ktl, rt + 4, ktl, rt + 4, negM, r32, hi, o, l);
                else attn_tile(lds, qfb, kmin, qi + 128, ktl, rt + 4, ktl, rt + 4, negM, r32, hi, o, l);
                l += exp2_fast(p.swa_sinks[layer * 6 + qh] * LOG2E + negM);
                store_orow_bf16(YC + row * DM + 640 + 64 * qh, o, 1.0f / l, hi);
            }
        }
        u = un; have = hn;
    }
    __syncthreads();
}

#define TOP3_INSERT(g, ju) do { if ((g) > v0) { v2 = v1; i2 = i1; v1 = v0; i1 = i0; v0 = (g); i0 = (ju); } else if ((g) > v1) { v2 = v1; i2 = i1; v1 = (g); i1 = (ju); } else if ((g) > v2) { v2 = (g); i2 = (ju); } } while (0)
__device__ __forceinline__ void sel_wave_unit(const Params& p, int wu, int qt, int lane) {
    const int bh = wu >> 8, i = wu & 255, b = bh / 6, h = bh % 6, t0 = i * 64, blk = t0 >> 8;
    unsigned* SEL = (unsigned*)(p.ws + WS_SEL) + (size_t)bh * S + t0;
    if (blk == 0) { if (lane < 32) SEL[32 * qt + lane] = 0xFFFFFFu; return; }
    const int r32 = lane & 31, hi = lane >> 5;
    const bf16_t* KH = (const bf16_t*)(p.ws + WS_KMH) + (size_t)bh * 4096; const bf16_t* KL = (const bf16_t*)(p.ws + WS_KML) + (size_t)bh * 4096;
    const bf16_t* PROJ = (const bf16_t*)(p.ws + WS_PROJ);
    const int njt = (blk > 32) ? 2 : 1;
    {
        bf16x8 qf[4]; load_qf(qf, PROJ + ((size_t)b * S + t0 + 32 * qt + r32) * NIN + C_MQ + 64 * h, hi);
        float v0 = -INFINITY, v1 = -INFINITY, v2 = -INFINITY; unsigned i0 = 255u, i1 = 255u, i2 = 255u;
#pragma unroll 1
        for (int jt = 0; jt < njt; ++jt) {
            f32x16 acc;
#pragma unroll
            for (int r = 0; r < 16; ++r) acc[r] = 0.f;
#pragma unroll
            for (int d0 = 0; d0 < 4; ++d0) {
                const bf16x8 ah = *(const bf16x8*)(KH + (32 * jt + r32) * 64 + 16 * d0 + 8 * hi), al = *(const bf16x8*)(KL + (32 * jt + r32) * 64 + 16 * d0 + 8 * hi);
                acc = __builtin_amdgcn_mfma_f32_32x32x16_bf16(ah, qf[d0], acc, 0, 0, 0);
                acc = __builtin_amdgcn_mfma_f32_32x32x16_bf16(al, qf[d0], acc, 0, 0, 0);
            }
#pragma unroll
            for (int r = 0; r < 16; ++r) { const int j = 32 * jt + (r & 3) + 8 * (r >> 2) + 4 * hi; const float g = (j < blk) ? acc[r] : -INFINITY; const unsigned ju = (unsigned)j; TOP3_INSERT(g, ju); }
        }
        const float p0 = shx(v0, 32, lane), p1 = shx(v1, 32, lane), p2 = shx(v2, 32, lane);
        const unsigned q0 = (unsigned)shx((int)i0, 32, lane), q1 = (unsigned)shx((int)i1, 32, lane), q2 = (unsigned)shx((int)i2, 32, lane);
        TOP3_INSERT(p0, q0); TOP3_INSERT(p1, q1); TOP3_INSERT(p2, q2);
        if (hi == 0) SEL[32 * qt + r32] = i0 | (i1 << 8) | (i2 << 16);
    }
}
constexpr int MOBA_TAB_W = 4;
__constant__ unsigned short moba_tab[256][MOBA_TAB_W] = {
    {693,65535,65535,65535},{630,65535,65535,65535},{567,65535,65535,65535},{504,65535,65535,65535},{441,65535,65535,65535},{378,65535,65535,65535},{315,65535,65535,65535},{252,65535,65535,65535},
    {189,65535,65535,65535},{126,65535,65535,65535},{63,65535,65535,65535},{0,65535,65535,65535},{694,65535,65535,65535},{631,65535,65535,65535},{568,65535,65535,65535},{505,65535,65535,65535},
    {442,65535,65535,65535},{379,65535,65535,65535},{316,65535,65535,65535},{253,65535,65535,65535},{190,65535,65535,65535},{127,65535,65535,65535},{64,65535,65535,65535},{1,65535,65535,65535},
    {695,748,65535,65535},{632,685,65535,65535},{569,622,65535,65535},{506,559,65535,65535},{443,496,65535,65535},{380,433,65535,65535},{317,370,65535,65535},{254,307,65535,65535},
    {191,244,65535,65535},{128,181,65535,65535},{65,118,65535,65535},{2,55,65535,65535},{696,237,754,65535},{633,174,691,65535},{570,111,628,65535},{507,48,565,65535},
    {444,742,501,65535},{381,679,438,65535},{318,616,375,65535},{255,553,312,65535},{192,490,249,65535},{129,427,186,65535},{66,364,123,65535},{3,301,60,65535},
    {697,480,251,65535},{634,417,188,65535},{571,354,125,65535},{508,291,62,65535},{445,228,65535,65535},{382,165,65535,65535},{319,102,65535,65535},{256,39,65535,65535},
    {193,733,250,65535},{130,670,187,65535},{67,607,124,65535},{4,544,61,65535},{698,479,755,65535},{635,416,692,65535},{572,353,629,65535},{509,290,566,65535},
    {446,227,503,65535},{383,164,440,65535},{320,101,377,65535},{257,38,314,65535},{194,732,502,65535},{131,669,439,65535},{68,606,376,65535},{5,543,313,65535},
    {699,224,746,65535},{636,161,683,65535},{573,98,620,65535},{510,35,557,65535},{447,729,491,65535},{384,666,428,65535},{321,603,365,65535},{258,540,302,65535},
    {195,477,239,65535},{132,414,176,65535},{69,351,113,65535},{6,288,50,65535},{700,223,494,65535},{637,160,431,65535},{574,97,368,65535},{511,34,305,65535},
    {448,728,238,65535},{385,665,175,65535},{322,602,112,65535},{259,539,49,65535},{196,476,743,65535},{133,413,680,65535},{70,350,617,65535},{7,287,554,65535},
    {701,222,242,65535},{638,159,179,65535},{575,96,116,65535},{512,33,53,65535},{449,727,744,65535},{386,664,681,65535},{323,601,618,65535},{260,538,555,65535},
    {197,475,492,65535},{134,412,429,65535},{71,349,366,65535},{8,286,303,65535},{702,221,747,65535},{639,158,684,65535},{576,95,621,65535},{513,32,558,65535},
    {450,726,481,65535},{387,663,418,65535},{324,600,355,65535},{261,537,292,65535},{198,474,229,65535},{135,411,166,65535},{72,348,103,65535},{9,285,40,65535},
    {703,220,495,65535},{640,157,432,65535},{577,94,369,65535},{514,31,306,65535},{451,725,240,65535},{388,662,177,65535},{325,599,114,65535},{262,536,51,65535},
    {199,473,745,65535},{136,410,682,65535},{73,347,619,65535},{10,284,556,65535},{704,219,243,65535},{641,156,180,65535},{578,93,117,65535},{515,30,54,65535},
    {452,724,493,65535},{389,661,430,65535},{326,598,367,65535},{263,535,304,65535},{200,472,241,65535},{137,409,178,65535},{74,346,115,65535},{11,283,52,65535},
    {705,218,739,246},{642,155,676,183},{579,92,613,120},{516,29,550,57},{453,723,734,65535},{390,660,671,65535},{327,597,608,65535},{264,534,545,65535},
    {201,471,482,65535},{138,408,419,65535},{75,345,356,65535},{12,282,293,65535},{706,217,487,751},{643,154,424,688},{580,91,361,625},{517,28,298,562},
    {454,722,230,65535},{391,659,167,65535},{328,596,104,65535},{265,533,41,65535},{202,470,735,65535},{139,407,672,65535},{76,344,609,65535},{13,281,546,65535},
    {707,216,235,499},{644,153,172,436},{581,90,109,373},{518,27,46,310},{455,721,483,65535},{392,658,420,65535},{329,595,357,65535},{266,532,294,65535},
    {203,469,231,65535},{140,406,168,65535},{77,343,105,65535},{14,280,42,65535},{708,215,740,245},{645,152,677,182},{582,89,614,119},{519,26,551,56},
    {456,720,736,65535},{393,657,673,65535},{330,594,610,65535},{267,531,547,65535},{204,468,484,65535},{141,405,421,65535},{78,342,358,65535},{15,279,295,65535},
    {709,214,488,750},{646,151,425,687},{583,88,362,624},{520,25,299,561},{457,719,232,65535},{394,656,169,65535},{331,593,106,65535},{268,530,43,65535},
    {205,467,737,65535},{142,404,674,65535},{79,341,611,65535},{16,278,548,65535},{710,213,731,247},{647,150,668,184},{584,87,605,121},{521,24,542,58},
    {458,718,225,753},{395,655,162,690},{332,592,99,627},{269,529,36,564},{206,466,730,752},{143,403,667,689},{80,340,604,626},{17,277,541,563},
    {711,212,236,498},{648,149,173,435},{585,86,110,372},{522,23,47,309},{459,717,478,500},{396,654,415,437},{333,591,352,374},{270,528,289,311},
    {207,465,226,248},{144,402,163,185},{81,339,100,122},{18,276,37,59},{712,211,741,749},{649,148,678,686},{586,85,615,623},{523,22,552,560},
    {460,716,485,65535},{397,653,422,65535},{334,590,359,65535},{271,527,296,65535},{208,464,233,65535},{145,401,170,65535},{82,338,107,65535},{19,275,44,65535},
    {713,210,489,497},{650,147,426,434},{587,84,363,371},{524,21,300,308},{461,715,738,65535},{398,652,675,65535},{335,589,612,65535},{272,526,549,65535},
    {209,463,486,65535},{146,400,423,65535},{83,337,360,65535},{20,274,297,65535},{714,462,234,65535},{651,399,171,65535},{588,336,108,65535},{525,273,45,65535},
};
__device__ __forceinline__ void moba_sel_loop(const Params& p, int layer, int bid, LAS unsigned char* lds, int tid, int wave, int lane) {
    const float negM = -softmax_ref(p, layer, 0);
    const bf16_t* PROJ = (const bf16_t*)(p.ws + WS_PROJ);
    float* PML = (float*)(p.ws + WS_PML); bf16_t* PO = (bf16_t*)(p.ws + WS_PARTO);
    LAS unsigned short* list = (LAS unsigned short*)(lds + AT_LIST); LAS unsigned* cnt = (LAS unsigned*)(lds + AT_CNT);
    const int r32 = lane & 31, hi = lane >> 5;
#pragma unroll 1
    for (int trow = bid; trow < 256; trow += (int)gridDim.x)
#pragma unroll 1
    for (int k = 0; k < MOBA_TAB_W; ++k) {
        const int code = (int)moba_tab[trow][k];
        if (code == 0xFFFF) break;
        const int bh = code / 63, j = code - bh * 63, b = bh / 6, h = bh - b * 6, tstart = 256 * (j + 1);
        __syncthreads();
        if (tid == 0) *cnt = 0u;
        { KVRegs kv; kv_load(kv, PROJ + C_MK + 64 * h, PROJ + C_MV + 64 * h, (long)b * S + 256 * j, 0, tid); kv_store(lds, kv, tid); }
        __syncthreads();
        const unsigned* SEL = (const unsigned*)(p.ws + WS_SEL) + (size_t)bh * S;
        for (int t0 = tstart; t0 < S; t0 += 8 * NTHR) {
            unsigned selv[8];
#pragma unroll
            for (int i = 0; i < 8; ++i) { const int t = t0 + i * NTHR + tid; selv[i] = (t < S) ? SEL[t] : 0xFFFFFFu; }
#pragma unroll
            for (int i = 0; i < 8; ++i) {
                const unsigned sel = selv[i]; int rk = -1;
                if ((sel & 0xffu) == (unsigned)j) rk = 0; else if (((sel >> 8) & 0xffu) == (unsigned)j) rk = 1; else if (((sel >> 16) & 0xffu) == (unsigned)j) rk = 2;
                if (rk >= 0) { const unsigned pos = __hip_atomic_fetch_add(cnt, 1u, __ATOMIC_RELAXED, __HIP_MEMORY_SCOPE_WORKGROUP); list[pos] = (unsigned short)((unsigned)(t0 - tstart + i * NTHR + tid) | ((unsigned)rk << 14)); }
            }
        }
        __syncthreads();
        const int n = (int)*cnt;
        const int ntl = (n + 31) >> 5;
        bf16x8 qf[4]; unsigned e = 0u; bool valid = false;
        if (wave < ntl) { const int idx = 32 * wave + r32; valid = idx < n; e = list[valid ? idx : 0]; load_qf(qf, PROJ + ((long)b * S + tstart + (int)(e & 0x3fffu)) * NIN + C_MQ + 64 * h, hi); }
        for (int tl = wave; tl < ntl; tl += 8) {
            bf16x8 qn[4]; unsigned en = 0u; bool vn = false;
            if (tl + 8 < ntl) { const int idx = 32 * (tl + 8) + r32; vn = idx < n; en = list[vn ? idx : 0]; load_qf(qn, PROJ + ((long)b * S + tstart + (int)(en & 0x3fffu)) * NIN + C_MQ + 64 * h, hi); }
            else {
#pragma unroll
                for (int d0 = 0; d0 < 4; ++d0) qn[d0] = qf[d0];
            }
            const int t = tstart + (int)(e & 0x3fffu), rk = (int)(e >> 14);
            f32x16 o[2]; float l; attn_tile(lds, qf, 0, 255, 0, 7, -1, 8, negM, r32, hi, o, l);
            if (valid) {
                const size_t base = ((size_t)bh * S + t) * 3 + rk;
                if (hi == 0) { PML[base * 2] = 0.f; PML[base * 2 + 1] = l; }
                store_orow_bf16(PO + base * 64, o, 1.0f, hi);
            }
#pragma unroll
            for (int d0 = 0; d0 < 4; ++d0) qf[d0] = qn[d0];
            e = en; valid = vn;
        }
    }
    __syncthreads();
}
__device__ __forceinline__ void moba_own_loop(const Params& p, int layer, int first, int stride, LAS unsigned char* lds, int tid, int wave, int lane) {
    const float negM = -softmax_ref(p, layer, 0);
    const bf16_t* PROJ = (const bf16_t*)(p.ws + WS_PROJ); bf16_t* YC = (bf16_t*)(p.ws + WS_YCAT);
    const float* PML = (const float*)(p.ws + WS_PML); const bf16_t* PO = (const bf16_t*)(p.ws + WS_PARTO);
    const int r32 = lane & 31, hi = lane >> 5, qi = 32 * wave + r32;
    int u = first; bool have = u < 768;
    while (have) {
        const int bh = u % 12, blk = u / 12, b = bh / 6, h = bh % 6, t = 256 * blk + qi; const long row = (long)b * S + t;
        __syncthreads();
        { KVRegs kv; kv_load(kv, PROJ + C_MK + 64 * h, PROJ + C_MV + 64 * h, (long)b * S + 256 * blk, 0, tid); kv_store(lds, kv, tid); }
        bf16x8 qf[4]; load_qf(qf, PROJ + row * NIN + C_MQ + 64 * h, hi);
        const int nv = blk < 3 ? blk : 3;
        const size_t base = ((size_t)bh * S + t) * 3;
        float lr[3]; u32x2 pov[3][2][4];
#pragma unroll
        for (int r = 0; r < 3; ++r) {
            lr[r] = 0.f;
#pragma unroll
            for (int dt = 0; dt < 2; ++dt)
#pragma unroll
                for (int g = 0; g < 4; ++g) { pov[r][dt][g].x = 0u; pov[r][dt][g].y = 0u; }
            if (r < nv) {
                lr[r] = PML[(base + r) * 2 + 1];
                const bf16_t* src = PO + (base + r) * 64;
#pragma unroll
                for (int dt = 0; dt < 2; ++dt)
#pragma unroll
                    for (int g = 0; g < 4; ++g) pov[r][dt][g] = *(const u32x2*)(src + 32 * dt + 8 * g + 4 * hi);
            }
        }
        __syncthreads();
        const int un = u + stride; const bool hn = un < 768;
        f32x16 o[2]; float l; attn_tile(lds, qf, 0, qi, 0, wave, -1, wave, negM, r32, hi, o, l);
        float L = l;
#pragma unroll
        for (int r = 0; r < 3; ++r) {
            L += lr[r];
#pragma unroll
            for (int dt = 0; dt < 2; ++dt)
#pragma unroll
                for (int g = 0; g < 4; ++g) { const u32x2 wv = pov[r][dt][g];
                    o[dt][4 * g] += bflo(wv.x); o[dt][4 * g + 1] += bfhi(wv.x); o[dt][4 * g + 2] += bflo(wv.y); o[dt][4 * g + 3] += bfhi(wv.y); }
        }
        store_orow_bf16(YC + row * DM + 64 * h, o, 1.0f / L, hi);
        u = un; have = hn;
    }
    __syncthreads();
}

__device__ __forceinline__ float log_sigmoid(float f) { return fminf(f, 0.f) - log1pf(__expf(-fabsf(f))); }
__device__ __forceinline__ float wave_incl_scan(float v, int lane) {
#pragma unroll
    for (int o = 1; o < 64; o <<= 1) { const float t = shup(v, o, lane); if (lane >= o) v += t; }
    return v;
}
constexpr int MP = 72;
constexpr int MW_KT = 0, MW_VT = 64 * MP * 2, MW_SUB = 2 * 64 * MP * 2;
__device__ __forceinline__ void m1_wave_unit(const Params& p, int unit, LAS unsigned char* L, int lane) {
    const int bh = unit >> 8, c = unit & 255, b = bh >> 2, h = bh & 3;
    const long row0 = (long)b * S + 64 * c;
    const float* GT = (const float*)(p.ws + WS_GATES);
    const bf16_t* LQK = (const bf16_t*)(p.ws + WS_LQK); const bf16_t* PROJ = (const bf16_t*)(p.ws + WS_PROJ);
    const float ig = GT[(row0 + lane) * 8 + h], fg = GT[(row0 + lane) * 8 + 4 + h];
    u32x4 kq[8], vq[8];
#pragma unroll
    for (int i = 0; i < 8; ++i) { const int s = 8 * i + (lane >> 3), c8 = lane & 7;
        kq[i] = *(const u32x4*)(LQK + (row0 + s) * 512 + 256 + 64 * h + 8 * c8); vq[i] = *(const u32x4*)(PROJ + (row0 + s) * NIN + C_XV + 64 * h + 8 * c8); }
    const float bs = wave_incl_scan(log_sigmoid(fg), lane);
    const float a = shidx(bs, 63), g = a - bs + ig, mg = wave_max(g, lane), wl = __expf(g - mg);
    if (lane == 0) { float* MISC = (float*)(p.ws + WS_MISC); MISC[unit] = a; MISC[2048 + unit] = mg; }
#pragma unroll
    for (int i = 0; i < 8; ++i) {
        const int s = 8 * i + (lane >> 3), c8 = lane & 7;
        const float ws_ = shidx(wl, s);
        float kf[8]; unpack8(kq[i], kf);
        LAS bf16_t* kt = (LAS bf16_t*)(L + MW_KT) + (8 * c8) * MP + s;
#pragma unroll
        for (int e = 0; e < 8; e += 2) { const unsigned pw = pk2(kf[e] * ws_, kf[e + 1] * ws_); kt[e * MP] = (bf16_t)(pw & 0xffffu); kt[(e + 1) * MP] = (bf16_t)(pw >> 16); }
        LAS bf16_t* vt = (LAS bf16_t*)(L + MW_VT) + (8 * c8) * MP + s; const u32x4 vw = vq[i];
        vt[0 * MP] = (bf16_t)(vw.x & 0xffffu); vt[1 * MP] = (bf16_t)(vw.x >> 16); vt[2 * MP] = (bf16_t)(vw.y & 0xffffu); vt[3 * MP] = (bf16_t)(vw.y >> 16);
        vt[4 * MP] = (bf16_t)(vw.z & 0xffffu); vt[5 * MP] = (bf16_t)(vw.z >> 16); vt[6 * MP] = (bf16_t)(vw.w & 0xffffu); vt[7 * MP] = (bf16_t)(vw.w >> 16);
    }
    LDS_WAIT();
    const int r32 = lane & 31, hi = lane >> 5;
    float* DC = (float*)((unsigned char*)p.out + OUT_DC) + (size_t)unit * 4160;
    { float dn = 0.f;
#pragma unroll
      for (int q8 = 0; q8 < 8; ++q8) { const u32x4 w = *(const LAS u32x4*)(L + MW_KT + (lane * MP + 8 * q8) * 2); float v[8]; unpack8(w, v);
#pragma unroll
          for (int e = 0; e < 8; ++e) dn += v[e]; }
      DC[64 * 64 + lane] = dn; }
#pragma unroll 1
    for (int wp = 0; wp < 2; ++wp) {
        f32x16 acc[2];
#pragma unroll
        for (int et = 0; et < 2; ++et)
#pragma unroll
            for (int r = 0; r < 16; ++r) acc[et][r] = 0.f;
#pragma unroll
        for (int ks = 0; ks < 4; ++ks) {
            const bf16x8 bfr = *(const LAS bf16x8*)(L + MW_KT + ((32 * wp + r32) * MP + 16 * ks + 8 * hi) * 2);
#pragma unroll
            for (int et = 0; et < 2; ++et) {
                const bf16x8 afr = *(const LAS bf16x8*)(L + MW_VT + ((32 * et + r32) * MP + 16 * ks + 8 * hi) * 2);
                acc[et] = __builtin_amdgcn_mfma_f32_32x32x16_bf16(afr, bfr, acc[et], 0, 0, 0);
            }
        }
        const int d = 32 * wp + r32;
#pragma unroll
        for (int et = 0; et < 2; ++et)
#pragma unroll
            for (int r = 0; r < 16; ++r) { const int e = 32 * et + (r & 3) + 8 * (r >> 2) + 4 * hi; DC[e * 64 + d] = acc[et][r]; }
    }
    LDS_WAIT();
}
__device__ __forceinline__ void scan_unit(const Params& p, int su, LAS unsigned char* lds, int tid) {
    const int e0 = su * NTHR, bh0 = e0 / 4160;
    const float* MISC = (const float*)(p.ws + WS_MISC); float* MS = (float*)(p.ws + WS_MISC) + 4096;
    const float* __restrict__ DC = (const float*)((const unsigned char*)p.out + OUT_DC); bf16_t* __restrict__ CST = (bf16_t*)((unsigned char*)p.out + OUT_CST);
    LAS float* la = (LAS float*)lds; LAS float* lmg = la + 512; LAS float* ldec = la + 1024; LAS float* lsc = la + 1536;
    { const int which = tid >> 8, c = tid & 255, bh = bh0 + which;
      la[tid] = (bh < 8) ? MISC[bh * 256 + c] : 0.f; lmg[tid] = (bh < 8) ? MISC[2048 + bh * 256 + c] : 0.f; }
    __syncthreads();
    LAS float* lm = la + 2048;
    if (tid < 2) {
        float m = 0.f;
#pragma unroll 1
        for (int c0 = 0; c0 < 256; c0 += 32) {
            float av[32], gv[32], mv[32];
#pragma unroll
            for (int k = 0; k < 32; ++k) { av[k] = la[tid * 256 + c0 + k]; gv[k] = lmg[tid * 256 + c0 + k]; }
#pragma unroll
            for (int k = 0; k < 32; ++k) { mv[k] = m; m = fmaxf(av[k] + m, gv[k]); }
#pragma unroll
            for (int k = 0; k < 32; ++k) lm[tid * 257 + c0 + k] = mv[k];
        }
        lm[tid * 257 + 256] = m;
    }
    __syncthreads();
    { const int which = tid >> 8, c = tid & 255, bh = bh0 + which;
      const float m0 = lm[which * 257 + c], m1 = lm[which * 257 + c + 1];
      ldec[tid] = __expf(la[tid] + m0 - m1); lsc[tid] = __expf(lmg[tid] - m1);
      if ((bh < 8) && (bh * 4160 >= e0) && (bh * 4160 < e0 + NTHR)) MS[bh * 256 + c] = m0; }
    __syncthreads();
    const int e = e0 + tid, bh = e / 4160, idx = e - bh * 4160, which = bh - bh0;
    const float* __restrict__ dcp = DC + (size_t)bh * 256 * 4160 + idx; bf16_t* __restrict__ csp = CST + (size_t)bh * 256 * 4160 + idx;
    float C = 0.f;
#pragma unroll 1
    for (int c0 = 0; c0 < 256; c0 += 32) {
        float dcv[32];
#pragma unroll
        for (int k = 0; k < 32; ++k) dcv[k] = dcp[(size_t)(c0 + k) * 4160];
#pragma unroll
        for (int k = 0; k < 32; ++k) {
            csp[(size_t)(c0 + k) * 4160] = (bf16_t)(pk2(C, 0.f) & 0xffffu);
            C = ldec[which * 256 + c0 + k] * C + lsc[which * 256 + c0 + k] * dcv[k];
        }
    }
    __syncthreads();
}
constexpr int M3_VT = 0, M3_CS = 64 * MP * 2, M3_BS = M3_CS + 256, M3_SUB = M3_BS + 256;
__device__ __forceinline__ void m3_wave_unit(const Params& p, int layer, int unit, LAS unsigned char* L, int lane) {
    const int bh = unit >> 8, c = unit & 255, b = bh >> 2, h = bh & 3;
    const long row0 = (long)b * S + 64 * c;
    LAS float* cs = (LAS float*)(L + M3_CS); LAS float* bsv = (LAS float*)(L + M3_BS);
    const float* GT = (const float*)(p.ws + WS_GATES);
    const bf16_t* LQK = (const bf16_t*)(p.ws + WS_LQK); const bf16_t* PROJ = (const bf16_t*)(p.ws + WS_PROJ);
    const int r32 = lane & 31, hi = lane >> 5;
    const float ig = GT[(row0 + lane) * 8 + h], fg = GT[(row0 + lane) * 8 + 4 + h];
    u32x4 vq[8];
#pragma unroll
    for (int i = 0; i < 8; ++i) { const int s = 8 * i + (lane >> 3), c8 = lane & 7; vq[i] = *(const u32x4*)(PROJ + (row0 + s) * NIN + C_XV + 64 * h + 8 * c8); }
    const bf16_t* CST = (const bf16_t*)((const unsigned char*)p.out + OUT_CST) + (size_t)unit * 4160;
    const float m_c = ((const float*)(p.ws + WS_MISC))[4096 + unit];
    { const float bs = wave_incl_scan(log_sigmoid(fg), lane); cs[lane] = ig - bs; bsv[lane] = bs; }
#pragma unroll
    for (int i = 0; i < 8; ++i) {
        const int s = 8 * i + (lane >> 3), c8 = lane & 7;
        LAS bf16_t* vt = (LAS bf16_t*)(L + M3_VT) + (8 * c8) * MP + s; const u32x4 vw = vq[i];
        vt[0 * MP] = (bf16_t)(vw.x & 0xffffu); vt[1 * MP] = (bf16_t)(vw.x >> 16); vt[2 * MP] = (bf16_t)(vw.y & 0xffffu); vt[3 * MP] = (bf16_t)(vw.y >> 16);
        vt[4 * MP] = (bf16_t)(vw.z & 0xffffu); vt[5 * MP] = (bf16_t)(vw.z >> 16); vt[6 * MP] = (bf16_t)(vw.w & 0xffffu); vt[7 * MP] = (bf16_t)(vw.w >> 16);
    }
    LDS_WAIT();
    const float* nw = p.mlstm_norm + (size_t)layer * 256 + 64 * h;
#pragma unroll 1
    for (int wp = 0; wp < 2; ++wp) {
        const int t = 32 * wp + r32; const long row = row0 + t;
        bf16x8 qf[4]; load_qf(qf, LQK + row * 512 + 64 * h, hi);
        bf16x8 kfr[2][4];
#pragma unroll
        for (int st = 0; st < 2; ++st)
#pragma unroll
            for (int d0 = 0; d0 < 4; ++d0) kfr[st][d0] = *(const bf16x8*)(LQK + (row0 + 32 * st + r32) * 512 + 256 + 64 * h + 16 * d0 + 8 * hi);
        u32x2 xwv[2][4];
#pragma unroll
        for (int et = 0; et < 2; ++et)
#pragma unroll
            for (int g = 0; g < 4; ++g) xwv[et][g] = *(const u32x2*)(PROJ + row * NIN + C_XO + 64 * h + 32 * et + 8 * g + 4 * hi);
        f32x16 sT[2];
#pragma unroll
        for (int st = 0; st < 2; ++st) {
            f32x16 a;
#pragma unroll
            for (int r = 0; r < 16; ++r) a[r] = 0.f;
#pragma unroll
            for (int d0 = 0; d0 < 4; ++d0) a = __builtin_amdgcn_mfma_f32_32x32x16_bf16(kfr[st][d0], qf[d0], a, 0, 0, 0);
            sT[st] = a;
        }
        const float b_t = bsv[t], inter = b_t + m_c;
        float mx = inter;
#pragma unroll
        for (int st = 0; st < 2; ++st)
#pragma unroll
            for (int g = 0; g < 4; ++g) {
                const f32x4 c4 = *(const LAS f32x4*)(cs + 32 * st + 8 * g + 4 * hi);
#pragma unroll
                for (int e2 = 0; e2 < 4; ++e2) { const int s = 32 * st + 8 * g + 4 * hi + e2; const float dv = (s <= t) ? (b_t + c4[e2]) : -INFINITY; mx = fmaxf(mx, dv); }
            }
        mx = max_x32(mx);
        const float w_inter = __expf(inter - mx);
        float den = 0.f;
#pragma unroll
        for (int st = 0; st < 2; ++st)
#pragma unroll
            for (int g = 0; g < 4; ++g) {
                const f32x4 c4 = *(const LAS f32x4*)(cs + 32 * st + 8 * g + 4 * hi);
#pragma unroll
                for (int e2 = 0; e2 < 4; ++e2) { const int s = 32 * st + 8 * g + 4 * hi + e2; const float dv = (s <= t) ? (b_t + c4[e2] - mx) : -INFINITY;
                    const float qk = sT[st][4 * g + e2] * __expf(dv); sT[st][4 * g + e2] = qk; den += qk; }
            }
        den = sum_x32(den);
        f32x16 acc[3];
#pragma unroll
        for (int et = 0; et < 3; ++et) {
            bf16x8 cfr[4];
#pragma unroll
            for (int d0 = 0; d0 < 4; ++d0) cfr[d0] = *(const bf16x8*)(CST + (32 * et + r32) * 64 + 16 * d0 + 8 * hi);
            f32x16 a;
#pragma unroll
            for (int r = 0; r < 16; ++r) a[r] = 0.f;
#pragma unroll
            for (int d0 = 0; d0 < 4; ++d0) a = __builtin_amdgcn_mfma_f32_32x32x16_bf16(cfr[d0], qf[d0], a, 0, 0, 0);
            acc[et] = a;
        }
        const float qn = shidx(acc[2][0], r32);
#pragma unroll
        for (int et = 0; et < 2; ++et)
#pragma unroll
            for (int r = 0; r < 16; ++r) acc[et][r] *= w_inter;
#pragma unroll
        for (int st = 0; st < 2; ++st)
#pragma unroll
            for (int j = 0; j < 2; ++j) {
                u32x4 pw; pw.x = pk2(sT[st][8 * j + 0], sT[st][8 * j + 1]); pw.y = pk2(sT[st][8 * j + 2], sT[st][8 * j + 3]); pw.z = pk2(sT[st][8 * j + 4], sT[st][8 * j + 5]); pw.w = pk2(sT[st][8 * j + 6], sT[st][8 * j + 7]);
                const bf16x8 pb = __builtin_bit_cast(bf16x8, pw);
#pragma unroll
                for (int et = 0; et < 2; ++et) {
                    const LAS unsigned char* vp = L + M3_VT + ((32 * et + r32) * MP + 32 * st + 16 * j + 4 * hi) * 2;
                    const u32x2 lo = *(const LAS u32x2*)vp, hi2 = *(const LAS u32x2*)(vp + 16);
                    u32x4 vw; vw.x = lo.x; vw.y = lo.y; vw.z = hi2.x; vw.w = hi2.y;
                    acc[et] = __builtin_amdgcn_mfma_f32_32x32x16_bf16(__builtin_bit_cast(bf16x8, vw), pb, acc[et], 0, 0, 0);
                }
            }
        const float dtot = w_inter * qn + den, inv = 1.0f / fmaxf(fabsf(dtot), __expf(-mx));
        float ss = 0.f;
#pragma unroll
        for (int et = 0; et < 2; ++et)
#pragma unroll
            for (int g = 0; g < 4; ++g) {
                const u32x2 xw = xwv[et][g];
                const float xo[4] = {bflo(xw.x), bfhi(xw.x), bflo(xw.y), bfhi(xw.y)};
#pragma unroll
                for (int e2 = 0; e2 < 4; ++e2) { const float hv = acc[et][4 * g + e2] * inv / (1.f + __expf(-xo[e2])); acc[et][4 * g + e2] = hv; ss += hv * hv; }
            }
        ss = sum_x32(ss);
        const float rs = rsqrtf(ss * (1.0f / 64.0f) + EPS);
        bf16_t* dst = (bf16_t*)(p.ws + WS_YCAT) + row * DM + 384 + 64 * h;
#pragma unroll
        for (int et = 0; et < 2; ++et)
#pragma unroll
            for (int g = 0; g < 4; ++g) {
                const f32x4 nv = *(const f32x4*)(nw + 32 * et + 8 * g + 4 * hi);
                u32x2 w; w.x = pk2(acc[et][4 * g] * rs * nv[0], acc[et][4 * g + 1] * rs * nv[1]); w.y = pk2(acc[et][4 * g + 2] * rs * nv[2], acc[et][4 * g + 3] * rs * nv[3]);
                *(u32x2*)(dst + 32 * et + 8 * g + 4 * hi) = w;
            }
    }
    LDS_WAIT();
}

__global__ void __launch_bounds__(NTHR, 2) hybrid_fwd(Params p0) {
    extern __shared__ __attribute__((aligned(16))) unsigned char lds_raw[];
    LAS unsigned char* lds = (LAS unsigned char*)lds_raw;
    cg::grid_group grid = cg::this_grid();
    const int lo = p0.ph_lo, hi = p0.ph_hi;
    if (threadIdx.x < 16) ((LAS unsigned*)(lds + BAR_LDS_OFF))[threadIdx.x] = 0u;
    __syncthreads();
    const int wave_s = __builtin_amdgcn_readfirstlane((int)threadIdx.x >> 6);
    XcdBarrier xbar; xbar.t0 = false; xbar.bar = (unsigned*)(p0.ws + WS_CTL) + 4096; xbar.x = 0; xbar.st = nullptr;
    (void)lo; (void)hi;
    if (blockIdx.x == 0) { unsigned* bw_ = (unsigned*)(p0.ws + WS_CTL) + 4096; for (int i_ = (int)threadIdx.x; i_ < XCD_BAR_WORDS; i_ += NTHR) bw_[i_] = 0u; }
#define IN(k) (true)
#ifdef TS_PROBE
#define STAMP(k) do { if (blockIdx.x == 0 && threadIdx.x == 0) ((LAS unsigned long long*)(lds + 131072 + 256))[(k)] = __builtin_amdgcn_s_memrealtime(); } while (0)
#else
#define STAMP(k) do { } while (0)
#endif
#define SEAM(k) do { if ((k) < 16) { if ((k) == 0) grid.sync(); else xcd_barrier(xbar); } STAMP((k) + 1); } while (0)
    STAMP(0);
#if defined(__HIP_DEVICE_COMPILE__)
#define LOAD_PARAMS(p) do { const __attribute__((address_space(4))) Params* kp_ = (const __attribute__((address_space(4))) Params*)__builtin_amdgcn_kernarg_segment_ptr(); asm volatile("" : "+s"(kp_)); p = *kp_; } while (0)
#else
#define LOAD_PARAMS(p) do { p = p0; } while (0)
#endif
#define PHASE_VARS() int lane_ = lane_nocse(); int wave_ = wave_s; asm volatile("" : "+s"(wave_)); const int lane = lane_, wave = wave_, tid = wave_ * 64 + lane_; \
    int bid = (int)blockIdx.x; asm volatile("" : "+s"(bid)); const int G = (int)gridDim.x; Params p; LOAD_PARAMS(p); { unsigned char* w_ = p.ws; asm volatile("" : "+s"(w_)); p.ws = w_; } unsigned char* ws = p.ws; (void)ws; (void)lane; (void)wave; (void)bid; (void)G
    for (int rep_ = 0; rep_ < ((REPEAT_MASK & 1) ? 2 : 1); ++rep_) { if (rep_) xcd_barrier(xbar);
        if (IN(0)) { PHASE_VARS(); prologue(p, lds, tid, wave, lane); }
    }
        SEAM(0);
    xbar = xcd_barrier_post((unsigned*)(p0.ws + WS_CTL) + 4096, (volatile LAS unsigned*)(lds + BAR_LDS_OFF), wave_s == 0);
#pragma unroll 1
    for (int layer = 0; layer < 2; ++layer) {
        const int P = 1 + 8 * layer;
        for (int rep_ = 0; rep_ < ((REPEAT_MASK & 2) ? 2 : 1); ++rep_) { if (rep_) xcd_barrier(xbar);
        if (IN(P)) { PHASE_VARS(); EpiScaled<0> E{(bf16_t*)(ws + WS_PROJ), NIN, (const float*)(ws + WS_SSQ)}; run_gemm(lds, (const bf16_t*)(ws + WS_XB), (const bf16_t*)(ws + WS_WIN + layer * WIN_L), T, NIN, DM, E, bid, tid);
            if (rep_ == 0) {
                const int nfull = ((T / 256) * (NIN / 256)) % G, w0 = (nfull == 0) ? 0 : nfull;
                if (bid >= w0) {
                    if (layer == 0) convert_deferred_weights(p, lds, (bid - w0) * 8 + wave, (G - w0) * 8, wave, lane);
                    for (int gu = bid - w0; gu < 128; gu += G - w0) gates_unit(p, layer, gu, wave, lane);
                }
            } }
        }
        SEAM(P);
        if (IN(P + 1)) { PHASE_VARS();
            for (int u = bid; u < 128 * 22; u += G) prep_unit(p, layer, u, lds, tid, wave, lane);
#if MIX_STAGE < 3
            { u32x4* y4 = (u32x4*)(ws + WS_YCAT); const u32x4 z = {0u, 0u, 0u, 0u}; for (size_t e = (size_t)bid * NTHR + tid; e < (size_t)T * DM / 8; e += (size_t)G * NTHR) y4[e] = z; }
#endif
        }
        SEAM(P + 1);
        for (int rep_ = 0; rep_ < ((REPEAT_MASK & 4) ? 2 : 1); ++rep_) { if (rep_) xcd_barrier(xbar);
        if (IN(P + 2)) { PHASE_VARS();
#if MIX_STAGE >= 1
            for (int r2_ = 0; r2_ < ((REPEAT_MASK & 512) ? 2 : 1); ++r2_) { for (int un_ = bid * 8 + wave; un_ < 2048; un_ += G * 8) m1_wave_unit(p, un_, lds + wave * MW_SUB, lane); }
#endif
#if MIX_STAGE >= 3
            for (int r2_ = 0; r2_ < ((REPEAT_MASK & 256) ? 2 : 1); ++r2_) { for (int hu = bid * 8 + wave; hu < 6144; hu += G * 8) sel_wave_unit(p, hu >> 1, hu & 1, lane); }
#endif
        }
        }
        SEAM(P + 2);
        for (int rep_ = 0; rep_ < ((REPEAT_MASK & 8) ? 2 : 1); ++rep_) { if (rep_) xcd_barrier(xbar);
        if (IN(P + 3)) { PHASE_VARS();
            if (bid < 65) {
#if MIX_STAGE >= 1
                for (int r2_ = 0; r2_ < ((REPEAT_MASK & 128) ? 2 : 1); ++r2_) { scan_unit(p, bid, lds, tid); }
#endif
            } else {
#if MIX_STAGE >= 2
                for (int r2_ = 0; r2_ < ((REPEAT_MASK & 128) ? 2 : 1); ++r2_) { swa_loop(p, layer, ((bid - 65) * 512) / (G - 65), ((bid - 64) * 512) / (G - 65), lds, tid, wave, lane); }
#endif
            }
#if MIX_STAGE >= 3
            for (int r2_ = 0; r2_ < ((REPEAT_MASK & 64) ? 2 : 1); ++r2_) { moba_sel_loop(p, layer, bid, lds, tid, wave, lane); }
#endif
        }
        }
        SEAM(P + 3);
        for (int rep_ = 0; rep_ < ((REPEAT_MASK & 16) ? 2 : 1); ++rep_) { if (rep_) xcd_barrier(xbar);
        if (IN(P + 4)) { PHASE_VARS();
#if MIX_STAGE >= 3
            for (int r2_ = 0; r2_ < ((REPEAT_MASK & 1024) ? 2 : 1); ++r2_) { moba_own_loop(p, layer, bid, G, lds, tid, wave, lane); }
#endif
#if MIX_STAGE >= 1
            for (int r2_ = 0; r2_ < ((REPEAT_MASK & 2048) ? 2 : 1); ++r2_) { for (int un_ = bid * 8 + wave; un_ < 2048; un_ += G * 8) m3_wave_unit(p, layer, un_, lds + wave * M3_SUB, lane); }
#endif
        }
        }
        SEAM(P + 4);
        if (IN(P + 5)) { PHASE_VARS(); EpiRes E{nullptr, (const bf16_t*)(ws + WS_XB), nullptr, (bf16_t*)(ws + WS_XB), (float*)(ws + WS_SSQ)};     run_gemm(lds, (const bf16_t*)(ws + WS_YCAT), (const bf16_t*)(ws + WS_WOUT + layer * WOUT_L), T, DM, DM, E, bid, tid); }
        SEAM(P + 5);
        for (int rep_ = 0; rep_ < ((REPEAT_MASK & 32) ? 2 : 1); ++rep_) { if (rep_) xcd_barrier(xbar);
        if (IN(P + 6)) { PHASE_VARS(); EpiScaled<1> E{(bf16_t*)(ws + WS_H), FF, (const float*)(ws + WS_SSQ)}; run_gemm(lds, (const bf16_t*)(ws + WS_XB), (const bf16_t*)(ws + WS_WUP + layer * WUP_L), T, FF, DM, E, bid, tid); }
        }
        SEAM(P + 6);
        if (IN(P + 7)) { PHASE_VARS(); EpiRes E{nullptr, (const bf16_t*)(ws + WS_XB), layer == 0 ? nullptr : p.out, layer == 0 ? (bf16_t*)(ws + WS_XB) : nullptr, layer == 0 ? (float*)(ws + WS_SSQ) : nullptr};     run_gemm(lds, (const bf16_t*)(ws + WS_H), (const bf16_t*)(ws + WS_WDN + layer * WDN_L), T, DM, FF, E, bid, tid); }
        SEAM(P + 7);
    }
#ifdef TS_PROBE
    xcd_barrier(xbar);
    if (blockIdx.x == 0 && threadIdx.x == 0) { LAS unsigned long long* ts = (LAS unsigned long long*)(lds + 131072 + 256); p0.out[0] = (float)(ts[TS_PROBE + 1] - ts[TS_PROBE]) * 10.0f; }
#endif
#undef IN
#undef SEAM
}

#ifndef N_LAUNCH_SPLIT
#define N_LAUNCH_SPLIT 0
#endif
extern "C" void kernel_launch(void* const* d_in, const int* in_sizes, int n_in, void* d_out, int out_size, void* d_ws, size_t ws_size, hipStream_t stream) {
    static int grid = 0;
    if (grid == 0) {
        if (n_in != 17 || in_sizes[0] != T * DM || out_size != T * DM || ws_size < WS_END) { fprintf(stderr, "kernel_launch: unexpected shapes (n_in %d, in0 %d, out %d, ws %zu); nothing launched\n", n_in, n_in > 0 ? in_sizes[0] : -1, out_size, ws_size); grid = -1; return; }
        int dev = 0, cus = 0, per_cu = 0;
        if (hipGetDevice(&dev) != hipSuccess || hipDeviceGetAttribute(&cus, hipDeviceAttributeMultiprocessorCount, dev) != hipSuccess) { grid = -1; return; }
        if (hipFuncSetAttribute((const void*)hybrid_fwd, hipFuncAttributeMaxDynamicSharedMemorySize, LDS_BYTES) != hipSuccess) { fprintf(stderr, "kernel_launch: hipFuncSetAttribute failed\n"); grid = -1; return; }
        if (hipOccupancyMaxActiveBlocksPerMultiprocessor(&per_cu, (const void*)hybrid_fwd, NTHR, LDS_BYTES) != hipSuccess || per_cu < 1) { fprintf(stderr, "kernel_launch: occupancy query says %d blocks per CU\n", per_cu); (void)hipGetLastError(); grid = -1; return; }
        grid = cus;
    }
    if (grid < 0) return;
    Params p{};
    const float** pp = (const float**)&p;
    for (int i = 0; i < 17; ++i) pp[i] = (const float*)d_in[i];
    p.out = (float*)d_out; p.ws = (unsigned char*)d_ws;
#if N_LAUNCH_SPLIT
    for (int ph = 0; ph < 17; ++ph) {
        p.ph_lo = ph; p.ph_hi = ph + 1; void* args[] = {&p};
        hipError_t e = hipLaunchCooperativeKernel((const void*)hybrid_fwd, dim3(grid), dim3(NTHR), args, LDS_BYTES, stream);
        if (e != hipSuccess) { fprintf(stderr, "cooperative launch failed: %s\n", hipGetErrorString(e)); break; }
    }
#else
    p.ph_lo = 0; p.ph_hi = 17; void* args[] = {&p};
    hipError_t e = hipLaunchCooperativeKernel((const void*)hybrid_fwd, dim3(grid), dim3(NTHR), args, LDS_BYTES, stream);
    if (e != hipSuccess) fprintf(stderr, "cooperative launch failed: %s (grid %d)\n", hipGetErrorString(e), grid);
#endif
}
```

```cpp
#include <hip/hip_runtime.h>
#include <hip/hip_cooperative_groups.h>
#include <cstdio>
#include <cstdint>
namespace cg = cooperative_groups;
namespace pg8 {
#define PG8_LAS __attribute__((address_space(3)))
typedef unsigned short bf16_t;
typedef short bf16x8 __attribute__((ext_vector_type(8)));
typedef float f32x4 __attribute__((ext_vector_type(4)));
typedef unsigned u32x4 __attribute__((ext_vector_type(4)));
constexpr int BM = 256, BK = 64, HALF = 128, HTB = HALF * BK * 2  , STAGE_BYTES = 8 * HTB, NXCD = 8, WGM = 8;

__host__ __device__ __forceinline__ int lds_byte(int r, int c) { const int st = (r >> 4) * 2 + (c >> 5), rr = r & 15, cc = c & 31, ob = rr * 64 + cc * 2; return st * 1024 + (ob ^ (((ob >> 9) & 1) << 5)); }
__host__ __device__ __forceinline__ void stage_rc(int b, int& R, int& C) { const int st = b / 1024, sb = b % 1024, swz = sb ^ (((sb >> 9) & 1) << 5); R = (st >> 1) * 16 + swz / 64; C = (st & 1) * 32 + (swz % 64) / 2; }
__host__ __device__ __forceinline__ int perm32(int rho) { const int n = rho >> 4, i = rho & 15; return 8 * (i >> 2) + 4 * n + (i & 3); }

struct Unit { int pm, pn; };
struct Gemm { const bf16_t* A; const bf16_t* Bt; int M, N, K; };

struct StaticOrder {
    int nM, nN, nwg, G, c;
    __host__ __device__ void init(int M, int N, int G_, int c_) { nM = M / BM; nN = N / BM; nwg = nM * nN; G = G_; c = c_; }
    __host__ __device__ bool next(int i, Unit& u) const {
        const long L = (long)i * G + c; if (L >= nwg) return false;
        int wgid = (int)L; { const int q = nwg / NXCD, r = nwg % NXCD, xcd = wgid % NXCD, off = wgid / NXCD; wgid = (xcd < r ? xcd * (q + 1) : r * (q + 1) + (xcd - r) * q) + off; }
        const int nig = WGM * nN, gid = wgid / nig, fm = gid * WGM, gsz = (nM - fm) < WGM ? (nM - fm) : WGM;
        u.pm = fm + ((wgid % nig) % gsz); u.pn = (wgid % nig) / gsz; return true;
    }
    __device__ __forceinline__ void a_ready(const Unit&) const {}
    __device__ __forceinline__ void done(const Unit&) const {}
};
__device__ __forceinline__ unsigned cvt_pk_bf16(float lo, float hi) { unsigned r; asm volatile("v_cvt_pk_bf16_f32 %0, %1, %2" : "=v"(r) : "v"(lo), "v"(hi)); return r; }
typedef float f32x2 __attribute__((ext_vector_type(2)));
template <class Epi, class Sched, bool ALIGN_EPI = false, bool SP2 = false>
__device__ __forceinline__ void gemm_phase(PG8_LAS unsigned char* lds, const Gemm g, const Sched& S, const Epi& E, const int tid_in  ) {
    const int tid = tid_in, wid = __builtin_amdgcn_readfirstlane(tid >> 6), lane = tid & 63, wr = wid >> 2, wc = wid & 3, fr = lane & 15, fq = lane >> 4;
    const int K = g.K, nt = K / BK;
    unsigned voffA[2], voffB[2];
#pragma unroll
    for (int i = 0; i < 2; ++i) { int R, C; stage_rc(tid * 16 + i * 8192, R, C); const int Rb = Epi::PERM ? ((R & ~31) + perm32(R & 31)) : R;
        voffA[i] = (unsigned)(R * K + C) * 2u; voffB[i] = (unsigned)(Rb * K + C) * 2u; }
    const size_t kstep = (size_t)(BK * 2);
    const size_t hstep = (size_t)HALF * K * 2;
    const size_t tstep = 2 * hstep;
    const unsigned ldsw = (unsigned)wid * 1024u;
    const int aoff = lds_byte(wr * 64 + fr, fq * 8), boff = lds_byte(wc * 32 + fr, fq * 8);
#define PG8_SA(b, h) (((b) * 2 + (h)) * HTB)
#define PG8_SB(b, h) ((4 + (b) * 2 + (h)) * HTB)
#define PG8_STAGE(bufoff, gbase, voff) do { _Pragma("unroll") for (int _i = 0; _i < 2; ++_i) \
        __builtin_amdgcn_global_load_lds((const unsigned*)((const char*)(gbase) + (voff)[_i]), (PG8_LAS unsigned*)(lds + (bufoff) + ldsw + _i * 8192), 16, 0, 0); } while (0)
#define PG8_LDA(dst, b, h) do { _Pragma("unroll") for (int m = 0; m < 4; ++m) _Pragma("unroll") for (int k = 0; k < 2; ++k) dst[m][k] = *(const PG8_LAS bf16x8*)(lds + PG8_SA(b, h) + aoff + m * 2048 + k * 1024); } while (0)
#define PG8_LDB(dst, b, h) do { _Pragma("unroll") for (int n = 0; n < 2; ++n) _Pragma("unroll") for (int k = 0; k < 2; ++k) dst[n][k] = *(const PG8_LAS bf16x8*)(lds + PG8_SB(b, h) + boff + n * 2048 + k * 1024); } while (0)
#define PG8_MMA(ai, bj, At, Bt) do { __builtin_amdgcn_s_setprio(1); _Pragma("unroll") for (int m = 0; m < 4; ++m) _Pragma("unroll") for (int n = 0; n < 2; ++n) _Pragma("unroll") for (int k = 0; k < 2; ++k) \
        acc[ai][bj][m][n] = __builtin_amdgcn_mfma_f32_16x16x32_bf16(Bt[n][k], At[m][k], acc[ai][bj][m][n], 0, 0, 0); __builtin_amdgcn_s_setprio(0); } while (0)
#define PG8_WAIT_V(n) asm volatile("s_waitcnt vmcnt(" #n ")" ::: "memory")
#define PG8_WAIT_L(n) asm volatile("s_waitcnt lgkmcnt(" #n ")" ::: "memory")
#define PG8_BAR __builtin_amdgcn_s_barrier()
#define PG8_SCHED __builtin_amdgcn_sched_barrier(0)
    Unit cur, nxt; int ui = 0;
    if (!S.next(0, cur)) return;
    f32x4 acc[2][2][4][2];
#pragma unroll
    for (int a = 0; a < 2; ++a)
#pragma unroll
        for (int b = 0; b < 2; ++b)
#pragma unroll
            for (int m = 0; m < 4; ++m)
#pragma unroll
                for (int n = 0; n < 2; ++n) acc[a][b][m][n] = (f32x4){0.f, 0.f, 0.f, 0.f};
    bf16x8 At[4][2], B0[2][2], B1[2][2];
    const char* cA = (const char*)g.A + (size_t)cur.pm * tstep; const char* cB = (const char*)g.Bt + (size_t)cur.pn * tstep;
    S.a_ready(cur);
    if constexpr (SP2) {
        PG8_STAGE(PG8_SB(0, 0), cB, voffB); PG8_STAGE(PG8_SB(0, 1), cB + hstep, voffB); PG8_STAGE(PG8_SA(0, 0), cA, voffA); PG8_STAGE(PG8_SA(0, 1), cA + hstep, voffA);
        if (wr == 1) PG8_BAR;
        PG8_WAIT_V(2); PG8_BAR;
        PG8_STAGE(PG8_SB(1, 0), cB + kstep, voffB); PG8_STAGE(PG8_SA(1, 0), cA + kstep, voffA); PG8_STAGE(PG8_SB(1, 1), cB + hstep + kstep, voffB);
        PG8_WAIT_V(6); PG8_BAR;
    } else {
        PG8_STAGE(PG8_SB(0, 0), cB, voffB); PG8_STAGE(PG8_SA(0, 0), cA, voffA); PG8_STAGE(PG8_SB(0, 1), cB + hstep, voffB); PG8_STAGE(PG8_SA(0, 1), cA + hstep, voffA);
        if (wr == 1) PG8_BAR;
        PG8_WAIT_V(4); PG8_BAR;
        PG8_STAGE(PG8_SB(1, 0), cB + kstep, voffB); PG8_STAGE(PG8_SA(1, 0), cA + kstep, voffA); PG8_STAGE(PG8_SB(1, 1), cB + hstep + kstep, voffB);
        PG8_WAIT_V(6); PG8_BAR;
    }
    for (;;) {
        const bool has_next = S.next(ui + 1, nxt);
        const char* nA = has_next ? (const char*)g.A + (size_t)nxt.pm * tstep : cA; const char* nB = has_next ? (const char*)g.Bt + (size_t)nxt.pn * tstep : cB;
        for (int t = 0; t < nt; t += 2) {
            const bool last = (t == nt - 2);
            const char* a1 = cA + (size_t)(t + 1) * kstep;
            const char* a2 = last ? nA : cA + (size_t)(t + 2) * kstep; const char* b2 = last ? nB : cB + (size_t)(t + 2) * kstep;
            const char* a3 = a2 + kstep; const char* b3 = b2 + kstep;
            if (last && has_next) S.a_ready(nxt);
            if constexpr (SP2) {
            PG8_LDB(B0, 0, 0); PG8_LDB(B1, 0, 1); PG8_SCHED; PG8_LDA(At, 0, 0); PG8_STAGE(PG8_SA(1, 1), a1 + hstep, voffA);
            PG8_WAIT_V(8); PG8_WAIT_L(0); PG8_BAR; PG8_MMA(0, 0, At, B0); PG8_MMA(0, 1, At, B1); PG8_BAR; PG8_SCHED;
            PG8_LDA(At, 0, 1); PG8_STAGE(PG8_SB(0, 0), b2, voffB); PG8_STAGE(PG8_SB(0, 1), b2 + hstep, voffB); PG8_STAGE(PG8_SA(0, 0), a2, voffA);
            PG8_WAIT_V(8); PG8_WAIT_L(0); PG8_BAR; PG8_MMA(1, 0, At, B0); PG8_MMA(1, 1, At, B1); PG8_BAR; PG8_SCHED;
            PG8_LDB(B0, 1, 0); PG8_LDB(B1, 1, 1); PG8_SCHED; PG8_LDA(At, 1, 0); PG8_STAGE(PG8_SA(0, 1), a2 + hstep, voffA);
            PG8_WAIT_V(8); PG8_WAIT_L(0); PG8_BAR; PG8_MMA(0, 0, At, B0); PG8_MMA(0, 1, At, B1); PG8_BAR; PG8_SCHED;
            PG8_LDA(At, 1, 1); PG8_STAGE(PG8_SB(1, 0), b3, voffB); PG8_STAGE(PG8_SB(1, 1), b3 + hstep, voffB); PG8_STAGE(PG8_SA(1, 0), a3, voffA);
            PG8_WAIT_V(8); PG8_WAIT_L(0); PG8_BAR; PG8_MMA(1, 0, At, B0); PG8_MMA(1, 1, At, B1); PG8_BAR; PG8_SCHED;
            } else {
            PG8_LDB(B0, 0, 0); PG8_SCHED; PG8_LDA(At, 0, 0); PG8_STAGE(PG8_SA(1, 1), a1 + hstep, voffA);
            PG8_WAIT_L(8); PG8_BAR; PG8_WAIT_L(0); PG8_MMA(0, 0, At, B0); PG8_BAR; PG8_SCHED;
            PG8_LDB(B1, 0, 1); PG8_STAGE(PG8_SB(0, 0), b2, voffB);
            PG8_BAR; PG8_WAIT_L(0); PG8_MMA(0, 1, At, B1); PG8_BAR;
            PG8_LDA(At, 0, 1); PG8_STAGE(PG8_SA(0, 0), a2, voffA);
            PG8_BAR; PG8_WAIT_L(0); PG8_MMA(1, 0, At, B0); PG8_BAR; PG8_SCHED;
            PG8_STAGE(PG8_SB(0, 1), b2 + hstep, voffB);
            PG8_WAIT_V(6); PG8_BAR; PG8_MMA(1, 1, At, B1); PG8_BAR;
            PG8_LDB(B0, 1, 0); PG8_SCHED; PG8_LDA(At, 1, 0); PG8_STAGE(PG8_SA(0, 1), a2 + hstep, voffA);
            PG8_WAIT_L(8); PG8_BAR; PG8_WAIT_L(0); PG8_MMA(0, 0, At, B0); PG8_BAR; PG8_SCHED;
            PG8_LDB(B1, 1, 1); PG8_STAGE(PG8_SB(1, 0), b3, voffB);
            PG8_BAR; PG8_WAIT_L(0); PG8_MMA(0, 1, At, B1); PG8_BAR;
            PG8_LDA(At, 1, 1); PG8_STAGE(PG8_SA(1, 0), a3, voffA);
            PG8_BAR; PG8_WAIT_L(0); PG8_MMA(1, 0, At, B0); PG8_BAR; PG8_SCHED;
            PG8_STAGE(PG8_SB(1, 1), b3 + hstep, voffB);
            PG8_WAIT_V(6); PG8_BAR; PG8_MMA(1, 1, At, B1); PG8_BAR;
            }
        }
        if constexpr (ALIGN_EPI) { if (wr == 0) PG8_BAR; }
        if constexpr (!Epi::AFTER_DRAIN) { E(acc, cur, wr, wc, fr, fq); S.done(cur); }
        if (!has_next) break;
#pragma unroll
        for (int a = 0; a < 2; ++a)
#pragma unroll
            for (int b = 0; b < 2; ++b)
#pragma unroll
                for (int m = 0; m < 4; ++m)
#pragma unroll
                    for (int n = 0; n < 2; ++n) acc[a][b][m][n] = (f32x4){0.f, 0.f, 0.f, 0.f};
        cur = nxt; cA = nA; cB = nB; ++ui;
        if constexpr (ALIGN_EPI) { if (wr == 1) PG8_BAR; }
    }
    PG8_WAIT_V(0);
    if constexpr (!ALIGN_EPI) { if (wr == 0) PG8_BAR; }
    PG8_BAR;
    if constexpr (Epi::AFTER_DRAIN) { E.fused(acc, cur, wr, wc, fr, fq, lds, wid, lane); S.done(cur); }
#undef PG8_SA
#undef PG8_SB
#undef PG8_STAGE
#undef PG8_LDA
#undef PG8_LDB
#undef PG8_MMA
#undef PG8_WAIT_V
#undef PG8_WAIT_L
#undef PG8_BAR
#undef PG8_SCHED
}
}

#ifndef MIX_STAGE
#define MIX_STAGE 3
#endif
using pg8::bf16_t; using pg8::bf16x8; using pg8::f32x4; using pg8::u32x4; using pg8::f32x2;
#define LAS __attribute__((address_space(3)))
typedef float f32x16 __attribute__((ext_vector_type(16)));
typedef unsigned u32x2 __attribute__((ext_vector_type(2)));
typedef __bf16 bf16x2_t __attribute__((ext_vector_type(2)));

constexpr int NB = 2, S = 16384, T = NB * S, DM = 1024, NIN = 2816, INW = 2824, FF = 4096;
constexpr int C_MQ = 0, C_MK = 384, C_MV = 768, C_SQ = 1152, C_SK = 1536, C_SV = 1664, C_XQK = 1792, C_XV = 2304, C_XO = 2560;
constexpr float EPS = 1e-6f;
constexpr float LOG2E = 1.4426950408889634f;
constexpr float QSCALE = 0.125f * LOG2E;
constexpr int NTHR = 512;

constexpr size_t MiB = 1ull << 20;
constexpr size_t WS_WIN = 1 * MiB, WIN_L = (size_t)NIN * DM * 2;
constexpr size_t WS_WOUT = 12 * MiB, WOUT_L = (size_t)DM * DM * 2;
constexpr size_t WS_WUP = 16 * MiB, WUP_L = (size_t)FF * DM * 2;
constexpr size_t WS_WDN = 32 * MiB, WDN_L = (size_t)DM * FF * 2;
constexpr size_t WS_WG = 48 * MiB;
constexpr size_t WS_COS = 49 * MiB, WS_SIN = 51 * MiB;
constexpr size_t WS_SSQ = 53 * MiB;
constexpr size_t WS_GATES = 55 * MiB;
constexpr size_t WS_KMH = 56 * MiB, WS_KML = 56 * MiB + 262144;
constexpr size_t WS_SEL = 57 * MiB;
constexpr size_t WS_MISC = 58 * MiB;
constexpr size_t WS_PML = 59 * MiB;
constexpr size_t WS_XB = 64 * MiB;
constexpr size_t OUT_DC = 0;
constexpr size_t OUT_CST = 40 * MiB;
constexpr size_t WS_LQK = 128 * MiB;
constexpr size_t WS_YCAT = 160 * MiB;
constexpr size_t WS_PROJ = 224 * MiB;
constexpr size_t WS_PARTO = 400 * MiB;
constexpr size_t WS_H = 224 * MiB;
constexpr size_t WS_END = 480 * MiB;
static_assert(WS_WIN + 2 * WIN_L <= WS_WOUT && OUT_DC + (size_t)2048 * 4160 * 4 <= OUT_CST && OUT_CST + (size_t)2049 * 4160 * 2 <= (size_t)T * DM * 4, "ws / d_out map");
static_assert(WS_PROJ + (size_t)T * NIN * 2 <= WS_PARTO && WS_PARTO + (size_t)12 * S * 3 * 64 * 2 <= WS_END && WS_H + (size_t)T * FF * 2 <= WS_END, "ws map 2");

constexpr int LDS_BYTES = 147456 + 256, BAR_LDS_OFF = 147456 + 64;
constexpr size_t WS_CTL = 0;

struct Params {
    const float* x; const float* ln1; const float* w_in; const float* conv_w; const float* conv_b; const float* igate_b; const float* fgate_b;
    const float* mlstm_norm; const float* moba_q_norm; const float* moba_k_norm; const float* swa_q_norm; const float* swa_k_norm; const float* swa_sinks;
    const float* w_out; const float* ln2; const float* w_up; const float* w_down;
    float* out; unsigned char* ws; int ph_lo, ph_hi;
};

__device__ __forceinline__ int lane_nocse() { int l; asm volatile("v_mbcnt_lo_u32_b32 %0, -1, 0\n\tv_mbcnt_hi_u32_b32 %0, -1, %0" : "=v"(l)); return l; }
__device__ __forceinline__ float shx(float v, int m, int lane) { return __builtin_bit_cast(float, __builtin_amdgcn_ds_bpermute((lane ^ m) << 2, __builtin_bit_cast(int, v))); }
__device__ __forceinline__ int shx(int v, int m, int lane) { return __builtin_amdgcn_ds_bpermute((lane ^ m) << 2, v); }
__device__ __forceinline__ float shidx(float v, int src) { return __builtin_bit_cast(float, __builtin_amdgcn_ds_bpermute(src << 2, __builtin_bit_cast(int, v))); }
__device__ __forceinline__ float shup(float v, int o, int lane) { return __builtin_bit_cast(float, __builtin_amdgcn_ds_bpermute((lane >= o ? lane - o : lane) << 2, __builtin_bit_cast(int, v))); }

__device__ __forceinline__ float wave_sum(float v, int lane) {
#pragma unroll
    for (int o = 1; o < 64; o <<= 1) v += shx(v, o, lane);
    return v;
}
__device__ __forceinline__ float wave_max(float v, int lane) {
#pragma unroll
    for (int o = 1; o < 64; o <<= 1) v = fmaxf(v, shx(v, o, lane));
    return v;
}
__device__ __forceinline__ unsigned pk2(float lo, float hi) { f32x2 v = {lo, hi}; bf16x2_t b = __builtin_convertvector(v, bf16x2_t); return __builtin_bit_cast(unsigned, b); }
__device__ __forceinline__ float bflo(unsigned w) { return __uint_as_float(w << 16); }
__device__ __forceinline__ float bfhi(unsigned w) { return __uint_as_float(w & 0xffff0000u); }
__device__ __forceinline__ void unpack8(const u32x4 w, float (&v)[8]) {
    v[0] = bflo(w.x); v[1] = bfhi(w.x); v[2] = bflo(w.y); v[3] = bfhi(w.y); v[4] = bflo(w.z); v[5] = bfhi(w.z); v[6] = bflo(w.w); v[7] = bfhi(w.w);
}
__device__ __forceinline__ u32x4 pack8(const float (&v)[8]) { u32x4 w; w.x = pk2(v[0], v[1]); w.y = pk2(v[2], v[3]); w.z = pk2(v[4], v[5]); w.w = pk2(v[6], v[7]); return w; }
#define LDS_WAIT() asm volatile("s_waitcnt lgkmcnt(0)" ::: "memory")
typedef unsigned u32x2s __attribute__((ext_vector_type(2)));
__device__ __forceinline__ float max_x32(float v) { const auto rr = __builtin_amdgcn_permlane32_swap(__float_as_uint(v), __float_as_uint(v), false, false); return fmaxf(__uint_as_float(rr[0]), __uint_as_float(rr[1])); }
__device__ __forceinline__ float sum_x32(float v) { const auto rr = __builtin_amdgcn_permlane32_swap(__float_as_uint(v), __float_as_uint(v), false, false); return __uint_as_float(rr[0]) + __uint_as_float(rr[1]); }
__device__ __forceinline__ float exp2_fast(float v) { return __builtin_amdgcn_exp2f(v); }

template <int ACT  > struct EpiScaled {
    static constexpr bool PERM = true, AFTER_DRAIN = false;
    bf16_t* O; int ldc; const float* ssq;
    __device__ __forceinline__ void operator()(const f32x4 (&acc)[2][2][4][2], const pg8::Unit& u, int wr, int wc, int fr, int fq) const {
        const int row0 = u.pm * pg8::BM + wr * 64 + fr, col0 = u.pn * pg8::BM + wc * 32 + 8 * fq;
        f32x4 sp[2][4];
#pragma unroll
        for (int ai = 0; ai < 2; ++ai)
#pragma unroll
            for (int m = 0; m < 4; ++m) sp[ai][m] = *(const f32x4*)(ssq + (size_t)(row0 + ai * pg8::HALF + m * 16) * 16 + 4 * fq);
#pragma unroll
        for (int ai = 0; ai < 2; ++ai)
#pragma unroll
            for (int m = 0; m < 4; ++m) {
                const int row = row0 + ai * pg8::HALF + m * 16;
                float s_ = (sp[ai][m][0] + sp[ai][m][1]) + (sp[ai][m][2] + sp[ai][m][3]); s_ += shx(s_, 16, fr + 16 * fq); s_ = sum_x32(s_);
                const float rs = rsqrtf(s_ * (1.0f / 1024.0f) + EPS);
                bf16_t* rowp = O + (size_t)row * ldc + col0;
#pragma unroll
                for (int bj = 0; bj < 2; ++bj) {
                    f32x4 v0 = acc[ai][bj][m][0] * rs, v1 = acc[ai][bj][m][1] * rs;
                    if (ACT == 1) {
#pragma unroll
                        for (int i = 0; i < 4; ++i) { const float a = fmaxf(v0[i], 0.f), b = fmaxf(v1[i], 0.f); v0[i] = a * a; v1[i] = b * b; }
                    }
                    u32x4 w; w.x = pk2(v0[0], v0[1]); w.y = pk2(v0[2], v0[3]); w.z = pk2(v1[0], v1[1]); w.w = pk2(v1[2], v1[3]);
                    *(u32x4*)(rowp + bj * pg8::HALF) = w;
                }
            }
    }
};
struct EpiRes {
    static constexpr bool PERM = true, AFTER_DRAIN = false;
    const float* resf; const bf16_t* resb; float* outf; bf16_t* xb; float* ssq;
    __device__ __forceinline__ void operator()(const f32x4 (&acc)[2][2][4][2], const pg8::Unit& u, int wr, int wc, int fr, int fq) const {
        const int row0 = u.pm * pg8::BM + wr * 64 + fr, col0 = u.pn * pg8::BM + wc * 32 + 8 * fq;
#pragma unroll
        for (int ai = 0; ai < 2; ++ai) {
            f32x4 rv[4][2][2];
            if (resf) {
#pragma unroll
                for (int m = 0; m < 4; ++m)
#pragma unroll
                    for (int bj = 0; bj < 2; ++bj) { const size_t o_ = (size_t)(row0 + ai * pg8::HALF + m * 16) * DM + col0 + bj * pg8::HALF; rv[m][bj][0] = *(const f32x4*)(resf + o_); rv[m][bj][1] = *(const f32x4*)(resf + o_ + 4); }
            } else {
                u32x4 rb[4][2];
#pragma unroll
                for (int m = 0; m < 4; ++m)
#pragma unroll
                    for (int bj = 0; bj < 2; ++bj) rb[m][bj] = *(const u32x4*)(resb + (size_t)(row0 + ai * pg8::HALF + m * 16) * DM + col0 + bj * pg8::HALF);
#pragma unroll
                for (int m = 0; m < 4; ++m)
#pragma unroll
                    for (int bj = 0; bj < 2; ++bj) { const u32x4 w = rb[m][bj]; rv[m][bj][0] = (f32x4){bflo(w.x), bfhi(w.x), bflo(w.y), bfhi(w.y)}; rv[m][bj][1] = (f32x4){bflo(w.z), bfhi(w.z), bflo(w.w), bfhi(w.w)}; }
            }
#pragma unroll
            for (int m = 0; m < 4; ++m) {
                const int row = row0 + ai * pg8::HALF + m * 16;
                const size_t off = (size_t)row * DM + col0;
                float part = 0.f;
#pragma unroll
                for (int bj = 0; bj < 2; ++bj) {
                    const f32x4 v0 = acc[ai][bj][m][0] + rv[m][bj][0], v1 = acc[ai][bj][m][1] + rv[m][bj][1];
                    if (outf) { __builtin_nontemporal_store(v0, (f32x4*)(outf + off + bj * pg8::HALF)); __builtin_nontemporal_store(v1, (f32x4*)(outf + off + bj * pg8::HALF + 4)); }
                    if (xb) { u32x4 w; w.x = pk2(v0[0], v0[1]); w.y = pk2(v0[2], v0[3]); w.z = pk2(v1[0], v1[1]); w.w = pk2(v1[2], v1[3]); *(u32x4*)(xb + off + bj * pg8::HALF) = w; }
                    part += (v0[0] * v0[0] + v0[1] * v0[1]) + (v0[2] * v0[2] + v0[3] * v0[3]) + (v1[0] * v1[0] + v1[1] * v1[1]) + (v1[2] * v1[2] + v1[3] * v1[3]);
                }
                part += shx(part, 16, fr + 16 * fq); part = sum_x32(part);
                if (ssq && fq == 0) ssq[(size_t)row * 16 + u.pn * 4 + wc] = part;
            }
        }
    }
};
template <class Epi> __device__ __forceinline__ void run_gemm(LAS unsigned char* lds, const bf16_t* A, const bf16_t* Bt, int M, int N, int K, const Epi& E, int bid, int tid) {
    pg8::Gemm g{A, Bt, M, N, K}; pg8::StaticOrder so; so.init(M, N, (int)gridDim.x, bid);
    pg8::gemm_phase<Epi, pg8::StaticOrder, true, true>(lds, g, so, E, tid);
}

__device__ __forceinline__ void transpose_item(const float* W, int K, int ld, int nblk, const float* scale, bf16_t* WT, LAS float* scr, int item, int lane) {
    const int kb = item / nblk, nb = item % nblk, k0 = 64 * kb, n0 = 32 * nb;
    float tv[32];
#pragma unroll
    for (int i = 0; i < 32; ++i) { const int kk = 2 * i + (lane >> 5); tv[i] = W[(size_t)(k0 + kk) * ld + n0 + (lane & 31)]; }
    if (scale) {
#pragma unroll
        for (int i = 0; i < 32; ++i) tv[i] *= scale[k0 + 2 * i + (lane >> 5)];
    }
#pragma unroll
    for (int i = 0; i < 32; ++i) scr[(2 * i + (lane >> 5)) * 33 + (lane & 31)] = tv[i];
    LDS_WAIT();
    const int c = lane & 7;
#pragma unroll
    for (int j = 0; j < 4; ++j) {
        const int n = (lane >> 3) + 8 * j; const LAS float* s = scr + (8 * c) * 33 + n;
        u32x4 o; o.x = pk2(s[0 * 33], s[1 * 33]); o.y = pk2(s[2 * 33], s[3 * 33]); o.z = pk2(s[4 * 33], s[5 * 33]); o.w = pk2(s[6 * 33], s[7 * 33]);
        *(u32x4*)(WT + (size_t)(n0 + n) * K + k0 + 8 * c) = o;
    }
    LDS_WAIT();
}
__device__ __forceinline__ void rope_entry(int pos, int i, float& cs, float& sn) {
    const double R = 0.74989420933245582730;
    double inv = 1.0; { double b = R; int e = i; while (e) { if (e & 1) inv *= b; b *= b; e >>= 1; } }
    const double ang = (double)pos * inv;
    const double n = __builtin_rint(ang * 0.63661977236758134308);
    double y = __builtin_fma(-n, 1.57079632679489655800, ang); y = __builtin_fma(-n, 6.12323399573676603587e-17, y);
    const double y2 = y * y;
    double sp = -1.0 / 1307674368000.0; sp = sp * y2 + 1.0 / 6227020800.0; sp = sp * y2 - 1.0 / 39916800.0; sp = sp * y2 + 1.0 / 362880.0; sp = sp * y2 - 1.0 / 5040.0;
    sp = sp * y2 + 1.0 / 120.0; sp = sp * y2 - 1.0 / 6.0; sp = sp * y2 + 1.0; const double sy = sp * y;
    double cp = 1.0 / 20922789888000.0; cp = cp * y2 - 1.0 / 87178291200.0; cp = cp * y2 + 1.0 / 479001600.0; cp = cp * y2 - 1.0 / 3628800.0; cp = cp * y2 + 1.0 / 40320.0;
    cp = cp * y2 - 1.0 / 720.0; cp = cp * y2 + 1.0 / 24.0; cp = cp * y2 - 0.5; const double cy = cp * y2 + 1.0;
    const int q = (int)((long long)n & 3);
    const double s_ = (q == 0) ? sy : (q == 1) ? cy : (q == 2) ? -sy : -cy;
    const double c_ = (q == 0) ? cy : (q == 1) ? -sy : (q == 2) ? -cy : sy;
    cs = (float)c_; sn = (float)s_;
}
__device__ __forceinline__ void prologue(const Params& p, LAS unsigned char* lds, int tid, int wave, int lane) {
    unsigned char* ws = p.ws;
    const int G = (int)gridDim.x, gw = (int)blockIdx.x * 8 + wave, NGW = G * 8;
    LAS float* scr = (LAS float*)(lds + wave * 8704);
    for (int it = gw; it < 16 * 88; it += NGW) transpose_item(p.w_in, DM, INW, 88, p.ln1, (bf16_t*)(ws + WS_WIN), scr, it, lane);
    constexpr int I_IN = 16 * 88, I_OUT = 16 * 32, I_UP = 16 * 128, I_DN = 64 * 32, I_L = I_IN + I_OUT + I_UP + I_DN;
    for (int it = gw; it < 0; it += NGW) {
        const int l = it / I_L; int r = it % I_L;
        if (r < I_IN) { transpose_item(p.w_in + (size_t)l * DM * INW, DM, INW, 88, p.ln1 + l * DM, (bf16_t*)(ws + WS_WIN + l * WIN_L), scr, r, lane); continue; } r -= I_IN;
        if (r < I_OUT) { transpose_item(p.w_out + (size_t)l * DM * DM, DM, DM, 32, nullptr, (bf16_t*)(ws + WS_WOUT + l * WOUT_L), scr, r, lane); continue; } r -= I_OUT;
        if (r < I_UP) { transpose_item(p.w_up + (size_t)l * DM * FF, DM, FF, 128, p.ln2 + l * DM, (bf16_t*)(ws + WS_WUP + l * WUP_L), scr, r, lane); continue; } r -= I_UP;
        transpose_item(p.w_down + (size_t)l * FF * DM, FF, DM, 32, nullptr, (bf16_t*)(ws + WS_WDN + l * WDN_L), scr, r, lane);
    }
    { float* WG = (float*)(ws + WS_WG);
      bf16_t* WGH = (bf16_t*)(ws + WS_WG + 131072); bf16_t* WGL = (bf16_t*)(ws + WS_WG + 196608);
      for (int e = (int)blockIdx.x * NTHR + tid; e < 2 * 8 * DM; e += G * NTHR) { const int l = e >> 13, c = (e >> 10) & 7, k = e & 1023; const float wv_ = p.ln1[l * DM + k] * p.w_in[((size_t)l * DM + k) * INW + NIN + c];
          WG[e] = wv_; const unsigned hb = pk2(wv_, 0.f) & 0xffffu; WGH[e] = (bf16_t)hb; WGL[e] = (bf16_t)(pk2(wv_ - bflo(hb), 0.f) & 0xffffu); } }
    if (blockIdx.x == 0 && tid < 4) {
        const int l = tid >> 1, ty = tid & 1; const float* gq = (ty ? p.swa_q_norm : p.moba_q_norm) + l * 64; const float* gk = (ty ? p.swa_k_norm : p.moba_k_norm) + l * 64;
        float mq = 0.f, mk = 0.f; for (int d = 0; d < 64; ++d) { mq = fmaxf(mq, fabsf(gq[d])); mk = fmaxf(mk, fabsf(gk[d])); }
        ((float*)(ws + WS_MISC))[6144 + tid] = fminf(QSCALE * 64.f * mq * mk * 1.01f, 60.f);
    }
    { float* COS = (float*)(ws + WS_COS); float* SIN = (float*)(ws + WS_SIN);
      for (int e = (int)blockIdx.x * NTHR + tid; e < S * 32; e += G * NTHR) { float c, s; rope_entry(e >> 5, e & 31, c, s); COS[e] = c; SIN[e] = s; } }
    { bf16_t* XB = (bf16_t*)(ws + WS_XB); float* SSQ = (float*)(ws + WS_SSQ);
      for (int m0 = gw * 4; m0 < T; m0 += NGW * 4) {
          f32x4 v[4][4];
#pragma unroll
          for (int rr = 0; rr < 4; ++rr) { const f32x4* xr = (const f32x4*)(p.x + (size_t)(m0 + rr) * DM) + lane;
#pragma unroll
              for (int j = 0; j < 4; ++j) v[rr][j] = xr[64 * j]; }
#pragma unroll
          for (int rr = 0; rr < 4; ++rr) {
              float s = 0.f;
#pragma unroll
              for (int j = 0; j < 4; ++j) s += (v[rr][j][0] * v[rr][j][0] + v[rr][j][1] * v[rr][j][1]) + (v[rr][j][2] * v[rr][j][2] + v[rr][j][3] * v[rr][j][3]);
              s = wave_sum(s, lane);
              u32x2* o8 = (u32x2*)(XB + (size_t)(m0 + rr) * DM) + lane;
#pragma unroll
              for (int j = 0; j < 4; ++j) { u32x2 w; w.x = pk2(v[rr][j][0], v[rr][j][1]); w.y = pk2(v[rr][j][2], v[rr][j][3]); o8[64 * j] = w; }
              if (lane < 16) SSQ[(size_t)(m0 + rr) * 16 + lane] = (lane == 0) ? s : 0.f;
          }
      } }
}

__device__ __forceinline__ void convert_deferred_weights(const Params& p, LAS unsigned char* lds, int first, int stride, int wave, int lane) {
    unsigned char* ws = p.ws;
    LAS float* scr = (LAS float*)(lds + wave * 8704);
    constexpr int I_IN = 16 * 88, I_OUT = 16 * 32, I_UP = 16 * 128, I_DN = 64 * 32, I_L0 = I_OUT + I_UP + I_DN, I_ALL = I_L0 + I_IN + I_OUT + I_UP + I_DN;
    for (int it = first; it < I_ALL; it += stride) {
        int r = it, l = 0;
        if (r >= I_L0) { r -= I_L0; l = 1;
            if (r < I_IN) { transpose_item(p.w_in + (size_t)DM * INW, DM, INW, 88, p.ln1 + DM, (bf16_t*)(ws + WS_WIN + WIN_L), scr, r, lane); continue; } r -= I_IN; }
        if (r < I_OUT) { transpose_item(p.w_out + (size_t)l * DM * DM, DM, DM, 32, nullptr, (bf16_t*)(ws + WS_WOUT + l * WOUT_L), scr, r, lane); continue; } r -= I_OUT;
        if (r < I_UP) { transpose_item(p.w_up + (size_t)l * DM * FF, DM, FF, 128, p.ln2 + l * DM, (bf16_t*)(ws + WS_WUP + l * WUP_L), scr, r, lane); continue; } r -= I_UP;
        transpose_item(p.w_down + (size_t)l * FF * DM, FF, DM, 32, nullptr, (bf16_t*)(ws + WS_WDN + l * WDN_L), scr, r, lane);
    }
}

__device__ __forceinline__ void gates_unit(const Params& p, int layer, int blk, int wave, int lane) {
    const int r32 = lane & 31, hi = lane >> 5; const size_t row = (size_t)blk * 256 + 32 * wave + r32;
    const bf16_t* XB = (const bf16_t*)(p.ws + WS_XB) + row * DM;
    const bf16_t* WGH = (const bf16_t*)(p.ws + WS_WG + 131072) + (size_t)layer * 8 * DM + (size_t)(r32 & 7) * DM;
    const bf16_t* WGL = (const bf16_t*)(p.ws + WS_WG + 196608) + (size_t)layer * 8 * DM + (size_t)(r32 & 7) * DM;
    const bool wrow = r32 < 8;
    f32x16 acc;
#pragma unroll
    for (int r = 0; r < 16; ++r) acc[r] = 0.f;
#pragma unroll 1
    for (int k0 = 0; k0 < 64; k0 += 4) {
        bf16x8 xb[4], ah[4], al[4];
#pragma unroll
        for (int ks = 0; ks < 4; ++ks) {
            xb[ks] = *(const bf16x8*)(XB + 16 * (k0 + ks) + 8 * hi);
            const bf16x8 z = {0, 0, 0, 0, 0, 0, 0, 0};
            ah[ks] = wrow ? *(const bf16x8*)(WGH + 16 * (k0 + ks) + 8 * hi) : z; al[ks] = wrow ? *(const bf16x8*)(WGL + 16 * (k0 + ks) + 8 * hi) : z;
        }
#pragma unroll
        for (int ks = 0; ks < 4; ++ks) { acc = __builtin_amdgcn_mfma_f32_32x32x16_bf16(ah[ks], xb[ks], acc, 0, 0, 0); acc = __builtin_amdgcn_mfma_f32_32x32x16_bf16(al[ks], xb[ks], acc, 0, 0, 0); }
    }
    const float* SSQ = (const float*)(p.ws + WS_SSQ) + row * 16;
    float sp = 0.f;
#pragma unroll
    for (int q4 = 0; q4 < 4; ++q4) { const f32x4 t4 = *(const f32x4*)(SSQ + 4 * q4); sp += (t4[0] + t4[1]) + (t4[2] + t4[3]); }
    const float rs = rsqrtf(sp * (1.0f / 1024.0f) + EPS);
    const float* bp = (hi == 0) ? (p.igate_b + layer * 4) : (p.fgate_b + layer * 4);
    f32x4 o; o[0] = acc[0] * rs + bp[0]; o[1] = acc[1] * rs + bp[1]; o[2] = acc[2] * rs + bp[2]; o[3] = acc[3] * rs + bp[3];
    *(f32x4*)((float*)(p.ws + WS_GATES) + row * 8 + 4 * hi) = o;
}

__device__ __forceinline__ void prep_unit(const Params& p, int layer, int u, LAS unsigned char* lds, int tid, int wave, int lane) {
    unsigned char* ws = p.ws;
    const int blk = u / 22, j22 = u % 22, job = j22 < 12 ? j22 : j22 + 6;
    const int row0 = blk * 256, b = blk >> 6, pos0 = (blk & 63) * 256;
    bf16_t* PROJ = (bf16_t*)(ws + WS_PROJ);
    const int c = lane & 7, tl = lane >> 3;
    if (job < 20) {
        int col; const float* gw; float scale; bool iskm = false; int kh = 0;
        if (job < 6) { col = C_MQ + 64 * job; gw = p.moba_q_norm + layer * 64; scale = QSCALE; }
        else if (job < 12) { kh = job - 6; col = C_MK + 64 * kh; gw = p.moba_k_norm + layer * 64; scale = 1.f; iskm = true; }
        else if (job < 18) { col = C_SQ + 64 * (job - 12); gw = p.swa_q_norm + layer * 64; scale = QSCALE; }
        else { col = C_SK + 64 * (job - 18); gw = p.swa_k_norm + layer * 64; scale = 1.f; }
        float gv[8]; { const f32x4 g0 = *(const f32x4*)(gw + 8 * c), g1 = *(const f32x4*)(gw + 8 * c + 4); gv[0] = g0[0]; gv[1] = g0[1]; gv[2] = g0[2]; gv[3] = g0[3]; gv[4] = g1[0]; gv[5] = g1[1]; gv[6] = g1[2]; gv[7] = g1[3]; }
        float ks[8];
#pragma unroll
        for (int e = 0; e < 8; ++e) ks[e] = 0.f;
        const float* COS = (const float*)(ws + WS_COS); const float* SIN = (const float*)(ws + WS_SIN);
        u32x4 win[4]; f32x4 cc0[4], cc1[4], sc0[4], sc1[4];
#pragma unroll
        for (int it = 0; it < 4; ++it) {
            const int tt = 32 * wave + 8 * it + tl, pos = pos0 + tt;
            win[it] = *(const u32x4*)(PROJ + (size_t)(row0 + tt) * NIN + col + 8 * c);
            cc0[it] = *(const f32x4*)(COS + (size_t)pos * 32 + 8 * (c & 3)); cc1[it] = *(const f32x4*)(COS + (size_t)pos * 32 + 8 * (c & 3) + 4);
            sc0[it] = *(const f32x4*)(SIN + (size_t)pos * 32 + 8 * (c & 3)); sc1[it] = *(const f32x4*)(SIN + (size_t)pos * 32 + 8 * (c & 3) + 4);
        }
#pragma unroll
        for (int it = 0; it < 4; ++it) {
            const int tt = 32 * wave + 8 * it + tl;
            bf16_t* ptr = PROJ + (size_t)(row0 + tt) * NIN + col + 8 * c;
            const u32x4 w = win[it]; float v[8]; unpack8(w, v);
            float ss = 0.f;
#pragma unroll
            for (int e = 0; e < 8; ++e) ss += v[e] * v[e];
            ss += shx(ss, 1, lane); ss += shx(ss, 2, lane); ss += shx(ss, 4, lane);
            const float rs = rsqrtf(ss * (1.0f / 64.0f) + EPS);
            const f32x4 c0 = cc0[it], c1 = cc1[it], s0 = sc0[it], s1 = sc1[it];
            float o[8];
#pragma unroll
            for (int e = 0; e < 8; ++e) {
                const float val = v[e] * rs * gv[e]; const float pr = shx(val, 4, lane);
                const float cs = (e < 4) ? c0[e & 3] : c1[e & 3], sn = (e < 4) ? s0[e & 3] : s1[e & 3];
                o[e] = (c < 4) ? (val * cs - pr * sn) : (val * cs + pr * sn);
                ks[e] += o[e];
                o[e] *= scale;
            }
            *(u32x4*)ptr = pack8(o);
        }
        if (iskm) {
#pragma unroll
            for (int e = 0; e < 8; ++e) { ks[e] += shx(ks[e], 8, lane); ks[e] += shx(ks[e], 16, lane); ks[e] = sum_x32(ks[e]); }
            LAS float* red = (LAS float*)lds;
            if (tl == 0) {
#pragma unroll
                for (int e = 0; e < 8; ++e) red[wave * 64 + 8 * c + e] = ks[e];
            }
            __syncthreads();
            if (tid < 64) {
                float s = 0.f;
#pragma unroll
                for (int w8 = 0; w8 < 8; ++w8) s += red[w8 * 64 + tid];
                const float mean = s * (1.0f / 256.0f); const unsigned hb = pk2(mean, 0.f) & 0xffffu; const unsigned lb = pk2(mean - bflo(hb), 0.f) & 0xffffu;
                const size_t ki = ((size_t)((b * 6 + kh) * 64 + (blk & 63))) * 64 + tid;
                ((bf16_t*)(ws + WS_KMH))[ki] = (bf16_t)hb; ((bf16_t*)(ws + WS_KML))[ki] = (bf16_t)lb;
            }
            __syncthreads();
        }
    } else if (job < 28) {
        const int cj = job - 20, col = C_XQK + 64 * cj; const float osc = (cj >= 4) ? 0.125f : 1.f;
        bf16_t* LQK = (bf16_t*)(ws + WS_LQK);
        float cw[4][8], cb[8];
#pragma unroll
        for (int jj = 0; jj < 4; ++jj) { const float* wp = p.conv_w + ((size_t)layer * 4 + jj) * 512 + 64 * cj + 8 * c; const f32x4 a = *(const f32x4*)wp, bq = *(const f32x4*)(wp + 4);
            cw[jj][0] = a[0]; cw[jj][1] = a[1]; cw[jj][2] = a[2]; cw[jj][3] = a[3]; cw[jj][4] = bq[0]; cw[jj][5] = bq[1]; cw[jj][6] = bq[2]; cw[jj][7] = bq[3]; }
        { const float* bp = p.conv_b + (size_t)layer * 512 + 64 * cj + 8 * c; const f32x4 a = *(const f32x4*)bp, bq = *(const f32x4*)(bp + 4);
          cb[0] = a[0]; cb[1] = a[1]; cb[2] = a[2]; cb[3] = a[3]; cb[4] = bq[0]; cb[5] = bq[1]; cb[6] = bq[2]; cb[7] = bq[3]; }
        u32x4 xin[4][4];
#pragma unroll
        for (int it = 0; it < 4; ++it) {
            const int tt = 32 * wave + 8 * it + tl, pos = pos0 + tt; const size_t row = (size_t)row0 + tt;
#pragma unroll
            for (int jj = 0; jj < 4; ++jj) { const u32x4 z = {0u, 0u, 0u, 0u}; xin[it][jj] = (pos - 3 + jj >= 0) ? *(const u32x4*)(PROJ + (row - 3 + jj) * NIN + col + 8 * c) : z; }
        }
#pragma unroll
        for (int it = 0; it < 4; ++it) {
            const int tt = 32 * wave + 8 * it + tl; const size_t row = (size_t)row0 + tt;
            float acc[8];
#pragma unroll
            for (int e = 0; e < 8; ++e) acc[e] = cb[e];
#pragma unroll
            for (int jj = 0; jj < 4; ++jj) {
                float v[8]; unpack8(xin[it][jj], v);
#pragma unroll
                for (int e = 0; e < 8; ++e) acc[e] += cw[jj][e] * v[e];
            }
            float o[8];
#pragma unroll
            for (int e = 0; e < 8; ++e) { const float y = acc[e]; o[e] = y / (1.f + __expf(-y)) * osc; }
            *(u32x4*)(LQK + row * 512 + 64 * cj + 8 * c) = pack8(o);
        }
    }
}

#define RLX_AGENT __ATOMIC_RELAXED, __HIP_MEMORY_SCOPE_AGENT
#define XB_TMO      128
#define XB_XCNT(j)  (256  + 64 * (j))
#define XB_XSUB(j)  (1280 + 64 * (j))
#define XB_XGEN(j)  (2304 + 64 * (j))
#define XB_TOP      3328
#define XB_TOPGEN   3392
#define XCD_BAR_WORDS 3456
#define XB_SPIN_CAP (1u << 18)

__device__ __forceinline__ unsigned xb_ld(unsigned* p)              { return __hip_atomic_load(p, __ATOMIC_RELAXED, __HIP_MEMORY_SCOPE_AGENT); }
__device__ __forceinline__ unsigned xb_add(unsigned* p, unsigned v) { return __hip_atomic_fetch_add(p, v, __ATOMIC_RELAXED, __HIP_MEMORY_SCOPE_AGENT); }
__device__ __forceinline__ unsigned xb_xcc_id() { return (unsigned)__builtin_amdgcn_s_getreg((3 << 11) | 20) & 0xFu; }
#define XB_SPIN(cond, bar) do { unsigned _sp = 0; while (cond) { __builtin_amdgcn_s_sleep(1); \
    if ((++_sp & 255u) == 0u) { if (xb_ld(&(bar)[XB_TMO])) break; if (_sp > XB_SPIN_CAP) { atomicAdd(&(bar)[XB_TMO], 1u); break; } } } } while (0)

struct XcdBarrier {
    bool t0; unsigned* bar; unsigned x;
    volatile LAS unsigned* st;
};

struct XcdBarrier; __device__ __forceinline__ bool xb_is_t0(const XcdBarrier& b);
__device__ __forceinline__ XcdBarrier xcd_barrier_post(unsigned* bar, volatile LAS unsigned* st, bool t0  ) {
    XcdBarrier b; b.bar = bar; b.x = xb_xcc_id(); b.st = st;
    b.t0 = t0; if (xb_is_t0(b)) (void)xb_add(&bar[XB_XCNT(b.x)], 1u);
    return b;
}
__device__ __forceinline__ void xcd_barrier_complete(unsigned* bar, unsigned x, unsigned& nloc, unsigned& nx) {
    const unsigned G = gridDim.x * gridDim.y * gridDim.z;
    unsigned sum, cnt, mine, sp = 0u;
    for (;;) {
        sum = 0u; cnt = 0u; mine = 0u;
#pragma unroll
        for (unsigned j = 0; j < 16; ++j) { const unsigned c = xb_ld(&bar[XB_XCNT(j)]); sum += c; cnt += (c > 0u) ? 1u : 0u; }
        if (sum == G) break;
        __builtin_amdgcn_s_sleep(1);
        if ((++sp & 255u) == 0u) { if (xb_ld(&bar[XB_TMO])) break; if (sp > XB_SPIN_CAP) { atomicAdd(&bar[XB_TMO], 1u); break; } }
    }
    mine = xb_ld(&bar[XB_XCNT(x)]);
    nloc = mine > 0u ? mine : 1u; nx = cnt > 0u ? cnt : 1u;
}

__device__ __forceinline__ bool xb_is_t0(const XcdBarrier& b) { int l_; asm volatile("v_mbcnt_lo_u32_b32 %0, -1, 0\n\tv_mbcnt_hi_u32_b32 %0, -1, %0" : "=v"(l_)); return b.t0 && l_ == 0; }
__device__ __forceinline__ void xcd_barrier(const XcdBarrier& b) {
    asm volatile("s_waitcnt vmcnt(0)" ::: "memory");
    __syncthreads();
    if (xb_is_t0(b)) {
        unsigned* bar = b.bar;
        __builtin_amdgcn_s_waitcnt(0);
        unsigned nloc = b.st[0], nx = b.st[1];
        if (nloc == 0u) { xcd_barrier_complete(bar, b.x, nloc, nx); b.st[0] = nloc; b.st[1] = nx; }
        const unsigned old = xb_add(&bar[XB_XSUB(b.x)], 1u);
        const unsigned gen = old / nloc;
        if (old + 1u == (gen + 1u) * nloc) {
            __builtin_amdgcn_fence(__ATOMIC_RELEASE, "agent");
            asm volatile("s_waitcnt vmcnt(0)" ::: "memory");
            const unsigned og = xb_add(&bar[XB_TOP], 1u);
            const unsigned tg = og / nx;
            if (og + 1u == (tg + 1u) * nx) xb_add(&bar[XB_TOPGEN], 1u);
            else XB_SPIN(xb_ld(&bar[XB_TOPGEN]) == tg, bar);
            __builtin_amdgcn_fence(__ATOMIC_ACQUIRE, "agent");
            xb_add(&bar[XB_XGEN(b.x)], 1u);
            asm volatile("s_waitcnt vmcnt(0)" ::: "memory");
        } else {
            XB_SPIN(xb_ld(&bar[XB_XGEN(b.x)]) == gen, bar);
            __builtin_amdgcn_fence(__ATOMIC_ACQUIRE, "agent");
            asm volatile("s_waitcnt vmcnt(0)" ::: "memory");
        }
    }
    __syncthreads();
}
#ifndef REPEAT_MASK
#define REPEAT_MASK 0
#endif

constexpr int KP = 72, VP = 260;
constexpr int AT_KS = 0, AT_VT = 256 * KP * 2, AT_LIST = AT_VT + 64 * VP * 2, AT_CNT = AT_LIST + 32768;
__device__ __forceinline__ void stage_kv256(LAS unsigned char* lds, const bf16_t* kb, const bf16_t* vb, long row0, long rowmin, int tid) {
#pragma unroll
    for (int i = 0; i < 4; ++i) {
        const int chunk = i * NTHR + tid, row = chunk >> 3, c8 = chunk & 7;
        long gr = row0 + row; gr = gr < rowmin ? rowmin : gr;
        const u32x4 kv = *(const u32x4*)(kb + gr * NIN + 8 * c8);
        const u32x4 vv = *(const u32x4*)(vb + gr * NIN + 8 * c8);
        *(LAS u32x4*)(lds + AT_KS + (row * KP + 8 * c8) * 2) = kv;
        LAS bf16_t* vt = (LAS bf16_t*)(lds + AT_VT) + (8 * c8) * VP + row;
        vt[0 * VP] = (bf16_t)(vv.x & 0xffffu); vt[1 * VP] = (bf16_t)(vv.x >> 16); vt[2 * VP] = (bf16_t)(vv.y & 0xffffu); vt[3 * VP] = (bf16_t)(vv.y >> 16);
        vt[4 * VP] = (bf16_t)(vv.z & 0xffffu); vt[5 * VP] = (bf16_t)(vv.z >> 16); vt[6 * VP] = (bf16_t)(vv.w & 0xffffu); vt[7 * VP] = (bf16_t)(vv.w >> 16);
    }
}
struct KVRegs { u32x4 k[4], v[4]; };
__device__ __forceinline__ void kv_load(KVRegs& r, const bf16_t* kb, const bf16_t* vb, long row0, long rowmin, int tid) {
#pragma unroll
    for (int i = 0; i < 4; ++i) {
        const int chunk = i * NTHR + tid, row = chunk >> 3, c8 = chunk & 7;
        long gr = row0 + row; gr = gr < rowmin ? rowmin : gr;
        r.k[i] = *(const u32x4*)(kb + gr * NIN + 8 * c8); r.v[i] = *(const u32x4*)(vb + gr * NIN + 8 * c8);
    }
}
__device__ __forceinline__ void kv_store(LAS unsigned char* lds, const KVRegs& r, int tid) {
#pragma unroll
    for (int i = 0; i < 4; ++i) {
        const int chunk = i * NTHR + tid, row = chunk >> 3, c8 = chunk & 7;
        *(LAS u32x4*)(lds + AT_KS + (row * KP + 8 * c8) * 2) = r.k[i];
        LAS bf16_t* vt = (LAS bf16_t*)(lds + AT_VT) + (8 * c8) * VP + row; const u32x4 vv = r.v[i];
        vt[0 * VP] = (bf16_t)(vv.x & 0xffffu); vt[1 * VP] = (bf16_t)(vv.x >> 16); vt[2 * VP] = (bf16_t)(vv.y & 0xffffu); vt[3 * VP] = (bf16_t)(vv.y >> 16);
        vt[4 * VP] = (bf16_t)(vv.z & 0xffffu); vt[5 * VP] = (bf16_t)(vv.z >> 16); vt[6 * VP] = (bf16_t)(vv.w & 0xffffu); vt[7 * VP] = (bf16_t)(vv.w >> 16);
    }
}
__device__ __forceinline__ void attn_iter(const LAS unsigned char* kbase, const LAS unsigned char* vbase, const bf16x8 (&qf)[4], const bf16x8 (&kc)[4], bf16x8 (&kn)[4], int kt, int ktn, bool masked, int klo, unsigned kspan,
                                          const f32x16& negMv, f32x16 (&o)[2], float& l) {
    u32x2 vfl[2][2], vfh[2][2];
#pragma unroll
    for (int j = 0; j < 2; ++j)
#pragma unroll
        for (int dt = 0; dt < 2; ++dt) { const LAS unsigned char* vp = vbase + (32 * dt * VP + 32 * kt + 16 * j) * 2; vfl[j][dt] = *(const LAS u32x2*)vp; vfh[j][dt] = *(const LAS u32x2*)(vp + 16); }
#pragma unroll
    for (int d0 = 0; d0 < 4; ++d0) kn[d0] = *(const LAS bf16x8*)(kbase + (32 * ktn * KP + 16 * d0) * 2);
    f32x16 s = __builtin_amdgcn_mfma_f32_32x32x16_bf16(kc[0], qf[0], negMv, 0, 0, 0);
#pragma unroll
    for (int d0 = 1; d0 < 4; ++d0) s = __builtin_amdgcn_mfma_f32_32x32x16_bf16(kc[d0], qf[d0], s, 0, 0, 0);
    if (masked) {
#pragma unroll
        for (int r = 0; r < 16; ++r) { const int kv = 32 * kt + (r & 3) + 8 * (r >> 2); s[r] = ((unsigned)(kv - klo) <= kspan) ? s[r] : -INFINITY; }
    }
    float sum = 0.f;
#pragma unroll
    for (int r = 0; r < 16; ++r) { const float pv = exp2_fast(s[r]); s[r] = pv; sum += pv; }
    l += sum;
#pragma unroll
    for (int j = 0; j < 2; ++j) {
        u32x4 pw; pw.x = pk2(s[8 * j + 0], s[8 * j + 1]); pw.y = pk2(s[8 * j + 2], s[8 * j + 3]); pw.z = pk2(s[8 * j + 4], s[8 * j + 5]); pw.w = pk2(s[8 * j + 6], s[8 * j + 7]);
        const bf16x8 pb = __builtin_bit_cast(bf16x8, pw);
#pragma unroll
        for (int dt = 0; dt < 2; ++dt) {
            u32x4 vw; vw.x = vfl[j][dt].x; vw.y = vfl[j][dt].y; vw.z = vfh[j][dt].x; vw.w = vfh[j][dt].y;
            o[dt] = __builtin_amdgcn_mfma_f32_32x32x16_bf16(__builtin_bit_cast(bf16x8, vw), pb, o[dt], 0, 0, 0);
        }
    }
}
__device__ __forceinline__ void attn_tile(const LAS unsigned char* lds, const bf16x8 (&qf)[4], int kmin, int kmax, int kt_lo, int kt_hi, int mlo_kt, int mhi_kt, float negM, int r32, int hi, f32x16 (&o)[2], float& lrow) {
    const LAS unsigned char* kbase = lds + AT_KS + (r32 * KP + 8 * hi) * 2;
    const LAS unsigned char* vbase = lds + AT_VT + (r32 * VP + 4 * hi) * 2;
    const int klo = kmin - 4 * hi; const unsigned kspan = (unsigned)(kmax - kmin);
    f32x16 negMv;
#pragma unroll
    for (int r = 0; r < 16; ++r) negMv[r] = negM;
#pragma unroll
    for (int dt = 0; dt < 2; ++dt)
#pragma unroll
        for (int r = 0; r < 16; ++r) o[dt][r] = 0.f;
    float l = 0.f;
    bf16x8 ka[4], kb[4];
#pragma unroll
    for (int d0 = 0; d0 < 4; ++d0) ka[d0] = *(const LAS bf16x8*)(kbase + (32 * kt_lo * KP + 16 * d0) * 2);
#pragma unroll 1
    for (int kt = kt_lo; kt <= kt_hi; kt += 2) {
        attn_iter(kbase, vbase, qf, ka, kb, kt, (kt < kt_hi) ? kt + 1 : kt, (kt <= mlo_kt || kt >= mhi_kt), klo, kspan, negMv, o, l);
        if (kt + 1 > kt_hi) break;
        attn_iter(kbase, vbase, qf, kb, ka, kt + 1, (kt + 1 < kt_hi) ? kt + 2 : kt + 1, (kt + 1 <= mlo_kt || kt + 1 >= mhi_kt), klo, kspan, negMv, o, l);
    }
    lrow = sum_x32(l);
}
__device__ __forceinline__ float softmax_ref(const Params& p, int layer, int type  ) { return ((const float*)(p.ws + WS_MISC))[6144 + layer * 2 + type]; }
__device__ __forceinline__ void store_orow_bf16(bf16_t* dst, const f32x16 (&o)[2], float sc, int hi) {
#pragma unroll
    for (int dt = 0; dt < 2; ++dt)
#pragma unroll
        for (int g = 0; g < 4; ++g) { u32x2 w; w.x = pk2(o[dt][4 * g] * sc, o[dt][4 * g + 1] * sc); w.y = pk2(o[dt][4 * g + 2] * sc, o[dt][4 * g + 3] * sc); *(u32x2*)(dst + 32 * dt + 8 * g + 4 * hi) = w; }
}
__device__ __forceinline__ void load_qf(bf16x8 (&qf)[4], const bf16_t* qrow, int hi) {
#pragma unroll
    for (int d0 = 0; d0 < 4; ++d0) qf[d0] = *(const bf16x8*)(qrow + 16 * d0 + 8 * hi);
}

__device__ __forceinline__ void qnorm_rope(bf16x8 (&qf)[4], int pos, const float* gq, const float* COS, const float* SIN, int hi) {
    float v[4][8];
#pragma unroll
    for (int d0 = 0; d0 < 4; ++d0) unpack8(__builtin_bit_cast(u32x4, qf[d0]), v[d0]);
    float ss = 0.f;
#pragma unroll
    for (int d0 = 0; d0 < 4; ++d0)
#pragma unroll
        for (int e = 0; e < 8; ++e) ss += v[d0][e] * v[d0][e];
    const float rs = rsqrtf(sum_x32(ss) * (1.0f / 64.0f) + EPS);
#pragma unroll
    for (int d0 = 0; d0 < 4; ++d0) { const f32x4 g0 = *(const f32x4*)(gq + 16 * d0 + 8 * hi), g1 = *(const f32x4*)(gq + 16 * d0 + 8 * hi + 4);
#pragma unroll
        for (int e = 0; e < 8; ++e) v[d0][e] *= rs * ((e < 4) ? g0[e & 3] : g1[e & 3]); }
#pragma unroll
    for (int d0 = 0; d0 < 2; ++d0) {
        const f32x4 c0 = *(const f32x4*)(COS + (size_t)pos * 32 + 16 * d0 + 8 * hi), c1 = *(const f32x4*)(COS + (size_t)pos * 32 + 16 * d0 + 8 * hi + 4);
        const f32x4 s0 = *(const f32x4*)(SIN + (size_t)pos * 32 + 16 * d0 + 8 * hi), s1 = *(const f32x4*)(SIN + (size_t)pos * 32 + 16 * d0 + 8 * hi + 4);
#pragma unroll
        for (int e = 0; e < 8; ++e) {
            const float cs = (e < 4) ? c0[e & 3] : c1[e & 3], sn = (e < 4) ? s0[e & 3] : s1[e & 3];
            const float x1 = v[d0][e], x2 = v[d0 + 2][e];
            v[d0][e] = (x1 * cs - x2 * sn) * QSCALE; v[d0 + 2][e] = (x2 * cs + x1 * sn) * QSCALE;
        }
    }
#pragma unroll
    for (int d0 = 0; d0 < 4; ++d0) qf[d0] = __builtin_bit_cast(bf16x8, pack8(v[d0]));
}
__device__ __forceinline__ void swa_loop(const Params& p, int layer, int first, int stride, LAS unsigned char* lds, int tid, int wave, int lane) {
    const bf16_t* PROJ = (const bf16_t*)(p.ws + WS_PROJ); bf16_t* YC = (bf16_t*)(p.ws + WS_YCAT);
    const int r32 = lane & 31, hi = lane >> 5; const float negM = -softmax_ref(p, layer, 1);
    int u = first; bool have = u < 512;
    while (have) {
        const int kh = u & 1, n = (u >> 1) & 127, b = u >> 8; const long rowb = (long)b * S;
        __syncthreads();
        { KVRegs kv; kv_load(kv, PROJ + C_SK + 64 * kh, PROJ + C_SV + 64 * kh, rowb + 128 * (n - 1), rowb, tid); kv_store(lds, kv, tid); }
        bf16x8 qfa[4], qfb[4];
        { const int qh = 3 * kh + (wave >> 2), rt = wave & 3; load_qf(qfa, PROJ + (rowb + 128 * n + 32 * rt + r32) * NIN + C_SQ + 64 * qh, hi); }
        { const int tl = (wave < 4) ? wave + 8 : wave; const int qh = 3 * kh + (tl >> 2), rt = tl & 3; load_qf(qfb, PROJ + (rowb + 128 * n + 32 * rt + r32) * NIN + C_SQ + 64 * qh, hi); }
        { const float* gq = p.swa_q_norm + layer * 64; const float* COS = (const float*)(p.ws + WS_COS); const float* SIN = (const float*)(p.ws + WS_SIN);
          qnorm_rope(qfa, 128 * n + 32 * (wave & 3) + r32, gq, COS, SIN, hi);
          asm volatile("" : "+v"(qfa[0]), "+v"(qfa[1]), "+v"(qfa[2]), "+v"(qfa[3]) :: "memory");
          qnorm_rope(qfb, 128 * n + 32 * (wave & 3) + r32, gq, COS, SIN, hi);
          asm volatile("" : "+v"(qfb[0]), "+v"(qfb[1]), "+v"(qfb[2]), "+v"(qfb[3]) :: "memory"); }
        __syncthreads();
        const int un = u + stride; const bool hn = un < 512;
#pragma unroll
        for (int rep = 0; rep < 2; ++rep) {
            const int tl = wave + 8 * rep;
            if (tl < 12) {
                const int qh = 3 * kh + (tl >> 2), rt = tl & 3, qi = 32 * rt + r32; const long row = rowb + 128 * n + qi;
                int kmin = qi + 1; if (n == 0 && kmin < 128) kmin = 128;
                const int ktl = (n == 0 && rt < 4) ? 4 : rt;
                f32x16 o[2]; float l;
                if (rep == 0) attn_tile(lds, qfa, kmin, qi + 128, ktl, rt + 4, ktl, rt + 4, negM, r32, hi, o, l);
                else attn_tile(lds, qfb, kmin, qi + 128, ktl, rt + 4, ktl, rt + 4, negM, r32, hi, o, l);
                l += exp2_fast(p.swa_sinks[layer * 6 + qh] * LOG2E + negM);
                store_orow_bf16(YC + row * DM + 640 + 64 * qh, o, 1.0f / l, hi);
            }
        }
        u = un; have = hn;
    }
    __syncthreads();
}

#define TOP3_INSERT(g, ju) do { if ((g) > v0) { v2 = v1; i2 = i1; v1 = v0; i1 = i0; v0 = (g); i0 = (ju); } else if ((g) > v1) { v2 = v1; i2 = i1; v1 = (g); i1 = (ju); } else if ((g) > v2) { v2 = (g); i2 = (ju); } } while (0)
__device__ __forceinline__ void sel_wave_unit(const Params& p, int wu, int qt, int lane) {
    const int bh = wu >> 8, i = wu & 255, b = bh / 6, h = bh % 6, t0 = i * 64, blk = t0 >> 8;
    unsigned* SEL = (unsigned*)(p.ws + WS_SEL) + (size_t)bh * S + t0;
    if (blk == 0) { if (lane < 32) SEL[32 * qt + lane] = 0xFFFFFFu; return; }
    const int r32 = lane & 31, hi = lane >> 5;
    const bf16_t* KH = (const bf16_t*)(p.ws + WS_KMH) + (size_t)bh * 4096; const bf16_t* KL = (const bf16_t*)(p.ws + WS_KML) + (size_t)bh * 4096;
    const bf16_t* PROJ = (const bf16_t*)(p.ws + WS_PROJ);
    const int njt = (blk > 32) ? 2 : 1;
    {
        bf16x8 qf[4]; load_qf(qf, PROJ + ((size_t)b * S + t0 + 32 * qt + r32) * NIN + C_MQ + 64 * h, hi);
        float v0 = -INFINITY, v1 = -INFINITY, v2 = -INFINITY; unsigned i0 = 255u, i1 = 255u, i2 = 255u;
#pragma unroll 1
        for (int jt = 0; jt < njt; ++jt) {
            f32x16 acc;
#pragma unroll
            for (int r = 0; r < 16; ++r) acc[r] = 0.f;
#pragma unroll
            for (int d0 = 0; d0 < 4; ++d0) {
                const bf16x8 ah = *(const bf16x8*)(KH + (32 * jt + r32) * 64 + 16 * d0 + 8 * hi), al = *(const bf16x8*)(KL + (32 * jt + r32) * 64 + 16 * d0 + 8 * hi);
                acc = __builtin_amdgcn_mfma_f32_32x32x16_bf16(ah, qf[d0], acc, 0, 0, 0);
                acc = __builtin_amdgcn_mfma_f32_32x32x16_bf16(al, qf[d0], acc, 0, 0, 0);
            }
#pragma unroll
            for (int r = 0; r < 16; ++r) { const int j = 32 * jt + (r & 3) + 8 * (r >> 2) + 4 * hi; const float g = (j < blk) ? acc[r] : -INFINITY; const unsigned ju = (unsigned)j; TOP3_INSERT(g, ju); }
        }
        const float p0 = shx(v0, 32, lane), p1 = shx(v1, 32, lane), p2 = shx(v2, 32, lane);
        const unsigned q0 = (unsigned)shx((int)i0, 32, lane), q1 = (unsigned)shx((int)i1, 32, lane), q2 = (unsigned)shx((int)i2, 32, lane);
        TOP3_INSERT(p0, q0); TOP3_INSERT(p1, q1); TOP3_INSERT(p2, q2);
        if (hi == 0) SEL[32 * qt + r32] = i0 | (i1 << 8) | (i2 << 16);
    }
}
constexpr int MOBA_TAB_W = 4;
__constant__ unsigned short moba_tab[256][MOBA_TAB_W] = {
    {693,65535,65535,65535},{630,65535,65535,65535},{567,65535,65535,65535},{504,65535,65535,65535},{441,65535,65535,65535},{378,65535,65535,65535},{315,65535,65535,65535},{252,65535,65535,65535},
    {189,65535,65535,65535},{126,65535,65535,65535},{63,65535,65535,65535},{0,65535,65535,65535},{694,65535,65535,65535},{631,65535,65535,65535},{568,65535,65535,65535},{505,65535,65535,65535},
    {442,65535,65535,65535},{379,65535,65535,65535},{316,65535,65535,65535},{253,65535,65535,65535},{190,65535,65535,65535},{127,65535,65535,65535},{64,65535,65535,65535},{1,65535,65535,65535},
    {695,748,65535,65535},{632,685,65535,65535},{569,622,65535,65535},{506,559,65535,65535},{443,496,65535,65535},{380,433,65535,65535},{317,370,65535,65535},{254,307,65535,65535},
    {191,244,65535,65535},{128,181,65535,65535},{65,118,65535,65535},{2,55,65535,65535},{696,237,754,65535},{633,174,691,65535},{570,111,628,65535},{507,48,565,65535},
    {444,742,501,65535},{381,679,438,65535},{318,616,375,65535},{255,553,312,65535},{192,490,249,65535},{129,427,186,65535},{66,364,123,65535},{3,301,60,65535},
    {697,480,251,65535},{634,417,188,65535},{571,354,125,65535},{508,291,62,65535},{445,228,65535,65535},{382,165,65535,65535},{319,102,65535,65535},{256,39,65535,65535},
    {193,733,250,65535},{130,670,187,65535},{67,607,124,65535},{4,544,61,65535},{698,479,755,65535},{635,416,692,65535},{572,353,629,65535},{509,290,566,65535},
    {446,227,503,65535},{383,164,440,65535},{320,101,377,65535},{257,38,314,65535},{194,732,502,65535},{131,669,439,65535},{68,606,376,65535},{5,543,313,65535},
    {699,224,746,65535},{636,161,683,65535},{573,98,620,65535},{510,35,557,65535},{447,729,491,65535},{384,666,428,65535},{321,603,365,65535},{258,540,302,65535},
    {195,477,239,65535},{132,414,176,65535},{69,351,113,65535},{6,288,50,65535},{700,223,494,65535},{637,160,431,65535},{574,97,368,65535},{511,34,305,65535},
    {448,728,238,65535},{385,665,175,65535},{322,602,112,65535},{259,539,49,65535},{196,476,743,65535},{133,413,680,65535},{70,350,617,65535},{7,287,554,65535},
    {701,222,242,65535},{638,159,179,65535},{575,96,116,65535},{512,33,53,65535},{449,727,744,65535},{386,664,681,65535},{323,601,618,65535},{260,538,555,65535},
    {197,475,492,65535},{134,412,429,65535},{71,349,366,65535},{8,286,303,65535},{702,221,747,65535},{639,158,684,65535},{576,95,621,65535},{513,32,558,65535},
    {450,726,481,65535},{387,663,418,65535},{324,600,355,65535},{261,537,292,65535},{198,474,229,65535},{135,411,166,65535},{72,348,103,65535},{9,285,40,65535},
    {703,220,495,65535},{640,157,432,65535},{577,94,369,65535},{514,31,306,65535},{451,725,240,65535},{388,662,177,65535},{325,599,114,65535},{262,536,51,65535},
    {199,473,745,65535},{136,410,682,65535},{73,347,619,65535},{10,284,556,65535},{704,219,243,65535},{641,156,180,65535},{578,93,117,65535},{515,30,54,65535},
    {452,724,493,65535},{389,661,430,65535},{326,598,367,65535},{263,535,304,65535},{200,472,241,65535},{137,409,178,65535},{74,346,115,65535},{11,283,52,65535},
    {705,218,739,246},{642,155,676,183},{579,92,613,120},{516,29,550,57},{453,723,734,65535},{390,660,671,65535},{327,597,608,65535},{264,534,545,65535},
    {201,471,482,65535},{138,408,419,65535},{75,345,356,65535},{12,282,293,65535},{706,217,487,751},{643,154,424,688},{580,91,361,625},{517,28,298,562},
    {454,722,230,65535},{391,659,167,65535},{328,596,104,65535},{265,533,41,65535},{202,470,735,65535},{139,407,672,65535},{76,344,609,65535},{13,281,546,65535},
    {707,216,235,499},{644,153,172,436},{581,90,109,373},{518,27,46,310},{455,721,483,65535},{392,658,420,65535},{329,595,357,65535},{266,532,294,65535},
    {203,469,231,65535},{140,406,168,65535},{77,343,105,65535},{14,280,42,65535},{708,215,740,245},{645,152,677,182},{582,89,614,119},{519,26,551,56},
    {456,720,736,65535},{393,657,673,65535},{330,594,610,65535},{267,531,547,65535},{204,468,484,65535},{141,405,421,65535},{78,342,358,65535},{15,279,295,65535},
    {709,214,488,750},{646,151,425,687},{583,88,362,624},{520,25,299,561},{457,719,232,65535},{394,656,169,65535},{331,593,106,65535},{268,530,43,65535},
    {205,467,737,65535},{142,404,674,65535},{79,341,611,65535},{16,278,548,65535},{710,213,731,247},{647,150,668,184},{584,87,605,121},{521,24,542,58},
    {458,718,225,753},{395,655,162,690},{332,592,99,627},{269,529,36,564},{206,466,730,752},{143,403,667,689},{80,340,604,626},{17,277,541,563},
    {711,212,236,498},{648,149,173,435},{585,86,110,372},{522,23,47,309},{459,717,478,500},{396,654,415,437},{333,591,352,374},{270,528,289,311},
    {207,465,226,248},{144,402,163,185},{81,339,100,122},{18,276,37,59},{712,211,741,749},{649,148,678,686},{586,85,615,623},{523,22,552,560},
    {460,716,485,65535},{397,653,422,65535},{334,590,359,65535},{271,527,296,65535},{208,464,233,65535},{145,401,170,65535},{82,338,107,65535},{19,275,44,65535},
    {713,210,489,497},{650,147,426,434},{587,84,363,371},{524,21,300,308},{461,715,738,65535},{398,652,675,65535},{335,589,612,65535},{272,526,549,65535},
    {209,463,486,65535},{146,400,423,65535},{83,337,360,65535},{20,274,297,65535},{714,462,234,65535},{651,399,171,65535},{588,336,108,65535},{525,273,45,65535},
};
__device__ __forceinline__ void moba_sel_loop(const Params& p, int layer, int bid, LAS unsigned char* lds, int tid, int wave, int lane) {
    const float negM = -softmax_ref(p, layer, 0);
    const bf16_t* PROJ = (const bf16_t*)(p.ws + WS_PROJ);
    float* PML = (float*)(p.ws + WS_PML); bf16_t* PO = (bf16_t*)(p.ws + WS_PARTO);
    LAS unsigned short* list = (LAS unsigned short*)(lds + AT_LIST); LAS unsigned* cnt = (LAS unsigned*)(lds + AT_CNT);
    const int r32 = lane & 31, hi = lane >> 5;
#pragma unroll 1
    for (int trow = bid; trow < 256; trow += (int)gridDim.x)
#pragma unroll 1
    for (int k = 0; k < MOBA_TAB_W; ++k) {
        const int code = (int)moba_tab[trow][k];
        if (code == 0xFFFF) break;
        const int bh = code / 63, j = code - bh * 63, b = bh / 6, h = bh - b * 6, tstart = 256 * (j + 1);
        __syncthreads();
        if (tid == 0) *cnt = 0u;
        { KVRegs kv; kv_load(kv, PROJ + C_MK + 64 * h, PROJ + C_MV + 64 * h, (long)b * S + 256 * j, 0, tid); kv_store(lds, kv, tid); }
        __syncthreads();
        const unsigned* SEL = (const unsigned*)(p.ws + WS_SEL) + (size_t)bh * S;
        for (int t0 = tstart; t0 < S; t0 += 8 * NTHR) {
            unsigned selv[8];
#pragma unroll
            for (int i = 0; i < 8; ++i) { const int t = t0 + i * NTHR + tid; selv[i] = (t < S) ? SEL[t] : 0xFFFFFFu; }
#pragma unroll
            for (int i = 0; i < 8; ++i) {
                const unsigned sel = selv[i]; int rk = -1;
                if ((sel & 0xffu) == (unsigned)j) rk = 0; else if (((sel >> 8) & 0xffu) == (unsigned)j) rk = 1; else if (((sel >> 16) & 0xffu) == (unsigned)j) rk = 2;
                if (rk >= 0) { const unsigned pos = __hip_atomic_fetch_add(cnt, 1u, __ATOMIC_RELAXED, __HIP_MEMORY_SCOPE_WORKGROUP); list[pos] = (unsigned short)((unsigned)(t0 - tstart + i * NTHR + tid) | ((unsigned)rk << 14)); }
            }
        }
        __syncthreads();
        const int n = (int)*cnt;
        const int ntl = (n + 31) >> 5;
        bf16x8 qf[4]; unsigned e = 0u; bool valid = false;
        if (wave < ntl) { const int idx = 32 * wave + r32; valid = idx < n; e = list[valid ? idx : 0]; load_qf(qf, PROJ + ((long)b * S + tstart + (int)(e & 0x3fffu)) * NIN + C_MQ + 64 * h, hi); }
        for (int tl = wave; tl < ntl; tl += 8) {
            bf16x8 qn[4]; unsigned en = 0u; bool vn = false;
            if (tl + 8 < ntl) { const int idx = 32 * (tl + 8) + r32; vn = idx < n; en = list[vn ? idx : 0]; load_qf(qn, PROJ + ((long)b * S + tstart + (int)(en & 0x3fffu)) * NIN + C_MQ + 64 * h, hi); }
            else {
#pragma unroll
                for (int d0 = 0; d0 < 4; ++d0) qn[d0] = qf[d0];
            }
            const int t = tstart + (int)(e & 0x3fffu), rk = (int)(e >> 14);
            f32x16 o[2]; float l; attn_tile(lds, qf, 0, 255, 0, 7, -1, 8, negM, r32, hi, o, l);
            if (valid) {
                const size_t base = ((size_t)bh * S + t) * 3 + rk;
                if (hi == 0) { PML[base * 2] = 0.f; PML[base * 2 + 1] = l; }
                store_orow_bf16(PO + base * 64, o, 1.0f, hi);
            }
#pragma unroll
            for (int d0 = 0; d0 < 4; ++d0) qf[d0] = qn[d0];
            e = en; valid = vn;
        }
    }
    __syncthreads();
}
__device__ __forceinline__ void moba_own_loop(const Params& p, int layer, int first, int stride, LAS unsigned char* lds, int tid, int wave, int lane) {
    const float negM = -softmax_ref(p, layer, 0);
    const bf16_t* PROJ = (const bf16_t*)(p.ws + WS_PROJ); bf16_t* YC = (bf16_t*)(p.ws + WS_YCAT);
    const float* PML = (const float*)(p.ws + WS_PML); const bf16_t* PO = (const bf16_t*)(p.ws + WS_PARTO);
    const int r32 = lane & 31, hi = lane >> 5, qi = 32 * wave + r32;
    int u = first; bool have = u < 768;
    while (have) {
        const int bh = u % 12, blk = u / 12, b = bh / 6, h = bh % 6, t = 256 * blk + qi; const long row = (long)b * S + t;
        __syncthreads();
        { KVRegs kv; kv_load(kv, PROJ + C_MK + 64 * h, PROJ + C_MV + 64 * h, (long)b * S + 256 * blk, 0, tid); kv_store(lds, kv, tid); }
        bf16x8 qf[4]; load_qf(qf, PROJ + row * NIN + C_MQ + 64 * h, hi);
        const int nv = blk < 3 ? blk : 3;
        const size_t base = ((size_t)bh * S + t) * 3;
        float lr[3]; u32x2 pov[3][2][4];
#pragma unroll
        for (int r = 0; r < 3; ++r) {
            lr[r] = 0.f;
#pragma unroll
            for (int dt = 0; dt < 2; ++dt)
#pragma unroll
                for (int g = 0; g < 4; ++g) { pov[r][dt][g].x = 0u; pov[r][dt][g].y = 0u; }
            if (r < nv) {
                lr[r] = PML[(base + r) * 2 + 1];
                const bf16_t* src = PO + (base + r) * 64;
#pragma unroll
                for (int dt = 0; dt < 2; ++dt)
#pragma unroll
                    for (int g = 0; g < 4; ++g) pov[r][dt][g] = *(const u32x2*)(src + 32 * dt + 8 * g + 4 * hi);
            }
        }
        __syncthreads();
        const int un = u + stride; const bool hn = un < 768;
        f32x16 o[2]; float l; attn_tile(lds, qf, 0, qi, 0, wave, -1, wave, negM, r32, hi, o, l);
        float L = l;
#pragma unroll
        for (int r = 0; r < 3; ++r) {
            L += lr[r];
#pragma unroll
            for (int dt = 0; dt < 2; ++dt)
#pragma unroll
                for (int g = 0; g < 4; ++g) { const u32x2 wv = pov[r][dt][g];
                    o[dt][4 * g] += bflo(wv.x); o[dt][4 * g + 1] += bfhi(wv.x); o[dt][4 * g + 2] += bflo(wv.y); o[dt][4 * g + 3] += bfhi(wv.y); }
        }
        store_orow_bf16(YC + row * DM + 64 * h, o, 1.0f / L, hi);
        u = un; have = hn;
    }
    __syncthreads();
}

__device__ __forceinline__ float log_sigmoid(float f) { return fminf(f, 0.f) - log1pf(__expf(-fabsf(f))); }
__device__ __forceinline__ float wave_incl_scan(float v, int lane) {
#pragma unroll
    for (int o = 1; o < 64; o <<= 1) { const float t = shup(v, o, lane); if (lane >= o) v += t; }
    return v;
}
constexpr int MP = 72;
constexpr int MW_KT = 0, MW_VT = 64 * MP * 2, MW_SUB = 2 * 64 * MP * 2;
__device__ __forceinline__ void m1_wave_unit(const Params& p, int unit, LAS unsigned char* L, int lane) {
    const int bh = unit >> 8, c = unit & 255, b = bh >> 2, h = bh & 3;
    const long row0 = (long)b * S + 64 * c;
    const float* GT = (const float*)(p.ws + WS_GATES);
    const bf16_t* LQK = (const bf16_t*)(p.ws + WS_LQK); const bf16_t* PROJ = (const bf16_t*)(p.ws + WS_PROJ);
    const float ig = GT[(row0 + lane) * 8 + h], fg = GT[(row0 + lane) * 8 + 4 + h];
    u32x4 kq[8], vq[8];
#pragma unroll
    for (int i = 0; i < 8; ++i) { const int s = 8 * i + (lane >> 3), c8 = lane & 7;
        kq[i] = *(const u32x4*)(LQK + (row0 + s) * 512 + 256 + 64 * h + 8 * c8); vq[i] = *(const u32x4*)(PROJ + (row0 + s) * NIN + C_XV + 64 * h + 8 * c8); }
    const float bs = wave_incl_scan(log_sigmoid(fg), lane);
    const float a = shidx(bs, 63), g = a - bs + ig, mg = wave_max(g, lane), wl = __expf(g - mg);
    if (lane == 0) { float* MISC = (float*)(p.ws + WS_MISC); MISC[unit] = a; MISC[2048 + unit] = mg; }
#pragma unroll
    for (int i = 0; i < 8; ++i) {
        const int s = 8 * i + (lane >> 3), c8 = lane & 7;
        const float ws_ = shidx(wl, s);
        float kf[8]; unpack8(kq[i], kf);
        LAS bf16_t* kt = (LAS bf16_t*)(L + MW_KT) + (8 * c8) * MP + s;
#pragma unroll
        for (int e = 0; e < 8; e += 2) { const unsigned pw = pk2(kf[e] * ws_, kf[e + 1] * ws_); kt[e * MP] = (bf16_t)(pw & 0xffffu); kt[(e + 1) * MP] = (bf16_t)(pw >> 16); }
        LAS bf16_t* vt = (LAS bf16_t*)(L + MW_VT) + (8 * c8) * MP + s; const u32x4 vw = vq[i];
        vt[0 * MP] = (bf16_t)(vw.x & 0xffffu); vt[1 * MP] = (bf16_t)(vw.x >> 16); vt[2 * MP] = (bf16_t)(vw.y & 0xffffu); vt[3 * MP] = (bf16_t)(vw.y >> 16);
        vt[4 * MP] = (bf16_t)(vw.z & 0xffffu); vt[5 * MP] = (bf16_t)(vw.z >> 16); vt[6 * MP] = (bf16_t)(vw.w & 0xffffu); vt[7 * MP] = (bf16_t)(vw.w >> 16);
    }
    LDS_WAIT();
    const int r32 = lane & 31, hi = lane >> 5;
    float* DC = (float*)((unsigned char*)p.out + OUT_DC) + (size_t)unit * 4160;
    { float dn = 0.f;
#pragma unroll
      for (int q8 = 0; q8 < 8; ++q8) { const u32x4 w = *(const LAS u32x4*)(L + MW_KT + (lane * MP + 8 * q8) * 2); float v[8]; unpack8(w, v);
#pragma unroll
          for (int e = 0; e < 8; ++e) dn += v[e]; }
      DC[64 * 64 + lane] = dn; }
#pragma unroll 1
    for (int wp = 0; wp < 2; ++wp) {
        f32x16 acc[2];
#pragma unroll
        for (int et = 0; et < 2; ++et)
#pragma unroll
            for (int r = 0; r < 16; ++r) acc[et][r] = 0.f;
#pragma unroll
        for (int ks = 0; ks < 4; ++ks) {
            const bf16x8 bfr = *(const LAS bf16x8*)(L + MW_KT + ((32 * wp + r32) * MP + 16 * ks + 8 * hi) * 2);
#pragma unroll
            for (int et = 0; et < 2; ++et) {
                const bf16x8 afr = *(const LAS bf16x8*)(L + MW_VT + ((32 * et + r32) * MP + 16 * ks + 8 * hi) * 2);
                acc[et] = __builtin_amdgcn_mfma_f32_32x32x16_bf16(afr, bfr, acc[et], 0, 0, 0);
            }
        }
        const int d = 32 * wp + r32;
#pragma unroll
        for (int et = 0; et < 2; ++et)
#pragma unroll
            for (int r = 0; r < 16; ++r) { const int e = 32 * et + (r & 3) + 8 * (r >> 2) + 4 * hi; DC[e * 64 + d] = acc[et][r]; }
    }
    LDS_WAIT();
}
__device__ __forceinline__ void scan_unit(const Params& p, int su, LAS unsigned char* lds, int tid) {
    const int e0 = su * NTHR, bh0 = e0 / 4160;
    const float* MISC = (const float*)(p.ws + WS_MISC); float* MS = (float*)(p.ws + WS_MISC) + 4096;
    const float* __restrict__ DC = (const float*)((const unsigned char*)p.out + OUT_DC); bf16_t* __restrict__ CST = (bf16_t*)((unsigned char*)p.out + OUT_CST);
    LAS float* la = (LAS float*)lds; LAS float* lmg = la + 512; LAS float* ldec = la + 1024; LAS float* lsc = la + 1536;
    { const int which = tid >> 8, c = tid & 255, bh = bh0 + which;
      la[tid] = (bh < 8) ? MISC[bh * 256 + c] : 0.f; lmg[tid] = (bh < 8) ? MISC[2048 + bh * 256 + c] : 0.f; }
    __syncthreads();
    LAS float* lm = la + 2048;
    if (tid < 2) {
        float m = 0.f;
#pragma unroll 1
        for (int c0 = 0; c0 < 256; c0 += 32) {
            float av[32], gv[32], mv[32];
#pragma unroll
            for (int k = 0; k < 32; ++k) { av[k] = la[tid * 256 + c0 + k]; gv[k] = lmg[tid * 256 + c0 + k]; }
#pragma unroll
            for (int k = 0; k < 32; ++k) { mv[k] = m; m = fmaxf(av[k] + m, gv[k]); }
#pragma unroll
            for (int k = 0; k < 32; ++k) lm[tid * 257 + c0 + k] = mv[k];
        }
        lm[tid * 257 + 256] = m;
    }
    __syncthreads();
    { const int which = tid >> 8, c = tid & 255, bh = bh0 + which;
      const float m0 = lm[which * 257 + c], m1 = lm[which * 257 + c + 1];
      ldec[tid] = __expf(la[tid] + m0 - m1); lsc[tid] = __expf(lmg[tid] - m1);
      if ((bh < 8) && (bh * 4160 >= e0) && (bh * 4160 < e0 + NTHR)) MS[bh * 256 + c] = m0; }
    __syncthreads();
    const int e = e0 + tid, bh = e / 4160, idx = e - bh * 4160, which = bh - bh0;
    const float* __restrict__ dcp = DC + (size_t)bh * 256 * 4160 + idx; bf16_t* __restrict__ csp = CST + (size_t)bh * 256 * 4160 + idx;
    float C = 0.f;
#pragma unroll 1
    for (int c0 = 0; c0 < 256; c0 += 32) {
        float dcv[32];
#pragma unroll
        for (int k = 0; k < 32; ++k) dcv[k] = dcp[(size_t)(c0 + k) * 4160];
#pragma unroll
        for (int k = 0; k < 32; ++k) {
            csp[(size_t)(c0 + k) * 4160] = (bf16_t)(pk2(C, 0.f) & 0xffffu);
            C = ldec[which * 256 + c0 + k] * C + lsc[which * 256 + c0 + k] * dcv[k];
        }
    }
    __syncthreads();
}
constexpr int M3_VT = 0, M3_CS = 64 * MP * 2, M3_BS = M3_CS + 256, M3_SUB = M3_BS + 256;
__device__ __forceinline__ void m3_wave_unit(const Params& p, int layer, int unit, LAS unsigned char* L, int lane) {
    const int bh = unit >> 8, c = unit & 255, b = bh >> 2, h = bh & 3;
    const long row0 = (long)b * S + 64 * c;
    LAS float* cs = (LAS float*)(L + M3_CS); LAS float* bsv = (LAS float*)(L + M3_BS);
    const float* GT = (const float*)(p.ws + WS_GATES);
    const bf16_t* LQK = (const bf16_t*)(p.ws + WS_LQK); const bf16_t* PROJ = (const bf16_t*)(p.ws + WS_PROJ);
    const int r32 = lane & 31, hi = lane >> 5;
    const float ig = GT[(row0 + lane) * 8 + h], fg = GT[(row0 + lane) * 8 + 4 + h];
    u32x4 vq[8];
#pragma unroll
    for (int i = 0; i < 8; ++i) { const int s = 8 * i + (lane >> 3), c8 = lane & 7; vq[i] = *(const u32x4*)(PROJ + (row0 + s) * NIN + C_XV + 64 * h + 8 * c8); }
    const bf16_t* CST = (const bf16_t*)((const unsigned char*)p.out + OUT_CST) + (size_t)unit * 4160;
    const float m_c = ((const float*)(p.ws + WS_MISC))[4096 + unit];
    { const float bs = wave_incl_scan(log_sigmoid(fg), lane); cs[lane] = ig - bs; bsv[lane] = bs; }
#pragma unroll
    for (int i = 0; i < 8; ++i) {
        const int s = 8 * i + (lane >> 3), c8 = lane & 7;
        LAS bf16_t* vt = (LAS bf16_t*)(L + M3_VT) + (8 * c8) * MP + s; const u32x4 vw = vq[i];
        vt[0 * MP] = (bf16_t)(vw.x & 0xffffu); vt[1 * MP] = (bf16_t)(vw.x >> 16); vt[2 * MP] = (bf16_t)(vw.y & 0xffffu); vt[3 * MP] = (bf16_t)(vw.y >> 16);
        vt[4 * MP] = (bf16_t)(vw.z & 0xffffu); vt[5 * MP] = (bf16_t)(vw.z >> 16); vt[6 * MP] = (bf16_t)(vw.w & 0xffffu); vt[7 * MP] = (bf16_t)(vw.w >> 16);
    }
    LDS_WAIT();
    const float* nw = p.mlstm_norm + (size_t)layer * 256 + 64 * h;
#pragma unroll 1
    for (int wp = 0; wp < 2; ++wp) {
        const int t = 32 * wp + r32; const long row = row0 + t;
        bf16x8 qf[4]; load_qf(qf, LQK + row * 512 + 64 * h, hi);
        bf16x8 kfr[2][4];
#pragma unroll
        for (int st = 0; st < 2; ++st)
#pragma unroll
            for (int d0 = 0; d0 < 4; ++d0) kfr[st][d0] = *(const bf16x8*)(LQK + (row0 + 32 * st + r32) * 512 + 256 + 64 * h + 16 * d0 + 8 * hi);
        u32x2 xwv[2][4];
#pragma unroll
        for (int et = 0; et < 2; ++et)
#pragma unroll
            for (int g = 0; g < 4; ++g) xwv[et][g] = *(const u32x2*)(PROJ + row * NIN + C_XO + 64 * h + 32 * et + 8 * g + 4 * hi);
        f32x16 sT[2];
#pragma unroll
        for (int st = 0; st < 2; ++st) {
            f32x16 a;
#pragma unroll
            for (int r = 0; r < 16; ++r) a[r] = 0.f;
#pragma unroll
            for (int d0 = 0; d0 < 4; ++d0) a = __builtin_amdgcn_mfma_f32_32x32x16_bf16(kfr[st][d0], qf[d0], a, 0, 0, 0);
            sT[st] = a;
        }
        const float b_t = bsv[t], inter = b_t + m_c;
        float mx = inter;
#pragma unroll
        for (int st = 0; st < 2; ++st)
#pragma unroll
            for (int g = 0; g < 4; ++g) {
                const f32x4 c4 = *(const LAS f32x4*)(cs + 32 * st + 8 * g + 4 * hi);
#pragma unroll
                for (int e2 = 0; e2 < 4; ++e2) { const int s = 32 * st + 8 * g + 4 * hi + e2; const float dv = (s <= t) ? (b_t + c4[e2]) : -INFINITY; mx = fmaxf(mx, dv); }
            }
        mx = max_x32(mx);
        const float w_inter = __expf(inter - mx);
        float den = 0.f;
#pragma unroll
        for (int st = 0; st < 2; ++st)
#pragma unroll
            for (int g = 0; g < 4; ++g) {
                const f32x4 c4 = *(const LAS f32x4*)(cs + 32 * st + 8 * g + 4 * hi);
#pragma unroll
                for (int e2 = 0; e2 < 4; ++e2) { const int s = 32 * st + 8 * g + 4 * hi + e2; const float dv = (s <= t) ? (b_t + c4[e2] - mx) : -INFINITY;
                    const float qk = sT[st][4 * g + e2] * __expf(dv); sT[st][4 * g + e2] = qk; den += qk; }
            }
        den = sum_x32(den);
        f32x16 acc[3];
#pragma unroll
        for (int et = 0; et < 3; ++et) {
            bf16x8 cfr[4];
#pragma unroll
            for (int d0 = 0; d0 < 4; ++d0) cfr[d0] = *(const bf16x8*)(CST + (32 * et + r32) * 64 + 16 * d0 + 8 * hi);
            f32x16 a;
#pragma unroll
            for (int r = 0; r < 16; ++r) a[r] = 0.f;
#pragma unroll
            for (int d0 = 0; d0 < 4; ++d0) a = __builtin_amdgcn_mfma_f32_32x32x16_bf16(cfr[d0], qf[d0], a, 0, 0, 0);
            acc[et] = a;
        }
        const float qn = shidx(acc[2][0], r32);
#pragma unroll
        for (int et = 0; et < 2; ++et)
#pragma unroll
            for (int r = 0; r < 16; ++r) acc[et][r] *= w_inter;
#pragma unroll
        for (int st = 0; st < 2; ++st)
#pragma unroll
            for (int j = 0; j < 2; ++j) {
                u32x4 pw; pw.x = pk2(sT[st][8 * j + 0], sT[st][8 * j + 1]); pw.y = pk2(sT[st][8 * j + 2], sT[st][8 * j + 3]); pw.z = pk2(sT[st][8 * j + 4], sT[st][8 * j + 5]); pw.w = pk2(sT[st][8 * j + 6], sT[st][8 * j + 7]);
                const bf16x8 pb = __builtin_bit_cast(bf16x8, pw);
#pragma unroll
                for (int et = 0; et < 2; ++et) {
                    const LAS unsigned char* vp = L + M3_VT + ((32 * et + r32) * MP + 32 * st + 16 * j + 4 * hi) * 2;
                    const u32x2 lo = *(const LAS u32x2*)vp, hi2 = *(const LAS u32x2*)(vp + 16);
                    u32x4 vw; vw.x = lo.x; vw.y = lo.y; vw.z = hi2.x; vw.w = hi2.y;
                    acc[et] = __builtin_amdgcn_mfma_f32_32x32x16_bf16(__builtin_bit_cast(bf16x8, vw), pb, acc[et], 0, 0, 0);
                }
            }
        const float dtot = w_inter * qn + den, inv = 1.0f / fmaxf(fabsf(dtot), __expf(-mx));
        float ss = 0.f;
#pragma unroll
        for (int et = 0; et < 2; ++et)
#pragma unroll
            for (int g = 0; g < 4; ++g) {
                const u32x2 xw = xwv[et][g];
                const float xo[4] = {bflo(xw.x), bfhi(xw.x), bflo(xw.y), bfhi(xw.y)};
#pragma unroll
                for (int e2 = 0; e2 < 4; ++e2) { const float hv = acc[et][4 * g + e2] * inv / (1.f + __expf(-xo[e2])); acc[et][4 * g + e2] = hv; ss += hv * hv; }
            }
        ss = sum_x32(ss);
        const float rs = rsqrtf(ss * (1.0f / 64.0f) + EPS);
        bf16_t* dst = (bf16_t*)(p.ws + WS_YCAT) + row * DM + 384 + 64 * h;
#pragma unroll
        for (int et = 0; et < 2; ++et)
#pragma unroll
            for (int g = 0; g < 4; ++g) {
                const f32x4 nv = *(const f32x4*)(nw + 32 * et + 8 * g + 4 * hi);
                u32x2 w; w.x = pk2(acc[et][4 * g] * rs * nv[0], acc[et][4 * g + 1] * rs * nv[1]); w.y = pk2(acc[et][4 * g + 2] * rs * nv[2], acc[et][4 * g + 3] * rs * nv[3]);
                *(u32x2*)(dst + 32 * et + 8 * g + 4 * hi) = w;
            }
    }
    LDS_WAIT();
}

__global__ void __launch_bounds__(NTHR, 2) hybrid_fwd(Params p0) {
    extern __shared__ __attribute__((aligned(16))) unsigned char lds_raw[];
    LAS unsigned char* lds = (LAS unsigned char*)lds_raw;
    cg::grid_group grid = cg::this_grid();
    const int lo = p0.ph_lo, hi = p0.ph_hi;
    if (threadIdx.x < 16) ((LAS unsigned*)(lds + BAR_LDS_OFF))[threadIdx.x] = 0u;
    __syncthreads();
    const int wave_s = __builtin_amdgcn_readfirstlane((int)threadIdx.x >> 6);
    XcdBarrier xbar; xbar.t0 = false; xbar.bar = (unsigned*)(p0.ws + WS_CTL) + 4096; xbar.x = 0; xbar.st = nullptr;
    (void)lo; (void)hi;
    if (blockIdx.x == 0) { unsigned* bw_ = (unsigned*)(p0.ws + WS_CTL) + 4096; for (int i_ = (int)threadIdx.x; i_ < XCD_BAR_WORDS; i_ += NTHR) bw_[i_] = 0u; }
#define IN(k) (true)
#ifdef TS_PROBE
#define STAMP(k) do { if (blockIdx.x == 0 && threadIdx.x == 0) ((LAS unsigned long long*)(lds + 131072 + 256))[(k)] = __builtin_amdgcn_s_memrealtime(); } while (0)
#else
#define STAMP(k) do { } while (0)
#endif
#define SEAM(k) do { if ((k) < 16) { if ((k) == 0) grid.sync(); else xcd_barrier(xbar); } STAMP((k) + 1); } while (0)
    STAMP(0);
#if defined(__HIP_DEVICE_COMPILE__)
#define LOAD_PARAMS(p) do { const __attribute__((address_space(4))) Params* kp_ = (const __attribute__((address_space(4))) Params*)__builtin_amdgcn_kernarg_segment_ptr(); asm volatile("" : "+s"(kp_)); p = *kp_; } while (0)
#else
#define LOAD_PARAMS(p) do { p = p0; } while (0)
#endif
#define PHASE_VARS() int lane_ = lane_nocse(); int wave_ = wave_s; asm volatile("" : "+s"(wave_)); const int lane = lane_, wave = wave_, tid = wave_ * 64 + lane_; \
    int bid = (int)blockIdx.x; asm volatile("" : "+s"(bid)); const int G = (int)gridDim.x; Params p; LOAD_PARAMS(p); { unsigned char* w_ = p.ws; asm volatile("" : "+s"(w_)); p.ws = w_; } unsigned char* ws = p.ws; (void)ws; (void)lane; (void)wave; (void)bid; (void)G
    for (int rep_ = 0; rep_ < ((REPEAT_MASK & 1) ? 2 : 1); ++rep_) { if (rep_) xcd_barrier(xbar);
        if (IN(0)) { PHASE_VARS(); prologue(p, lds, tid, wave, lane); }
    }
        SEAM(0);
    xbar = xcd_barrier_post((unsigned*)(p0.ws + WS_CTL) + 4096, (volatile LAS unsigned*)(lds + BAR_LDS_OFF), wave_s == 0);
#pragma unroll 1
    for (int layer = 0; layer < 2; ++layer) {
        const int P = 1 + 8 * layer;
        for (int rep_ = 0; rep_ < ((REPEAT_MASK & 2) ? 2 : 1); ++rep_) { if (rep_) xcd_barrier(xbar);
        if (IN(P)) { PHASE_VARS(); EpiScaled<0> E{(bf16_t*)(ws + WS_PROJ), NIN, (const float*)(ws + WS_SSQ)}; run_gemm(lds, (const bf16_t*)(ws + WS_XB), (const bf16_t*)(ws + WS_WIN + layer * WIN_L), T, NIN, DM, E, bid, tid);
            if (rep_ == 0) {
                const int nfull = ((T / 256) * (NIN / 256)) % G, w0 = (nfull == 0) ? 0 : nfull;
                if (bid >= w0) {
                    if (layer == 0) convert_deferred_weights(p, lds, (bid - w0) * 8 + wave, (G - w0) * 8, wave, lane);
                    for (int gu = bid - w0; gu < 128; gu += G - w0) gates_unit(p, layer, gu, wave, lane);
                }
            } }
        }
        SEAM(P);
        if (IN(P + 1)) { PHASE_VARS();
            for (int u = bid; u < 128 * 22; u += G) prep_unit(p, layer, u, lds, tid, wave, lane);
#if MIX_STAGE < 3
            { u32x4* y4 = (u32x4*)(ws + WS_YCAT); const u32x4 z = {0u, 0u, 0u, 0u}; for (size_t e = (size_t)bid * NTHR + tid; e < (size_t)T * DM / 8; e += (size_t)G * NTHR) y4[e] = z; }
#endif
        }
        SEAM(P + 1);
        for (int rep_ = 0; rep_ < ((REPEAT_MASK & 4) ? 2 : 1); ++rep_) { if (rep_) xcd_barrier(xbar);
        if (IN(P + 2)) { PHASE_VARS();
#if MIX_STAGE >= 1
            for (int r2_ = 0; r2_ < ((REPEAT_MASK & 512) ? 2 : 1); ++r2_) { for (int un_ = bid * 8 + wave; un_ < 2048; un_ += G * 8) m1_wave_unit(p, un_, lds + wave * MW_SUB, lane); }
#endif
#if MIX_STAGE >= 3
            for (int r2_ = 0; r2_ < ((REPEAT_MASK & 256) ? 2 : 1); ++r2_) { for (int hu = bid * 8 + wave; hu < 6144; hu += G * 8) sel_wave_unit(p, hu >> 1, hu & 1, lane); }
#endif
        }
        }
        SEAM(P + 2);
        for (int rep_ = 0; rep_ < ((REPEAT_MASK & 8) ? 2 : 1); ++rep_) { if (rep_) xcd_barrier(xbar);
        if (IN(P + 3)) { PHASE_VARS();
            if (bid < 65) {
#if MIX_STAGE >= 1
                for (int r2_ = 0; r2_ < ((REPEAT_MASK & 128) ? 2 : 1); ++r2_) { scan_unit(p, bid, lds, tid); }
#endif
            } else {
#if MIX_STAGE >= 2
                for (int r2_ = 0; r2_ < ((REPEAT_MASK & 128) ? 2 : 1); ++r2_) { swa_loop(p, layer, bid - 65, G - 65, lds, tid, wave, lane); }
#endif
            }
#if MIX_STAGE >= 3
            for (int r2_ = 0; r2_ < ((REPEAT_MASK & 64) ? 2 : 1); ++r2_) { moba_sel_loop(p, layer, bid, lds, tid, wave, lane); }
#endif
        }
        }
        SEAM(P + 3);
        for (int rep_ = 0; rep_ < ((REPEAT_MASK & 16) ? 2 : 1); ++rep_) { if (rep_) xcd_barrier(xbar);
        if (IN(P + 4)) { PHASE_VARS();
#if MIX_STAGE >= 3
            for (int r2_ = 0; r2_ < ((REPEAT_MASK & 1024) ? 2 : 1); ++r2_) { moba_own_loop(p, layer, bid, G, lds, tid, wave, lane); }
#endif
#if MIX_STAGE >= 1
            for (int r2_ = 0; r2_ < ((REPEAT_MASK & 2048) ? 2 : 1); ++r2_) { for (int un_ = bid * 8 + wave; un_ < 2048; un_ += G * 8) m3_wave_unit(p, layer, un_, lds + wave * M3_SUB, lane); }
#endif
        }
        }
        SEAM(P + 4);
        if (IN(P + 5)) { PHASE_VARS(); EpiRes E{nullptr, (const bf16_t*)(ws + WS_XB), nullptr, (bf16_t*)(ws + WS_XB), (float*)(ws + WS_SSQ)};     run_gemm(lds, (const bf16_t*)(ws + WS_YCAT), (const bf16_t*)(ws + WS_WOUT + layer * WOUT_L), T, DM, DM, E, bid, tid); }
        SEAM(P + 5);
        for (int rep_ = 0; rep_ < ((REPEAT_MASK & 32) ? 2 : 1); ++rep_) { if (rep_) xcd_barrier(xbar);
        if (IN(P + 6)) { PHASE_VARS(); EpiScaled<1> E{(bf16_t*)(ws + WS_H), FF, (const float*)(ws + WS_SSQ)}; run_gemm(lds, (const bf16_t*)(ws + WS_XB), (const bf16_t*)(ws + WS_WUP + layer * WUP_L), T, FF, DM, E, bid, tid); }
        }
        SEAM(P + 6);
        if (IN(P + 7)) { PHASE_VARS(); EpiRes E{nullptr, (const bf16_t*)(ws + WS_XB), layer == 0 ? nullptr : p.out, layer == 0 ? (bf16_t*)(ws + WS_XB) : nullptr, layer == 0 ? (float*)(ws + WS_SSQ) : nullptr};     run_gemm(lds, (const bf16_t*)(ws + WS_H), (const bf16_t*)(ws + WS_WDN + layer * WDN_L), T, DM, FF, E, bid, tid); }
        SEAM(P + 7);
    }
#ifdef TS_PROBE
    xcd_barrier(xbar);
    if (blockIdx.x == 0 && threadIdx.x == 0) { LAS unsigned long long* ts = (LAS unsigned long long*)(lds + 131072 + 256); p0.out[0] = (float)(ts[TS_PROBE + 1] - ts[TS_PROBE]) * 10.0f; }
#endif
#undef IN
#undef SEAM
}

#ifndef N_LAUNCH_SPLIT
#define N_LAUNCH_SPLIT 0
#endif
extern "C" void kernel_launch(void* const* d_in, const int* in_sizes, int n_in, void* d_out, int out_size, void* d_ws, size_t ws_size, hipStream_t stream) {
    static int grid = 0;
    if (grid == 0) {
        if (n_in != 17 || in_sizes[0] != T * DM || out_size != T * DM || ws_size < WS_END) { fprintf(stderr, "kernel_launch: unexpected shapes (n_in %d, in0 %d, out %d, ws %zu); nothing launched\n", n_in, n_in > 0 ? in_sizes[0] : -1, out_size, ws_size); grid = -1; return; }
        int dev = 0, cus = 0, per_cu = 0;
        if (hipGetDevice(&dev) != hipSuccess || hipDeviceGetAttribute(&cus, hipDeviceAttributeMultiprocessorCount, dev) != hipSuccess) { grid = -1; return; }
        if (hipFuncSetAttribute((const void*)hybrid_fwd, hipFuncAttributeMaxDynamicSharedMemorySize, LDS_BYTES) != hipSuccess) { fprintf(stderr, "kernel_launch: hipFuncSetAttribute failed\n"); grid = -1; return; }
        if (hipOccupancyMaxActiveBlocksPerMultiprocessor(&per_cu, (const void*)hybrid_fwd, NTHR, LDS_BYTES) != hipSuccess || per_cu < 1) { fprintf(stderr, "kernel_launch: occupancy query says %d blocks per CU\n", per_cu); (void)hipGetLastError(); grid = -1; return; }
        grid = cus;
    }
    if (grid < 0) return;
    Params p{};
    const float** pp = (const float**)&p;
    for (int i = 0; i < 17; ++i) pp[i] = (const float*)d_in[i];
    p.out = (float*)d_out; p.ws = (unsigned char*)d_ws;
#if N_LAUNCH_SPLIT
    for (int ph = 0; ph < 17; ++ph) {
        p.ph_lo = ph; p.ph_hi = ph + 1; void* args[] = {&p};
        hipError_t e = hipLaunchCooperativeKernel((const void*)hybrid_fwd, dim3(grid), dim3(NTHR), args, LDS_BYTES, stream);
        if (e != hipSuccess) { fprintf(stderr, "cooperative launch failed: %s\n", hipGetErrorString(e)); break; }
    }
#else
    p.ph_lo = 0; p.ph_hi = 17; void* args[] = {&p};
    hipError_t e = hipLaunchCooperativeKernel((const void*)hybrid_fwd, dim3(grid), dim3(NTHR), args, LDS_BYTES, stream);
    if (e != hipSuccess) fprintf(stderr, "cooperative launch failed: %s (grid %d)\n", hipGetErrorString(e), grid);
#endif
}
```
